# Optimizing an MI355X kernel written in HIP

```python
import math
import jax, jax.numpy as jnp
from jax import lax
import numpy as np

D_MODEL = 1024
BATCH = 4
SEQ = 8192
DEPTH = 2

HEAD_DIM = 64
NSA_HEADS = 8
NSA_KV_HEADS = 2
NSA_GROUP = NSA_HEADS // NSA_KV_HEADS
RET_HEADS = 8
RET_DK = 32
RET_DV = 64
NSA_WIDTH = NSA_HEADS * HEAD_DIM
RET_WIDTH = RET_HEADS * RET_DV
MIX_WIDTH = NSA_WIDTH + RET_WIDTH
KV_WIDTH = NSA_KV_HEADS * HEAD_DIM
CMP_LEN = 32
CMP_STRIDE = 16
SLC_LEN = 64
SLC_TOPK = 16
WIN = 512
Q_BLOCK = 128
RET_CHUNK = 128
D_FF = 2816
N_EXPERTS = 8
TOP_K_EXPERTS = 2
N_DENSE = (DEPTH + 1) // 2
N_MOE = DEPTH // 2
EPS = 1e-6
NEG = -1e30
BIG = 1e9
IN_WIDTHS = (NSA_WIDTH, KV_WIDTH, KV_WIDTH, KV_WIDTH, KV_WIDTH, KV_WIDTH, KV_WIDTH,
             3 * NSA_HEADS, RET_HEADS * RET_DK, RET_HEADS * RET_DK, RET_WIDTH, RET_WIDTH)
IN_COLS = sum(IN_WIDTHS)

kernel_name = "hymba_nsa_retention_moe_block"


def rms_norm(x, g):
    xf = x.astype(jnp.float32)
    y = xf * lax.rsqrt(jnp.mean(xf * xf, axis=-1, keepdims=True) + EPS)
    return (y * g).astype(x.dtype)


def alibi_slopes(n):
    return jnp.exp2(-8.0 * jnp.arange(1, n + 1, dtype=jnp.float32) / n)


def _cmp_to_slc(nc, ns):
    cs = jnp.arange(nc) * CMP_STRIDE
    ce = cs + CMP_LEN
    ss = jnp.arange(ns) * SLC_LEN
    se = ss + SLC_LEN
    ov = jnp.clip(jnp.minimum(ce[:, None], se[None]) - jnp.maximum(cs[:, None], ss[None]), 0, None)
    return ov.astype(jnp.float32) / CMP_LEN


def _nsa(q, k_cmp, v_cmp, k_slc, v_slc, k_win, v_win, gates):
    B, G, R, T, Dh = q.shape
    nc = k_cmp.shape[2]
    ns = T // SLC_LEN
    n_sel = min(SLC_TOPK, ns)
    scale = Dh ** -0.5
    slopes = alibi_slopes(NSA_HEADS).reshape(G, R)[:, :, None, None]
    cmp_end = jnp.arange(nc) * CMP_STRIDE + CMP_LEN - 1
    overlap = _cmp_to_slc(nc, ns)
    k_blk = k_slc.reshape(B, G, ns, SLC_LEN, Dh)
    v_blk = v_slc.reshape(B, G, ns, SLC_LEN, Dh)
    pad = ((0, 0), (0, 0), (WIN, 0), (0, 0))
    k_win_p = jnp.pad(k_win, pad)
    v_win_p = jnp.pad(v_win, pad)
    bi = jnp.arange(B)[:, None, None]
    gi = jnp.arange(G)[None, :, None]
    blk = jnp.arange(ns)

    def block(i):
        q0 = i * Q_BLOCK
        qb = lax.dynamic_slice_in_dim(q, q0, Q_BLOCK, axis=3)
        gb = lax.dynamic_slice_in_dim(gates, q0, Q_BLOCK, axis=3)
        t = q0 + jnp.arange(Q_BLOCK)

        s = jnp.einsum('bgrqd,bgcd->bgrqc', qb, k_cmp).astype(jnp.float32) * scale
        dist = (t[:, None] - cmp_end[None, :]).astype(jnp.float32)
        s = jnp.where(dist >= 0, s - slopes * dist, NEG)
        p_cmp = jax.nn.softmax(s, axis=-1) * (t >= CMP_LEN - 1)[:, None]
        o_cmp = jnp.einsum('bgrqc,bgcd->bgrqd', p_cmp.astype(v_cmp.dtype), v_cmp)

        imp = jnp.einsum('bgrqc,cs->bgqs', p_cmp, overlap)
        cur = t // SLC_LEN
        forced = (blk[None] == 0) | (blk[None] == cur[:, None]) | (blk[None] == cur[:, None] - 1)
        valid = blk[None] * SLC_LEN <= t[:, None]
        imp = jnp.where(forced, BIG, jnp.where(valid, imp, -BIG))
        _, sel = lax.top_k(imp, n_sel)
        sel_flat = sel.reshape(B, G, Q_BLOCK * n_sel)
        k_sel = k_blk[bi, gi, sel_flat].reshape(B, G, Q_BLOCK, n_sel * SLC_LEN, Dh)
        v_sel = v_blk[bi, gi, sel_flat].reshape(B, G, Q_BLOCK, n_sel * SLC_LEN, Dh)
        pos = (sel[..., None] * SLC_LEN + jnp.arange(SLC_LEN)).reshape(B, G, Q_BLOCK, n_sel * SLC_LEN)
        s = jnp.einsum('bgrqd,bgqkd->bgrqk', qb, k_sel).astype(jnp.float32) * scale
        dist = (t[:, None] - pos).astype(jnp.float32)[:, :, None]
        s = jnp.where(dist >= 0, s - slopes * dist, NEG)
        p = jax.nn.softmax(s, axis=-1)
        o_slc = jnp.einsum('bgrqk,bgqkd->bgrqd', p.astype(v_sel.dtype), v_sel)

        kw = lax.dynamic_slice_in_dim(k_win_p, q0, WIN + Q_BLOCK, axis=2)
        vw = lax.dynamic_slice_in_dim(v_win_p, q0, WIN + Q_BLOCK, axis=2)
        posw = q0 - WIN + jnp.arange(WIN + Q_BLOCK)
        dist = (t[:, None] - posw[None, :])
        ok = (dist >= 0) & (dist < WIN) & (posw[None, :] >= 0)
        s = jnp.einsum('bgrqd,bgkd->bgrqk', qb, kw).astype(jnp.float32) * scale
        s = jnp.where(ok, s - slopes * dist.astype(jnp.float32), NEG)
        p = jax.nn.softmax(s, axis=-1)
        o_win = jnp.einsum('bgrqk,bgkd->bgrqd', p.astype(vw.dtype), vw)

        return gb[..., 0:1] * o_cmp + gb[..., 1:2] * o_slc + gb[..., 2:3] * o_win

    out = lax.map(block, jnp.arange(T // Q_BLOCK))
    return out.transpose(1, 0, 4, 2, 3, 5).reshape(B, T, G * R * Dh)


def _retention(q, k, v):
    B, T, H, dk = q.shape
    dv = v.shape[-1]
    nch = T // RET_CHUNK
    log_g = jnp.log1p(-jnp.exp2(-5.0 - jnp.arange(H, dtype=jnp.float32)))
    idx = jnp.arange(RET_CHUNK, dtype=jnp.float32)
    diff = idx[:, None] - idx[None, :]
    decay = jnp.where(diff >= 0, jnp.exp(jnp.maximum(diff, 0.0) * log_g[:, None, None]), 0.0)
    zeta = jnp.exp((RET_CHUNK - 1 - idx) * log_g[:, None])
    xi = jnp.exp((idx + 1) * log_g[:, None])
    g_chunk = jnp.exp(RET_CHUNK * log_g)

    def chunks(a):
        return a.reshape(B, nch, RET_CHUNK, H, a.shape[-1]).transpose(1, 0, 3, 2, 4).astype(jnp.float32)

    def step(state, qkv):
        qc, kc, vc = qkv
        inner = jnp.einsum('bhid,bhjd->bhij', qc, kc) * decay
        o = jnp.einsum('bhij,bhje->bhie', inner, vc) + jnp.einsum('bhid,bhde->bhie', qc, state) * xi[..., None]
        state = state * g_chunk[:, None, None] + jnp.einsum('bhjd,bhje->bhde', kc * zeta[..., None], vc)
        return state, o

    _, o = lax.scan(step, jnp.zeros((B, H, dk, dv), jnp.float32), (chunks(q), chunks(k), chunks(v)))
    return o.transpose(1, 0, 3, 2, 4).reshape(B, T, H, dv)


def _mixer(h, w_in, q_norm_g, k_norm_g, cmp_pos, w_cmp, ret_norm_g, w_out):
    B, T, _ = h.shape
    G, R, Dh = NSA_KV_HEADS, NSA_GROUP, HEAD_DIM
    points = [int(p) for p in np.cumsum(IN_WIDTHS)[:-1]]
    q, kc, vc, ks, vs, kw, vw, gts, rq, rk, rv, rg = jnp.split(h @ w_in, points, axis=-1)

    q = rms_norm(q.reshape(B, T, G, R, Dh).transpose(0, 2, 3, 1, 4), q_norm_g)

    def kv(a):
        return a.reshape(B, T, G, Dh).transpose(0, 2, 1, 3)

    k_slc = rms_norm(kv(ks), k_norm_g[1])
    k_win = rms_norm(kv(kw), k_norm_g[2])
    nc = (T - CMP_LEN) // CMP_STRIDE + 1
    cidx = jnp.arange(nc)[:, None] * CMP_STRIDE + jnp.arange(CMP_LEN)[None, :]

    def compress(a, pos_emb, w):
        blocks = kv(a)[:, :, cidx] + pos_emb
        return blocks.reshape(B, G, nc, CMP_LEN * Dh) @ w

    k_cmp = rms_norm(compress(kc, cmp_pos[0], w_cmp[0]), k_norm_g[0])
    v_cmp = compress(vc, cmp_pos[1], w_cmp[1])
    gates = jax.nn.sigmoid(gts.reshape(B, T, G, R, 3).transpose(0, 2, 3, 1, 4))
    nsa = _nsa(q, k_cmp, v_cmp, k_slc, kv(vs), k_win, kv(vw), gates)

    rq = rq.reshape(B, T, RET_HEADS, RET_DK) * (RET_DK ** -0.5)
    rk = rk.reshape(B, T, RET_HEADS, RET_DK)
    rv = rv.reshape(B, T, RET_HEADS, RET_DV)
    ret = rms_norm(_retention(rq, rk, rv), ret_norm_g.reshape(RET_HEADS, RET_DV))
    ret = ret.reshape(B, T, RET_WIDTH).astype(h.dtype) * jax.nn.silu(rg)

    return jnp.concatenate([nsa, ret], axis=-1) @ w_out


def _swiglu(h, wg, wu, wd):
    return (jax.nn.silu(h @ wg) * (h @ wu)) @ wd


def _moe(h, router, router_b, wg, wu, wd):
    logits = (h @ router).astype(jnp.float32) + router_b
    top_vals, top_idx = lax.top_k(logits, TOP_K_EXPERTS)
    w = jax.nn.softmax(top_vals, axis=-1)
    combine = jnp.sum(jax.nn.one_hot(top_idx, N_EXPERTS, dtype=jnp.float32) * w[..., None], axis=-2)
    y = jnp.zeros_like(h)
    for e in range(N_EXPERTS):
        y = y + combine[..., e:e + 1].astype(h.dtype) * _swiglu(h, wg[e], wu[e], wd[e])
    return y


def setup_inputs(seed: int = 0) -> dict:
    key = jax.random.key(seed)
    ks = jax.random.split(key, 18)

    def nrm(k, shape, scale):
        return jax.random.normal(k, shape, jnp.float32) * scale

    def gain(k, shape):
        return 1.0 + 0.01 * jax.random.normal(k, shape, jnp.float32)

    return {
        "x": nrm(ks[0], (BATCH, SEQ, D_MODEL), 1.0),
        "norm_mix_g": gain(ks[1], (DEPTH, D_MODEL)),
        "w_in": nrm(ks[2], (DEPTH, D_MODEL, IN_COLS), D_MODEL ** -0.5),
        "q_norm_g": gain(ks[3], (DEPTH, HEAD_DIM)),
        "k_norm_g": gain(ks[4], (DEPTH, 3, HEAD_DIM)),
        "cmp_pos": nrm(ks[5], (DEPTH, 2, CMP_LEN, HEAD_DIM), 0.02),
        "w_cmp": nrm(ks[6], (DEPTH, 2, CMP_LEN * HEAD_DIM, HEAD_DIM), (CMP_LEN * HEAD_DIM) ** -0.5),
        "ret_norm_g": gain(ks[7], (DEPTH, RET_WIDTH)),
        "w_out": nrm(ks[8], (DEPTH, MIX_WIDTH, D_MODEL), MIX_WIDTH ** -0.5),
        "norm_ffn_g": gain(ks[9], (DEPTH, D_MODEL)),
        "ffn_w_gate": nrm(ks[10], (N_DENSE, D_MODEL, D_FF), D_MODEL ** -0.5),
        "ffn_w_up": nrm(ks[11], (N_DENSE, D_MODEL, D_FF), D_MODEL ** -0.5),
        "ffn_w_down": nrm(ks[12], (N_DENSE, D_FF, D_MODEL), D_FF ** -0.5),
        "moe_router": nrm(ks[13], (N_MOE, D_MODEL, N_EXPERTS), D_MODEL ** -0.5),
        "moe_router_b": nrm(ks[14], (N_MOE, N_EXPERTS), 0.01),
        "moe_w_gate": nrm(ks[15], (N_MOE, N_EXPERTS, D_MODEL, D_FF), D_MODEL ** -0.5),
        "moe_w_up": nrm(ks[16], (N_MOE, N_EXPERTS, D_MODEL, D_FF), D_MODEL ** -0.5),
        "moe_w_down": nrm(ks[17], (N_MOE, N_EXPERTS, D_FF, D_MODEL), D_FF ** -0.5),
    }


def reference(x, norm_mix_g, w_in, q_norm_g, k_norm_g, cmp_pos, w_cmp, ret_norm_g, w_out,
              norm_ffn_g, ffn_w_gate, ffn_w_up, ffn_w_down,
              moe_router, moe_router_b, moe_w_gate, moe_w_up, moe_w_down):
    for l in range(DEPTH):
        h = rms_norm(x, norm_mix_g[l])
        x = x + _mixer(h, w_in[l], q_norm_g[l], k_norm_g[l], cmp_pos[l], w_cmp[l], ret_norm_g[l], w_out[l])
        h = rms_norm(x, norm_ffn_g[l])
        j = l // 2
        if l % 2 == 0:
            x = x + _swiglu(h, ffn_w_gate[j], ffn_w_up[j], ffn_w_down[j])
        else:
            x = x + _moe(h, moe_router[j], moe_router_b[j], moe_w_gate[j], moe_w_up[j], moe_w_down[j])
    return x
```

```cpp
#include <hip/hip_runtime.h>
#include <cstdio>
#include <cstdint>

#ifndef FAST_GEMM
#define FAST_GEMM 1
#endif
#ifndef NSA_FAST
#define NSA_FAST 1
#endif
#ifndef MOE_FP8
#define MOE_FP8 1
#endif
#ifndef DENSE_FP8
#define DENSE_FP8 0
#endif
#ifndef FUSE_NORM
#define FUSE_NORM 0
#endif
#ifndef NSA_LS
#define NSA_LS 0
#endif
#ifndef RET_FAST
#define RET_FAST 1
#endif
#ifndef ONE_LAUNCH
#define ONE_LAUNCH 1
#endif

#define LAS __attribute__((address_space(3)))
typedef unsigned short bf16;
typedef float f32x4 __attribute__((ext_vector_type(4)));
typedef unsigned u32x4 __attribute__((ext_vector_type(4)));
typedef unsigned u32x2 __attribute__((ext_vector_type(2)));
typedef short bf16x8 __attribute__((ext_vector_type(8)));
typedef float f32x16 __attribute__((ext_vector_type(16)));
typedef int v8i __attribute__((ext_vector_type(8)));
typedef int v4i __attribute__((ext_vector_type(4)));

constexpr int NB = 4, T = 8192, D = 1024, M = NB * T;
constexpr int PC = 2816;
constexpr int NIN = 3072;
constexpr int INC = 2840;
constexpr int FF = 2816, NE = 8;
constexpr int C_Q = 0, C_KC = 512, C_VC = 640, C_KS = 768, C_VS = 896, C_KW = 1024, C_VW = 1152, C_RQ = 1280, C_RK = 1536, C_RV = 1792, C_RG = 2304;
constexpr int NCB = 512;
constexpr float EPS = 1e-6f;
constexpr float LOG2E = 1.4426950408889634f;
constexpr int NTHR = 512, NWAVES = 8;
constexpr int HROWS = M + NE * 256;

constexpr size_t MiB = 1u << 20;
constexpr size_t WS_CTL = 0, CTL_BYTES = 1 * MiB;
constexpr size_t WS_WIN = 2 * MiB;
constexpr size_t WS_WOUT = 14 * MiB;
constexpr size_t WS_WGU = 18 * MiB;
constexpr size_t WS_WDN = 29 * MiB;
constexpr size_t WS_MGU = 35 * MiB;
constexpr size_t WS_MDN = (MOE_FP8 && FAST_GEMM ? 79 : 123) * MiB;
constexpr size_t WS_X2 = 102 * MiB;
static_assert(!FUSE_NORM || (MOE_FP8 && FAST_GEMM && !DENSE_FP8), "FUSE_NORM uses workspace freed by MOE_FP8 and the bf16 dense FFN");
static_assert(!FUSE_NORM || (WS_X2 >= WS_MDN + (size_t)8 * FF * D && WS_X2 + (size_t)M * D * 2 <= 168 * MiB), "X2 region");
constexpr size_t WS_HN = 168 * MiB;
constexpr size_t WS_PROJ = 232 * MiB;
constexpr size_t WS_GATES = 420 * MiB;
constexpr size_t WS_KCMP = 423 * MiB;
constexpr size_t WS_VCMP = WS_KCMP + 512 * 1024;
constexpr size_t WS_RETS = 424 * MiB;
constexpr size_t WS_RTOK = 440 * MiB;
constexpr size_t WS_RWT = 442 * MiB;
constexpr size_t WS_KS = 444 * MiB;
constexpr size_t WS_KW = 452 * MiB;
constexpr size_t WS_VST = 460 * MiB;
constexpr size_t WS_VWT = 468 * MiB;
constexpr size_t WS_VCT = 476 * MiB;
constexpr size_t WS_WCT = 477 * MiB;
constexpr size_t WS_RST = 478 * MiB;
constexpr size_t WS_KCF = 486 * MiB;
constexpr size_t WS_ROWP = 487 * MiB;
constexpr size_t WS_END = 491 * MiB;
static_assert(WS_PROJ + (size_t)HROWS * FF * 2 <= WS_GATES, "hidden overlay fits");
constexpr int CW_BAR = 4096;
constexpr int CW_CNT = 16384;
constexpr int CW_ROWSS = 32768;
constexpr int CW_CBIAS = 196608;

constexpr int LDS_BYTES = 155648;
constexpr int MISC_OFF = 131072;
constexpr int SELM_OFF = 131072 + 1024;
constexpr int TOKL_OFF = 131072 + 2048;
constexpr int TOKL_MAXU = 14;
constexpr int NVOFF_OFF = 147456;

__device__ __forceinline__ unsigned f2bf(float f) { unsigned u = __builtin_bit_cast(unsigned, f); return (u + 0x7fffu + ((u >> 16) & 1u)) >> 16; }
typedef float f32x2_t __attribute__((ext_vector_type(2)));
typedef __bf16 bf16x2_t __attribute__((ext_vector_type(2)));
__device__ __forceinline__ unsigned pk2(float lo, float hi) { const f32x2_t v = {lo, hi}; const bf16x2_t b = __builtin_convertvector(v, bf16x2_t); return __builtin_bit_cast(unsigned, b); }
__device__ __forceinline__ float bflo(unsigned u) { return __builtin_bit_cast(float, u << 16); }
__device__ __forceinline__ float bfhi(unsigned u) { return __builtin_bit_cast(float, u & 0xffff0000u); }
__device__ __forceinline__ float bf2f(bf16 h) { return __builtin_bit_cast(float, (unsigned)h << 16); }
__device__ __forceinline__ float wave_sum(float v) {
#pragma unroll
    for (int o = 1; o < 64; o <<= 1) v += __shfl_xor(v, o);
    return v;
}
__device__ __forceinline__ unsigned pk4_fp8(float a, float b, float c, float d) {
    a = __builtin_amdgcn_fmed3f(a, -448.f, 448.f); b = __builtin_amdgcn_fmed3f(b, -448.f, 448.f); c = __builtin_amdgcn_fmed3f(c, -448.f, 448.f); d = __builtin_amdgcn_fmed3f(d, -448.f, 448.f);
    int w = 0; w = __builtin_amdgcn_cvt_pk_fp8_f32(a, b, w, false); w = __builtin_amdgcn_cvt_pk_fp8_f32(c, d, w, true); return (unsigned)w;
}
constexpr float F8_SA = 16.f, F8_SW = 256.f, F8_SH = 8.f;
#define LDS_WAIT() asm volatile("s_waitcnt lgkmcnt(0)" ::: "memory")
__device__ __forceinline__ float fsigmoid(float x) { return __builtin_amdgcn_rcpf(1.f + __builtin_amdgcn_exp2f(x * -1.4426950408889634f)); }
__device__ __forceinline__ float fsilu(float x) { return x * fsigmoid(x); }
__device__ __forceinline__ int lane_id() { int l; asm volatile("v_mbcnt_lo_u32_b32 %0, -1, 0\n\tv_mbcnt_hi_u32_b32 %0, -1, %0" : "=v"(l)); return l; }

#define XB_TMO      128
#define XB_XCNT(j)  (256  + 64 * (j))
#define XB_XSUB(j)  (1280 + 64 * (j))
#define XB_XGEN(j)  (2304 + 64 * (j))
#define XB_TOP      3328
#define XB_TOPGEN   3392
#define XCD_BAR_WORDS 3456
#define XB_SPIN_CAP (1u << 18)
__device__ __forceinline__ unsigned xb_ld(unsigned* p)              { return __hip_atomic_load(p, __ATOMIC_RELAXED, __HIP_MEMORY_SCOPE_AGENT); }
__device__ __forceinline__ unsigned xb_add(unsigned* p, unsigned v) { return __hip_atomic_fetch_add(p, v, __ATOMIC_RELAXED, __HIP_MEMORY_SCOPE_AGENT); }
__device__ __forceinline__ unsigned xb_xcc_id() { return (unsigned)__builtin_amdgcn_s_getreg((3 << 11) | 20) & 0xFu; }
#define XB_SPIN(cond, bar) do { unsigned _sp = 0; while (cond) { __builtin_amdgcn_s_sleep(1); \
    if ((++_sp & 255u) == 0u) { if (xb_ld(&(bar)[XB_TMO])) break; if (_sp > XB_SPIN_CAP) { atomicAdd(&(bar)[XB_TMO], 1u); break; } } } } while (0)
struct XcdBarrier { unsigned* bar; unsigned x; volatile LAS unsigned* st; int wave; };
__device__ __forceinline__ XcdBarrier xcd_barrier_post(unsigned* bar, volatile LAS unsigned* st, int wave) {
    XcdBarrier b; b.bar = bar; b.x = xb_xcc_id(); b.st = st; b.wave = wave;
    if (wave == 0 && lane_id() == 0) (void)xb_add(&bar[XB_XCNT(b.x)], 1u);
    return b;
}
__device__ __forceinline__ void xcd_barrier_complete(unsigned* bar, unsigned x, unsigned& nloc, unsigned& nx) {
    const unsigned G = gridDim.x * gridDim.y * gridDim.z;
    unsigned sum, cnt, mine, sp = 0u;
    for (;;) {
        sum = 0u; cnt = 0u; mine = 0u;
#pragma unroll
        for (unsigned j = 0; j < 16; ++j) { const unsigned c = xb_ld(&bar[XB_XCNT(j)]); sum += c; cnt += (c > 0u) ? 1u : 0u; mine = (j == x) ? c : mine; }
        if (sum == G) break;
        __builtin_amdgcn_s_sleep(1);
        if ((++sp & 255u) == 0u) { if (xb_ld(&bar[XB_TMO])) break; if (sp > XB_SPIN_CAP) { atomicAdd(&bar[XB_TMO], 1u); break; } }
    }
    nloc = mine > 0u ? mine : 1u; nx = cnt > 0u ? cnt : 1u;
}
__device__ __forceinline__ void xcd_barrier(const XcdBarrier& b) {
    asm volatile("s_waitcnt vmcnt(0)" ::: "memory");
    __syncthreads();
    if (b.wave == 0 && lane_id() == 0) {
        unsigned* bar = b.bar;
        __builtin_amdgcn_s_waitcnt(0);
        unsigned nloc = b.st[0], nx = b.st[1];
        if (nloc == 0u) { xcd_barrier_complete(bar, b.x, nloc, nx); b.st[0] = nloc; b.st[1] = nx; }
        const unsigned old = xb_add(&bar[XB_XSUB(b.x)], 1u);
        const unsigned gen = old / nloc;
        if (old + 1u == (gen + 1u) * nloc) {
            __builtin_amdgcn_fence(__ATOMIC_RELEASE, "agent");
            asm volatile("s_waitcnt vmcnt(0)" ::: "memory");
            const unsigned og = xb_add(&bar[XB_TOP], 1u);
            const unsigned tg = og / nx;
            if (og + 1u == (tg + 1u) * nx) xb_add(&bar[XB_TOPGEN], 1u);
            else XB_SPIN(xb_ld(&bar[XB_TOPGEN]) == tg, bar);
            __builtin_amdgcn_fence(__ATOMIC_ACQUIRE, "agent");
            xb_add(&bar[XB_XGEN(b.x)], 1u);
            asm volatile("s_waitcnt vmcnt(0)" ::: "memory");
        } else {
            XB_SPIN(xb_ld(&bar[XB_XGEN(b.x)]) == gen, bar);
            __builtin_amdgcn_fence(__ATOMIC_ACQUIRE, "agent");
            asm volatile("s_waitcnt vmcnt(0)" ::: "memory");
        }
    }
    __syncthreads();
}

struct Args {
    const float* in[18];
    float* out;
    unsigned char* ws;
    int ph_lo, ph_hi;
};

__device__ __forceinline__ void tr_item(const float* __restrict__ src, int ld, int k0, int c0, int nvalid, bf16* dst, int Kd, float* scr, int lane) {
#pragma unroll 8
    for (int i = 0; i < 32; ++i) { const int kk = 2 * i + (lane >> 5), n = lane & 31; scr[kk * 33 + n] = (n < nvalid) ? src[(size_t)(k0 + kk) * ld + c0 + n] : 0.f; }
    LDS_WAIT();
    const int c = lane & 7;
#pragma unroll
    for (int j = 0; j < 4; ++j) { const int n = (lane >> 3) + 8 * j; const float* s = scr + (8 * c) * 33 + n;
        u32x4 o; o.x = pk2(s[0 * 33], s[1 * 33]); o.y = pk2(s[2 * 33], s[3 * 33]); o.z = pk2(s[4 * 33], s[5 * 33]); o.w = pk2(s[6 * 33], s[7 * 33]);
        *(u32x4*)(dst + (size_t)n * Kd + k0 + 8 * c) = o; }
    LDS_WAIT();
}
__device__ __forceinline__ void tr_item8(const float* __restrict__ src, int ld, int k0, int c0, unsigned char* dst, int Kd, float* scr, int lane) {
#pragma unroll 8
    for (int i = 0; i < 32; ++i) { const int kk = 2 * i + (lane >> 5), n = lane & 31; scr[kk * 33 + n] = src[(size_t)(k0 + kk) * ld + c0 + n] * F8_SW; }
    LDS_WAIT();
    const int c = lane & 7;
#pragma unroll
    for (int j = 0; j < 4; ++j) { const int n = (lane >> 3) + 8 * j; const float* sp = scr + (8 * c) * 33 + n;
        u32x2 o; o.x = pk4_fp8(sp[0 * 33], sp[1 * 33], sp[2 * 33], sp[3 * 33]); o.y = pk4_fp8(sp[4 * 33], sp[5 * 33], sp[6 * 33], sp[7 * 33]);
        *(u32x2*)(dst + (size_t)n * Kd + k0 + 8 * c) = o; }
    LDS_WAIT();
}
__device__ __forceinline__ void conv_phase(const Args& a, unsigned char* lds, int gw, int NGW, int wave, int lane) {
    float* scr = (float*)lds + wave * (64 * 33);
    unsigned char* ws = a.ws;
    constexpr int I_IN = (NIN / 32) * (D / 64);
    constexpr int I_OUT = (D / 32) * (D / 64);
    constexpr int I_GU = (2 * FF / 32) * (D / 64);
    constexpr int I_DN = (D / 32) * (FF / 64);
    constexpr int I_CMP = 2 * 32;
    constexpr int NITEMS = 2 * I_IN + 2 * I_OUT + I_GU + I_DN + NE * (I_GU + I_DN) + 4 * I_CMP;
    for (int it0 = gw; it0 < NITEMS; it0 += NGW) {
        int it = it0;
        if (it < 2 * I_IN) { const int l = it / I_IN, r = it % I_IN, nb = r % (NIN / 32), kb = r / (NIN / 32), n0 = 32 * nb;
            int c0, nv; if (n0 < 1280) { c0 = n0; nv = 32; } else if (n0 < 2816) { c0 = n0 + 24; nv = 32; } else if (n0 == 2816) { c0 = 1280; nv = 24; } else { c0 = 0; nv = 0; }
            tr_item(a.in[2] + (size_t)l * D * INC, INC, 64 * kb, c0, nv, (bf16*)(ws + WS_WIN) + ((size_t)l * NIN + n0) * D, D, scr, lane); continue; }
        it -= 2 * I_IN;
        if (it < 2 * I_OUT) { const int l = it / I_OUT, r = it % I_OUT, nb = r % (D / 32), kb = r / (D / 32), n0 = 32 * nb;
            tr_item(a.in[8] + (size_t)l * D * D, D, 64 * kb, n0, 32, (bf16*)(ws + WS_WOUT) + ((size_t)l * D + n0) * D, D, scr, lane); continue; }
        it -= 2 * I_OUT;
        if (it < I_GU) { const int nb = it % (2 * FF / 32), kb = it / (2 * FF / 32), n0 = 32 * nb, p = n0 >> 8, c = n0 & 255;
#if DENSE_FP8
            tr_item8(c < 128 ? a.in[10] : a.in[11], FF, 64 * kb, 128 * p + (c & 127), (unsigned char*)(ws + WS_WGU) + (size_t)n0 * D, D, scr, lane); continue; }
#else
            tr_item(c < 128 ? a.in[10] : a.in[11], FF, 64 * kb, 128 * p + (c & 127), 32, (bf16*)(ws + WS_WGU) + (size_t)n0 * D, D, scr, lane); continue; }
#endif
        it -= I_GU;
        if (it < I_DN) { const int nb = it % (D / 32), kb = it / (D / 32), n0 = 32 * nb;
#if DENSE_FP8
            tr_item8(a.in[12], D, 64 * kb, n0, (unsigned char*)(ws + WS_WDN) + (size_t)n0 * FF, FF, scr, lane); continue; }
#else
            tr_item(a.in[12], D, 64 * kb, n0, 32, (bf16*)(ws + WS_WDN) + (size_t)n0 * FF, FF, scr, lane); continue; }
#endif
        it -= I_DN;
        if (it < NE * I_GU) { const int e = it / I_GU, r = it % I_GU, nb = r % (2 * FF / 32), kb = r / (2 * FF / 32), n0 = 32 * nb, p = n0 >> 8, c = n0 & 255;
#if MOE_FP8
            tr_item8((c < 128 ? a.in[15] : a.in[16]) + (size_t)e * D * FF, FF, 64 * kb, 128 * p + (c & 127), (unsigned char*)(ws + WS_MGU) + ((size_t)e * 2 * FF + n0) * D, D, scr, lane); continue; }
#else
            tr_item((c < 128 ? a.in[15] : a.in[16]) + (size_t)e * D * FF, FF, 64 * kb, 128 * p + (c & 127), 32, (bf16*)(ws + WS_MGU) + ((size_t)e * 2 * FF + n0) * D, D, scr, lane); continue; }
#endif
        it -= NE * I_GU;
        if (it >= NE * I_DN) { it -= NE * I_DN; const int lw = it / I_CMP, r = it % I_CMP, nb = r & 1, kb = r >> 1;
            tr_item(a.in[6] + (size_t)lw * 2048 * 64, 64, 64 * kb, 32 * nb, 32, (bf16*)(ws + WS_WCT) + ((size_t)lw * 64 + 32 * nb) * 2048, 2048, scr, lane); continue; }
        { const int e = it / I_DN, r = it % I_DN, nb = r % (D / 32), kb = r / (D / 32), n0 = 32 * nb;
#if MOE_FP8
            tr_item8(a.in[17] + (size_t)e * FF * D, D, 64 * kb, n0, (unsigned char*)(ws + WS_MDN) + ((size_t)e * D + n0) * FF, FF, scr, lane); }
#else
            tr_item(a.in[17] + (size_t)e * FF * D, D, 64 * kb, n0, 32, (bf16*)(ws + WS_MDN) + ((size_t)e * D + n0) * FF, FF, scr, lane); }
#endif
    }
}

template <bool ROUTE, bool OUT8 = false>
__device__ __forceinline__ void norm_phase(const Args& a, unsigned char* lds, const float* x, const float* g, bf16* out, int blk, int G, int wave, int lane, int tid) {
    const int RPB = M / G;
    int* r_e = (int*)lds;
    float* r_w = (float*)(lds + 8192);
    const float* router = a.in[13]; const float* rb = a.in[14];
    f32x4 gv[4];
#pragma unroll
    for (int j = 0; j < 4; ++j) gv[j] = ((const f32x4*)g)[64 * j + lane];
    f32x4 vn[4];
    { const f32x4* xr0 = (const f32x4*)(x + (size_t)(blk * RPB + wave) * D) + lane;
#pragma unroll
        for (int j = 0; j < 4; ++j) vn[j] = xr0[64 * j]; }
    for (int rl = wave; rl < RPB; rl += NWAVES) {
        const int m = blk * RPB + rl;
        f32x4 v[4]; float ss = 0.f;
#pragma unroll
        for (int j = 0; j < 4; ++j) v[j] = vn[j];
        if (rl + NWAVES < RPB) { const f32x4* xr1 = (const f32x4*)(x + (size_t)(m + NWAVES) * D) + lane;
#pragma unroll
            for (int j = 0; j < 4; ++j) vn[j] = xr1[64 * j]; }
#pragma unroll
        for (int j = 0; j < 4; ++j) ss += (v[j].x * v[j].x + v[j].y * v[j].y) + (v[j].z * v[j].z + v[j].w * v[j].w);
        const float rstd = 1.0f / sqrtf(wave_sum(ss) * (1.f / D) + EPS);
        if (OUT8) {
            unsigned* o4 = (unsigned*)((unsigned char*)out + (size_t)m * D) + lane;
#pragma unroll
            for (int j = 0; j < 4; ++j) { v[j] = v[j] * rstd * gv[j]; o4[64 * j] = pk4_fp8(v[j].x * F8_SA, v[j].y * F8_SA, v[j].z * F8_SA, v[j].w * F8_SA); }
        } else {
        u32x2* o8 = (u32x2*)(out + (size_t)m * D) + lane;
#pragma unroll
        for (int j = 0; j < 4; ++j) { v[j] = v[j] * rstd * gv[j]; u32x2 w; w.x = pk2(v[j].x, v[j].y); w.y = pk2(v[j].z, v[j].w); o8[64 * j] = w; }
        }
        if (ROUTE) {
            float lg[8];
#pragma unroll
            for (int e = 0; e < 8; ++e) lg[e] = 0.f;
#pragma unroll
            for (int j = 0; j < 4; ++j) {
#pragma unroll
                for (int i = 0; i < 4; ++i) { const int k = 4 * (64 * j + lane) + i; const f32x4 r0 = *(const f32x4*)(router + (size_t)k * 8), r1 = *(const f32x4*)(router + (size_t)k * 8 + 4); const float xv = v[j][i];
                    lg[0] += xv * r0.x; lg[1] += xv * r0.y; lg[2] += xv * r0.z; lg[3] += xv * r0.w; lg[4] += xv * r1.x; lg[5] += xv * r1.y; lg[6] += xv * r1.z; lg[7] += xv * r1.w; }
            }
#pragma unroll
            for (int e = 0; e < 8; ++e) lg[e] = wave_sum(lg[e]) + rb[e];
            int i0 = 0; float v0 = lg[0];
#pragma unroll
            for (int e = 1; e < 8; ++e) if (lg[e] > v0) { v0 = lg[e]; i0 = e; }
            int i1 = -1; float v1 = -3.0e38f;
#pragma unroll
            for (int e = 0; e < 8; ++e) if (e != i0 && lg[e] > v1) { v1 = lg[e]; i1 = e; }
            const float w1 = 1.f / (1.f + __expf(v0 - v1)), w0 = 1.f - w1;
            if (lane == 0) { r_e[2 * rl] = i0; r_e[2 * rl + 1] = i1; r_w[2 * rl] = w0; r_w[2 * rl + 1] = w1; }
        }
    }
    if (ROUTE) {
        __syncthreads();
        if (tid < 16) {
            const int s = tid >> 3, e = tid & 7; int n = 0;
            for (int rl = 0; rl < RPB; ++rl) n += (r_e[2 * rl + s] == e) ? 1 : 0;
            int* cnt = (int*)(a.ws + WS_CTL) + CW_CNT;
            int base = n ? atomicAdd(&cnt[s * 8 + e], n) : 0;
            int* tok = (int*)(a.ws + WS_RTOK) + (size_t)(s * 8 + e) * M; float* wt = (float*)(a.ws + WS_RWT) + (size_t)(s * 8 + e) * M;
            for (int rl = 0; rl < RPB; ++rl) if (r_e[2 * rl + s] == e) { tok[base] = blk * RPB + rl; wt[base] = r_w[2 * rl + s]; ++base; }
        }
        __syncthreads();
    }
}

__device__ __forceinline__ void post_phase(const Args& a, unsigned char* lds, int l, int blk, int G, int wave, int lane, int tid) {
    bf16* proj = (bf16*)(a.ws + WS_PROJ);
    const int gw = blk * NWAVES + wave, NGW = G * NWAVES;
    {
        const float* qg = a.in[3] + l * 64; const float* kg = a.in[4] + l * 192;
        const int sub = lane & 7;
        for (int v0 = gw * 8; v0 < M * 12; v0 += NGW * 8) {
            const int vec = v0 + (lane >> 3), m = vec / 12, j = vec % 12;
            int col; const float* gp; float sc = 1.f;
            if (j < 8) { col = C_Q + 64 * j; gp = qg; sc = 0.125f * LOG2E; } else if (j < 10) { col = C_KS + 64 * (j - 8); gp = kg + 64; } else { col = C_KW + 64 * (j - 10); gp = kg + 128; }
            u32x4* p = (u32x4*)(proj + (size_t)m * PC + col + 8 * sub);
            const u32x4 u = *p;
            float f[8] = {bflo(u.x), bfhi(u.x), bflo(u.y), bfhi(u.y), bflo(u.z), bfhi(u.z), bflo(u.w), bfhi(u.w)};
            float ss = 0.f;
#pragma unroll
            for (int i = 0; i < 8; ++i) ss += f[i] * f[i];
            ss += __shfl_xor(ss, 1); ss += __shfl_xor(ss, 2); ss += __shfl_xor(ss, 4);
            const float rs = sc / sqrtf(ss * (1.f / 64.f) + EPS);
            const f32x4 g0 = *(const f32x4*)(gp + 8 * sub), g1 = *(const f32x4*)(gp + 8 * sub + 4);
            u32x4 o; o.x = pk2(f[0] * rs * g0.x, f[1] * rs * g0.y); o.y = pk2(f[2] * rs * g0.z, f[3] * rs * g0.w); o.z = pk2(f[4] * rs * g1.x, f[5] * rs * g1.y); o.w = pk2(f[6] * rs * g1.z, f[7] * rs * g1.w);
            *p = o;
            if (j >= 8) { const int gg = (j - 8) & 1, bb = m / T, tt = m % T, kk = tt & 31, nn = (kk & 0x13) | ((kk & 4) << 1) | ((kk & 8) >> 1);
                *(u32x4*)((bf16*)(a.ws + (j < 10 ? WS_KS : WS_KW)) + (size_t)(bb * 2 + gg) * T * 64 + ((size_t)((tt >> 5) * 4 + (sub >> 1)) * 64 + (sub & 1) * 32 + nn) * 8) = o; }
        }
    }
    {
        const int dim = tid & 63, tq = tid >> 6;
        for (int u = blk; u < 2 * NB * 2 * 128; u += G) {
            const int which = u >> 10, b = (u >> 8) & 3, g = (u >> 7) & 1, ch = u & 127;
            const bf16* src = proj + ((size_t)b * T + ch * 64 + 8 * tq) * PC + (which ? C_VW : C_VS) + 64 * g + dim;
            unsigned short v[8];
#pragma unroll
            for (int i = 0; i < 8; ++i) v[i] = src[(size_t)i * PC];
            u32x4 o; o.x = v[0] | ((unsigned)v[1] << 16); o.y = v[2] | ((unsigned)v[3] << 16); o.z = v[4] | ((unsigned)v[5] << 16); o.w = v[6] | ((unsigned)v[7] << 16);
            { const int t8 = ch * 64 + 8 * tq, tile = t8 >> 5, ko = t8 & 31;
                *(u32x4*)((bf16*)(a.ws + (which ? WS_VWT : WS_VST)) + (size_t)(b * 2 + g) * 64 * T + ((size_t)((tile * 2 + (ko >> 4)) * 2 + (dim >> 5)) * 64 + ((ko >> 3) & 1) * 32 + (dim & 31)) * 8) = o; }
        }
    }
    {
        const float* kg0 = a.in[4] + l * 192;
        const float* cbias = (const float*)(a.ws + WS_CTL) + CW_CBIAS + l * 128;
        float* red = (float*)lds;
        const int n = lane & 31, h = lane >> 5;
        for (int u = blk; u < 2 * NB * 2 * 16; u += G) {
            const int which = u >> 7, b = (u >> 5) & 3, g = (u >> 4) & 1, rt = u & 15;
            const bf16* arow = proj + ((size_t)b * T + 16 * (32 * rt + n) + 4 * wave) * PC + (which ? C_VC : C_KC) + g * 64 + 8 * h;
            const bf16* wt = (const bf16*)(a.ws + WS_WCT) + ((size_t)(l * 2 + which) * 64 + n) * 2048 + 256 * wave + 8 * h;
            f32x16 acc0, acc1;
#pragma unroll
            for (int i = 0; i < 16; ++i) { acc0[i] = 0.f; acc1[i] = 0.f; }
#pragma unroll
            for (int ks = 0; ks < 16; ++ks) {
                const bf16x8 af = *(const bf16x8*)(arow + (size_t)(ks >> 2) * PC + 16 * (ks & 3));
                const bf16x8 b0 = *(const bf16x8*)(wt + 16 * ks), b1 = *(const bf16x8*)(wt + 32 * 2048 + 16 * ks);
                acc0 = __builtin_amdgcn_mfma_f32_32x32x16_bf16(af, b0, acc0, 0, 0, 0); acc1 = __builtin_amdgcn_mfma_f32_32x32x16_bf16(af, b1, acc1, 0, 0, 0);
            }
            __syncthreads();
#pragma unroll
            for (int i = 0; i < 16; ++i) { const int row = 8 * (i >> 2) + 4 * h + (i & 3); red[(wave * 32 + row) * 64 + n] = acc0[i]; red[(wave * 32 + row) * 64 + 32 + n] = acc1[i]; }
            __syncthreads();
            { const int row = tid >> 4, n4 = (tid & 15) * 4, c = 32 * rt + row;
                f32x4 sum = *(const f32x4*)(cbias + which * 64 + n4);
#pragma unroll
                for (int w = 0; w < 8; ++w) sum = sum + *(const f32x4*)(red + (w * 32 + row) * 64 + n4);
                if (which == 0) { float ss = sum.x * sum.x + sum.y * sum.y + sum.z * sum.z + sum.w * sum.w;
                    ss += __shfl_xor(ss, 1); ss += __shfl_xor(ss, 2); ss += __shfl_xor(ss, 4); ss += __shfl_xor(ss, 8);
                    const float rs = 1.f / sqrtf(ss * (1.f / 64.f) + EPS); const f32x4 gg = *(const f32x4*)(kg0 + n4); sum = sum * rs * gg; }
                if (c >= 511) sum = (f32x4){0.f, 0.f, 0.f, 0.f};
                u32x2 o; o.x = pk2(sum.x, sum.y); o.y = pk2(sum.z, sum.w);
                *(u32x2*)((bf16*)(a.ws + (which ? WS_VCMP : WS_KCMP)) + ((size_t)(b * 2 + g) * NCB + c) * 64 + n4) = o;
                const int ko = c & 31;
                if (which) {
                    bf16* dT = (bf16*)(a.ws + WS_VCT) + (size_t)(b * 2 + g) * 64 * NCB + ((size_t)(((c >> 5) * 2 + (ko >> 4)) * 2 + (n4 >> 5)) * 64 + ((ko >> 3) & 1) * 32 + (n4 & 31)) * 8 + (ko & 7);
                    dT[0] = (bf16)(o.x & 0xffffu); dT[8] = (bf16)(o.x >> 16); dT[16] = (bf16)(o.y & 0xffffu); dT[24] = (bf16)(o.y >> 16);
                } else {
                    const int nn = (ko & 0x13) | ((ko & 4) << 1) | ((ko & 8) >> 1);
                    *(u32x2*)((bf16*)(a.ws + WS_KCF) + (size_t)(b * 2 + g) * NCB * 64 + ((size_t)((c >> 5) * 4 + (n4 >> 4)) * 64 + ((n4 >> 3) & 1) * 32 + nn) * 8 + (n4 & 7)) = o; } }
        }
        __syncthreads();
    }
    {
        float* rets = (float*)(a.ws + WS_RETS);
        float* Ksf = (float*)lds;
        float* Vsf = Ksf + 128 * 32;
        const int d = tid >> 4, e4 = (tid & 15) * 4;
        for (int u = blk; u < NB * 8 * 64; u += G) {
            const int b = u >> 9, h = (u >> 6) & 7, c = u & 63;
            const float lg2 = log2f(1.f - exp2f(-5.f - (float)h));
            const bf16* base = proj + ((size_t)b * T + c * 128) * PC;
            __syncthreads();
            { const int row = tid >> 2, pc = tid & 3; const u32x4 uk = *(const u32x4*)(base + (size_t)row * PC + C_RK + 32 * h + 8 * pc); const float z = exp2f((float)(127 - row) * lg2);
                *(f32x4*)(Ksf + row * 32 + 8 * pc) = (f32x4){bflo(uk.x) * z, bfhi(uk.x) * z, bflo(uk.y) * z, bfhi(uk.y) * z};
                *(f32x4*)(Ksf + row * 32 + 8 * pc + 4) = (f32x4){bflo(uk.z) * z, bfhi(uk.z) * z, bflo(uk.w) * z, bfhi(uk.w) * z}; }
#pragma unroll
            for (int it = 0; it < 2; ++it) { const int idx = tid + NTHR * it, row = idx >> 3, pc = idx & 7; const u32x4 uv = *(const u32x4*)(base + (size_t)row * PC + C_RV + 64 * h + 8 * pc);
                *(f32x4*)(Vsf + row * 64 + 8 * pc) = (f32x4){bflo(uv.x), bfhi(uv.x), bflo(uv.y), bfhi(uv.y)};
                *(f32x4*)(Vsf + row * 64 + 8 * pc + 4) = (f32x4){bflo(uv.z), bfhi(uv.z), bflo(uv.w), bfhi(uv.w)}; }
            __syncthreads();
            f32x4 acc = (f32x4){0.f, 0.f, 0.f, 0.f};
#pragma unroll 8
            for (int j = 0; j < 128; ++j) { const float kz = Ksf[j * 32 + d]; acc = acc + *(const f32x4*)(Vsf + j * 64 + e4) * kz; }
            *(f32x4*)(rets + ((size_t)(b * 8 + h) * 64 + c) * 2048 + d * 64 + e4) = acc;
        }
        __syncthreads();
    }
}

__device__ __forceinline__ void scan_phase(const Args& a, int blk, int G, int tid) {
    float* rets = (float*)(a.ws + WS_RETS);
    if (tid < 256) {
        const int i = blk * 256 + tid;
        if (i < 32 * 2048) {
            const int bh = i >> 11, idx = i & 2047, h = bh & 7;
            const float gc = exp2f(128.f * log2f(1.f - exp2f(-5.f - (float)h)));
            float* p = rets + (size_t)bh * 64 * 2048 + idx;
            bf16* st = (bf16*)(a.ws + WS_RST) + (size_t)bh * 64 * 2048 + (idx & 63) * 32 + (idx >> 6);
            float tv[64];
#pragma unroll
            for (int c = 0; c < 64; ++c) tv[c] = p[(size_t)c * 2048];
            float S = 0.f;
#pragma unroll
            for (int c = 0; c < 64; ++c) { p[(size_t)c * 2048] = S; st[(size_t)c * 2048] = (bf16)f2bf(S); S = S * gc + tv[c]; }
        }
    }
}

__device__ __forceinline__ float dot32(const float (&q)[32], const bf16* kp) {
    const u32x4* p = (const u32x4*)kp; float s = 0.f;
#pragma unroll
    for (int i = 0; i < 4; ++i) { const u32x4 u = p[i];
        s += q[8 * i + 0] * bflo(u.x) + q[8 * i + 1] * bfhi(u.x) + q[8 * i + 2] * bflo(u.y) + q[8 * i + 3] * bfhi(u.y) + q[8 * i + 4] * bflo(u.z) + q[8 * i + 5] * bfhi(u.z) + q[8 * i + 6] * bflo(u.w) + q[8 * i + 7] * bfhi(u.w); }
    return s;
}
__device__ __forceinline__ float dot16(const float (&q)[16], const bf16* kp) {
    const u32x4* p = (const u32x4*)kp; float s = 0.f;
#pragma unroll
    for (int i = 0; i < 2; ++i) { const u32x4 u = p[i];
        s += q[8 * i + 0] * bflo(u.x) + q[8 * i + 1] * bfhi(u.x) + q[8 * i + 2] * bflo(u.y) + q[8 * i + 3] * bfhi(u.y) + q[8 * i + 4] * bflo(u.z) + q[8 * i + 5] * bfhi(u.z) + q[8 * i + 6] * bflo(u.w) + q[8 * i + 7] * bfhi(u.w); }
    return s;
}
__device__ __forceinline__ void axpy16(float (&o)[16], float p, const bf16* vp) {
    const u32x4* q = (const u32x4*)vp;
#pragma unroll
    for (int i = 0; i < 2; ++i) { const u32x4 u = q[i];
        o[8 * i + 0] += p * bflo(u.x); o[8 * i + 1] += p * bfhi(u.x); o[8 * i + 2] += p * bflo(u.y); o[8 * i + 3] += p * bfhi(u.y); o[8 * i + 4] += p * bflo(u.z); o[8 * i + 5] += p * bfhi(u.z); o[8 * i + 6] += p * bflo(u.w); o[8 * i + 7] += p * bfhi(u.w); }
}
__device__ __forceinline__ void nsa_phase(const Args& a, unsigned char* lds, int blk, int G, int tid) {
    const bf16* proj = (const bf16*)(a.ws + WS_PROJ);
    const float* gates = (const float*)(a.ws + WS_GATES);
    bf16* mix = (bf16*)(a.ws + WS_HN);
    float* impH = (float*)lds;
    unsigned* selm = (unsigned*)(lds + SELM_OFF);
    const int tl = tid >> 4, r = (tid >> 2) & 3, qt = tid & 3;
    for (int u = blk; u < NB * 2 * 256; u += G) {
        const int b = u >> 9, g = (u >> 8) & 1, tb = u & 255, cur = tb >> 1;
        const int hq = 4 * g + r, t = 32 * tb + tl; const size_t m = (size_t)b * T + t;
        const float slope = exp2f(-(float)(hq + 1)) * LOG2E;
        float q[16], res[16], o[16];
        { const u32x4* p = (const u32x4*)(proj + m * PC + C_Q + 64 * hq + 16 * qt);
#pragma unroll
            for (int i = 0; i < 2; ++i) { const u32x4 uu = p[i]; q[8 * i] = bflo(uu.x); q[8 * i + 1] = bfhi(uu.x); q[8 * i + 2] = bflo(uu.y); q[8 * i + 3] = bfhi(uu.y); q[8 * i + 4] = bflo(uu.z); q[8 * i + 5] = bfhi(uu.z); q[8 * i + 6] = bflo(uu.w); q[8 * i + 7] = bfhi(uu.w); } }
#pragma unroll
        for (int i = 0; i < 16; ++i) res[i] = 0.f;
        const float g0 = gates[m * 24 + 3 * hq], g1 = gates[m * 24 + 3 * hq + 1], g2 = gates[m * 24 + 3 * hq + 2];
        float* myimp = impH + (tl * 4 + r) * 128;
        for (int s = 32 * qt; s < 32 * qt + 32; ++s) myimp[s] = 0.f;
        if (tid < 128) selm[tid] = 0u;
        __syncthreads();
        const int ncv = t >= 31 ? ((t - 31) >> 4) + 1 : 0;
        const bf16* kc = (const bf16*)(a.ws + WS_KCMP) + (size_t)(b * 2 + g) * NCB * 64 + 16 * qt;
        const bf16* vc = (const bf16*)(a.ws + WS_VCMP) + (size_t)(b * 2 + g) * NCB * 64 + 16 * qt;
        float mx = -1e30f, lsum = 0.f;
        for (int c = 0; c < ncv; ++c) {
            float s = dot16(q, kc + c * 64); s += __shfl_xor(s, 1); s += __shfl_xor(s, 2); s -= slope * (float)(t - 16 * c - 31);
            const float mn = fmaxf(mx, s); lsum = lsum * exp2f(mx - mn) + exp2f(s - mn); mx = mn;
        }
        const float il = 1.f / lsum;
        for (int c = 0; c < ncv; ++c) {
            float s = dot16(q, kc + c * 64); s += __shfl_xor(s, 1); s += __shfl_xor(s, 2); s -= slope * (float)(t - 16 * c - 31);
            const float p = exp2f(s - mx) * il;
            axpy16(res, g0 * p, vc + c * 64);
            if (qt == 0) { const int sb = c >> 2; if ((c & 3) == 3) { myimp[sb] += 0.5f * p; if (sb + 1 < 128) myimp[sb + 1] += 0.5f * p; } else myimp[sb] += p; }
        }
        __syncthreads();
        for (int idx = tid; idx < 32 * 128; idx += NTHR) {
            const int tl2 = idx >> 7, s = idx & 127; float* p = impH + tl2 * 512 + s;
            const float v = (p[0] + p[128]) + (p[256] + p[384]);
            const bool forced = (s == 0) || (s == cur) || (s == cur - 1), valid = s <= cur;
            p[0] = forced ? 1e9f : (valid ? v : -1e9f);
        }
        __syncthreads();
        { const int k16 = tid & 15; const float* val = impH + tl * 512; unsigned bits = 0u;
#pragma unroll 1
            for (int ii = 0; ii < 8; ++ii) { const int i = 8 * k16 + ii; const float vi = val[i]; int rank = 0;
#pragma unroll 4
                for (int j = 0; j < 128; ++j) { const float vj = val[j]; rank += ((vj > vi) || (vj == vi && j < i)) ? 1 : 0; }
                if (rank < 16 && i <= cur) bits |= 1u << ii; }
            atomicOr(&selm[tl * 4 + (k16 >> 2)], bits << (8 * (k16 & 3))); }
        __syncthreads();
        {
            const bf16* kb = proj + (size_t)b * T * PC + C_KS + 64 * g + 16 * qt; const bf16* vb = proj + (size_t)b * T * PC + C_VS + 64 * g + 16 * qt;
            mx = -1e30f; lsum = 0.f;
#pragma unroll
            for (int i = 0; i < 16; ++i) o[i] = 0.f;
            for (int w = 0; w < 4; ++w) { unsigned word = selm[tl * 4 + w];
                while (word) { const int bit = __ffs(word) - 1; word &= word - 1u; const int sblk = 32 * w + bit;
                    const int pend = min(64 * sblk + 63, t);
                    for (int pos = 64 * sblk; pos <= pend; ++pos) {
                        float s = dot16(q, kb + (size_t)pos * PC); s += __shfl_xor(s, 1); s += __shfl_xor(s, 2); s -= slope * (float)(t - pos);
                        const float mn = fmaxf(mx, s), cr = exp2f(mx - mn), p = exp2f(s - mn); lsum = lsum * cr + p; mx = mn;
#pragma unroll
                        for (int i = 0; i < 16; ++i) o[i] *= cr;
                        axpy16(o, p, vb + (size_t)pos * PC);
                    } } }
            const float sc = g1 / lsum;
#pragma unroll
            for (int i = 0; i < 16; ++i) res[i] += sc * o[i];
        }
        {
            const bf16* kb = proj + (size_t)b * T * PC + C_KW + 64 * g + 16 * qt; const bf16* vb = proj + (size_t)b * T * PC + C_VW + 64 * g + 16 * qt;
            mx = -1e30f; lsum = 0.f;
#pragma unroll
            for (int i = 0; i < 16; ++i) o[i] = 0.f;
            for (int pos = max(0, t - 511); pos <= t; ++pos) {
                float s = dot16(q, kb + (size_t)pos * PC); s += __shfl_xor(s, 1); s += __shfl_xor(s, 2); s -= slope * (float)(t - pos);
                const float mn = fmaxf(mx, s), cr = exp2f(mx - mn), p = exp2f(s - mn); lsum = lsum * cr + p; mx = mn;
#pragma unroll
                for (int i = 0; i < 16; ++i) o[i] *= cr;
                axpy16(o, p, vb + (size_t)pos * PC);
            }
            const float sc = g2 / lsum;
#pragma unroll
            for (int i = 0; i < 16; ++i) res[i] += sc * o[i];
        }
        { u32x4* op = (u32x4*)(mix + m * D + 64 * hq + 16 * qt);
#pragma unroll
            for (int i = 0; i < 2; ++i) { u32x4 w; w.x = pk2(res[8 * i], res[8 * i + 1]); w.y = pk2(res[8 * i + 2], res[8 * i + 3]); w.z = pk2(res[8 * i + 4], res[8 * i + 5]); w.w = pk2(res[8 * i + 6], res[8 * i + 7]); op[i] = w; } }
        __syncthreads();
    }
}
#define MFMA32(a, b, c) __builtin_amdgcn_mfma_f32_32x32x16_bf16(a, b, c, 0, 0, 0)
constexpr float NSA_NEG = -1e30f;
__device__ __forceinline__ float ex2(float x) { return __builtin_amdgcn_exp2f(x); }
typedef __amdgpu_buffer_rsrc_t brsrc_t;
__device__ __forceinline__ brsrc_t nsa_rsrc(const bf16* base, int nbytes) { return __builtin_amdgcn_make_buffer_rsrc((void*)base, (short)0, nbytes, 0x00020000); }
__device__ __forceinline__ void nsa_ldk(bf16x8 (&kf)[4], brsrc_t rs, int tile, unsigned voff) {
#pragma unroll
    for (int ks = 0; ks < 4; ++ks) kf[ks] = __builtin_bit_cast(bf16x8, __builtin_amdgcn_raw_buffer_load_b128(rs, voff + 1024u * ks, tile * 4096, 0));
}
__device__ __forceinline__ void nsa_ldv(bf16x8 (&vf)[4], brsrc_t rs, int tile, unsigned voff) {
#pragma unroll
    for (int q = 0; q < 4; ++q) vf[q] = __builtin_bit_cast(bf16x8, __builtin_amdgcn_raw_buffer_load_b128(rs, voff + 1024u * q, tile * 4096, 0));
}
__device__ __forceinline__ void nsa_qk(const bf16x8 (&kf)[4], const bf16x8 (&qf)[4], const bf16x8& kaug, unsigned slpk, float c, f32x16& u) {
    f32x16 acc;
#pragma unroll
    for (int i = 0; i < 16; ++i) acc[i] = 0.f;
    const unsigned hp = pk2(c, c); const float hif = bflo(hp);
    u32x4 w; w.x = slpk; w.y = pk2(hif, c - hif); w.z = 0u; w.w = 0u;
    acc = MFMA32(kaug, __builtin_bit_cast(bf16x8, w), acc);
#pragma unroll
    for (int ks = 0; ks < 4; ++ks) acc = MFMA32(kf[ks], qf[ks], acc);
    u = acc;
}
__device__ __forceinline__ void nsa_qk2(const bf16x8 (&kA)[4], const bf16x8 (&kB)[4], const bf16x8 (&qf)[4], const bf16x8& kaug, unsigned slpk, float cA, float cB, f32x16& uA, f32x16& uB) {
    f32x16 a0, a1;
#pragma unroll
    for (int i = 0; i < 16; ++i) { a0[i] = 0.f; a1[i] = 0.f; }
    u32x4 wA, wB;
    { const unsigned hp = pk2(cA, cA); const float hif = bflo(hp); wA.x = slpk; wA.y = pk2(hif, cA - hif); wA.z = 0u; wA.w = 0u; }
    { const unsigned hp = pk2(cB, cB); const float hif = bflo(hp); wB.x = slpk; wB.y = pk2(hif, cB - hif); wB.z = 0u; wB.w = 0u; }
    a0 = MFMA32(kaug, __builtin_bit_cast(bf16x8, wA), a0); a1 = MFMA32(kaug, __builtin_bit_cast(bf16x8, wB), a1);
#pragma unroll
    for (int ks = 0; ks < 4; ++ks) { a0 = MFMA32(kA[ks], qf[ks], a0); a1 = MFMA32(kB[ks], qf[ks], a1); }
    uA = a0; uB = a1;
}
__device__ __forceinline__ void nsa_mask(f32x16& u, int kminp, int kmaxp) {
#pragma unroll
    for (int i = 0; i < 16; ++i) { const int c = 16 * (i >> 3) + (i & 7); u[i] = (c >= kminp && c <= kmaxp) ? u[i] : NSA_NEG; }
}
__device__ __forceinline__ bf16x8 nsa_pack8(const f32x16& p, int j) {
    u32x4 w; w.x = pk2(p[8 * j], p[8 * j + 1]); w.y = pk2(p[8 * j + 2], p[8 * j + 3]); w.z = pk2(p[8 * j + 4], p[8 * j + 5]); w.w = pk2(p[8 * j + 6], p[8 * j + 7]);
    return __builtin_bit_cast(bf16x8, w);
}
__device__ __forceinline__ void nsa_pv(const bf16x8 (&vf)[4], const f32x16& p, f32x16 (&O)[2]) {
#pragma unroll
    for (int j = 0; j < 2; ++j) { const bf16x8 pb = nsa_pack8(p, j);
#pragma unroll
        for (int dt = 0; dt < 2; ++dt) O[dt] = MFMA32(vf[2 * j + dt], pb, O[dt]); }
}
__device__ __forceinline__ void nsa_expv(const f32x16& u, f32x16& p, float& lpart, f32x16 (&O)[2], const bf16x8 (&vf)[4]) {
    float lt = 0.f;
#pragma unroll
    for (int i = 0; i < 8; ++i) { p[i] = ex2(u[i]); lt += p[i]; }
    { const bf16x8 pb = nsa_pack8(p, 0); O[0] = MFMA32(vf[0], pb, O[0]); O[1] = MFMA32(vf[1], pb, O[1]); }
    __builtin_amdgcn_sched_barrier(0);
#pragma unroll
    for (int i = 8; i < 16; ++i) { p[i] = ex2(u[i]); lt += p[i]; }
    { const bf16x8 pb = nsa_pack8(p, 1); O[0] = MFMA32(vf[2], pb, O[0]); O[1] = MFMA32(vf[3], pb, O[1]); }
    lpart += lt;
}
struct SlcIt { unsigned w[4]; int sblk, half; };
__device__ __forceinline__ int slc_next(SlcIt& it, int tmax) {
    if (it.half == 1) { it.half = 0; return 64 * it.sblk; }
    int wi = it.w[3] ? 3 : it.w[2] ? 2 : it.w[1] ? 1 : it.w[0] ? 0 : -1;
    if (wi < 0) return -1;
    const unsigned word = wi == 3 ? it.w[3] : wi == 2 ? it.w[2] : wi == 1 ? it.w[1] : it.w[0];
    const int bit = 31 - __builtin_clz(word); const unsigned nw = word & ~(1u << bit);
    if (wi == 3) it.w[3] = nw; else if (wi == 2) it.w[2] = nw; else if (wi == 1) it.w[1] = nw; else it.w[0] = nw;
    it.sblk = 32 * wi + bit;
    if (64 * it.sblk + 32 <= tmax) { it.half = 1; return 64 * it.sblk + 32; }
    it.half = 0; return 64 * it.sblk;
}
__device__ __forceinline__ float dpp_xor1(float x) { return __builtin_bit_cast(float, __builtin_amdgcn_update_dpp(0, __builtin_bit_cast(int, x), 0xB1, 0xf, 0xf, true)); }
__device__ __forceinline__ float dpp_xor2(float x) { return __builtin_bit_cast(float, __builtin_amdgcn_update_dpp(0, __builtin_bit_cast(int, x), 0x4E, 0xf, 0xf, true)); }
__device__ __forceinline__ void nsa_res(float* resL, unsigned voff, const f32x16 (&O)[2], float sc, bool first) {
#pragma unroll
    for (int q = 0; q < 8; ++q) { f32x4* p = (f32x4*)((char*)resL + q * 1024 + voff);
        const f32x4 o = (f32x4){O[q >> 2][4 * (q & 3)], O[q >> 2][4 * (q & 3) + 1], O[q >> 2][4 * (q & 3) + 2], O[q >> 2][4 * (q & 3) + 3]} * sc;
        *p = first ? o : (*p + o);
        if (q & 1) asm volatile("" ::: "memory"); }
}
__device__ __forceinline__ bf16x8 nsa_kaug(unsigned kapk, int h) { u32x4 w; w.x = kapk; w.y = h ? 0u : 0x3f803f80u; w.z = 0u; w.w = 0u; return __builtin_bit_cast(bf16x8, w); }
__device__ __forceinline__ void nsa_fast_phase(const Args& a, unsigned char* lds, int l, int blk, int G, int wave) {
    const bf16* proj = (const bf16*)(a.ws + WS_PROJ);
    const float* gates = (const float*)(a.ws + WS_GATES);
    bf16* mix = (bf16*)(a.ws + WS_HN);
    const int lane = lane_id(), n = lane & 31, h = lane >> 5, tq = n >> 2, r = n & 3;
    const int krow = (n & 0x13) | ((n & 4) << 1) | ((n & 8) >> 1);
    const unsigned voff = (unsigned)lane * 16u;
    float* imp = (float*)lds + wave * (8 * 128);
    float* resL = (float*)(lds + 32768) + wave * 2048;
    unsigned* selw = (unsigned*)(lds + SELM_OFF) + wave * 32;
    const unsigned kapk = h ? 0u : pk2((float)krow, (float)krow);
#define kaug nsa_kaug(kapk, h)
    float gmax; { const float* kg = a.in[4] + l * 192; gmax = fmaxf(fmaxf(fabsf(kg[lane]), fabsf(kg[64 + lane])), fabsf(kg[128 + lane]));
#pragma unroll
        for (int o = 1; o < 64; o <<= 1) gmax = fmaxf(gmax, __shfl_xor(gmax, o));
        gmax = __builtin_bit_cast(float, __builtin_amdgcn_readfirstlane(__builtin_bit_cast(int, gmax))); }
    for (int u = blk; u < NB * 2 * 128; u += G) {
        const int b = u >> 8, g = (u >> 7) & 1, tb = ((u & 127) + 32 * (u >> 8)) & 127;
        const int hq = 4 * g + r, t0 = 64 * tb + 8 * wave, t = t0 + tq;
#define m ((size_t)b * T + t)
        const float sl2 = ex2(-(float)(hq + 1)) * LOG2E;
        bf16x8 qf[4];
#pragma unroll
        for (int ks = 0; ks < 4; ++ks) qf[ks] = *(const bf16x8*)(proj + m * PC + C_Q + 64 * hq + 16 * ks + 8 * h);
        float Ccol; { float qq = 0.f;
#pragma unroll
            for (int ks = 0; ks < 4; ++ks) { const u32x4 w = __builtin_bit_cast(u32x4, qf[ks]);
                qq += bflo(w.x) * bflo(w.x) + bfhi(w.x) * bfhi(w.x) + bflo(w.y) * bflo(w.y) + bfhi(w.y) * bfhi(w.y) + bflo(w.z) * bflo(w.z) + bfhi(w.z) * bfhi(w.z) + bflo(w.w) * bflo(w.w) + bfhi(w.w) * bfhi(w.w); }
            qq += __shfl_xor(qq, 32); Ccol = sqrtf(qq) * 8.f * gmax; }
        unsigned slpk1, slpk16; { const unsigned hp = pk2(sl2, sl2); const float hif = bflo(hp); slpk1 = pk2(hif, sl2 - hif); const float s16 = 16.f * sl2; const unsigned hq2 = pk2(s16, s16); const float h2 = bflo(hq2); slpk16 = pk2(h2, s16 - h2); }
        f32x16 O[2];
#pragma unroll
        for (int i = 0; i < 16; ++i) imp[lane + 64 * i] = 0.f;
        if (lane < 32) selw[lane] = 0u;
        bf16x8 kA[4], kB[4], vA[4], vB[4];
        {
            const brsrc_t KC = nsa_rsrc((const bf16*)(a.ws + WS_KCF) + (size_t)(b * 2 + g) * NCB * 64, NCB * 64 * 2);
            const brsrc_t VCT = nsa_rsrc((const bf16*)(a.ws + WS_VCT) + (size_t)(b * 2 + g) * 64 * NCB, NCB * 64 * 2);
            const int ncv = t >= 31 ? ((t - 31) >> 4) + 1 : 0;
            const int tmax = t0 + 7, ncvmax = tmax >= 31 ? ((tmax - 31) >> 4) + 1 : 0, nct = (ncvmax + 31) >> 5;
            const float c0 = sl2 * (float)(31 - t) - Ccol, c1 = sl2 * 512.f;
            float lp = 0.f;
#define CMP_A(KF, TI) do { f32x16 uu; nsa_qk(KF, qf, kaug, slpk16, c0 + (float)(TI) * c1, uu); \
                if ((TI) == nct - 1) nsa_mask(uu, -1000, ncv - 1 - 32 * (TI) - 8 * h); \
                float lt = 0.f; _Pragma("unroll") for (int i = 0; i < 16; ++i) lt += ex2(uu[i]); lp += lt; } while (0)
            if (nct > 0) nsa_ldk(kA, KC, 0, voff);
            for (int ti = 0; ti < nct; ti += 2) {
                if (ti + 1 < nct) nsa_ldk(kB, KC, ti + 1, voff);
                CMP_A(kA, ti);
                if (ti + 1 >= nct) break;
                if (ti + 2 < nct) nsa_ldk(kA, KC, ti + 2, voff);
                CMP_A(kB, ti + 1);
            }
#undef CMP_A
            lp += __shfl_xor(lp, 32);
            const float cB = ncv > 0 ? c0 - __builtin_amdgcn_logf(lp) : -30000.f;
#pragma unroll
            for (int i = 0; i < 16; ++i) { O[0][i] = 0.f; O[1][i] = 0.f; }
            float dummy = 0.f;
#define CMP_B(KF, VF, TI) do { f32x16 uu; nsa_qk(KF, qf, kaug, slpk16, cB + (float)(TI) * c1, uu); \
                if ((TI) == nct - 1) nsa_mask(uu, -1000, ncv - 1 - 32 * (TI) - 8 * h); \
                f32x16 p; nsa_expv(uu, p, dummy, O, VF); \
                float av[4], bv[4]; \
                _Pragma("unroll") for (int q4 = 0; q4 < 4; ++q4) { const int i0 = 4 * q4; av[q4] = (p[i0] + p[i0 + 1]) + (p[i0 + 2] + 0.5f * p[i0 + 3]); bv[q4] = 0.5f * p[i0 + 3]; } \
                _Pragma("unroll") for (int q4 = 0; q4 < 4; ++q4) { av[q4] += dpp_xor1(av[q4]); av[q4] += dpp_xor2(av[q4]); bv[q4] += dpp_xor1(bv[q4]); bv[q4] += dpp_xor2(bv[q4]); } \
                const float am = r == 0 ? av[0] : r == 1 ? av[1] : r == 2 ? av[2] : av[3], bm = r == 0 ? bv[0] : r == 1 ? bv[1] : r == 2 ? bv[2] : bv[3]; \
                const int sb = 8 * (TI) + 4 * (r >> 1) + 2 * h + (r & 1); \
                atomicAdd(&imp[tq * 128 + sb], am); \
                if (sb + 1 < 128) atomicAdd(&imp[tq * 128 + sb + 1], bm); } while (0)
            if (nct > 0) { nsa_ldk(kA, KC, 0, voff); nsa_ldv(vA, VCT, 0, voff); }
            for (int ti = 0; ti < nct; ti += 2) {
                if (ti + 1 < nct) { nsa_ldk(kB, KC, ti + 1, voff); nsa_ldv(vB, VCT, ti + 1, voff); }
                CMP_B(kA, vA, ti);
                if (ti + 1 >= nct) break;
                if (ti + 2 < nct) { nsa_ldk(kA, KC, ti + 2, voff); nsa_ldv(vA, VCT, ti + 2, voff); }
                CMP_B(kB, vB, ti + 1);
            }
#undef CMP_B
            nsa_res(resL, voff, O, gates[m * 24 + 3 * hq], true);
        }
        {
            const int l2 = lane_id(), tk = l2 >> 3, k8 = l2 & 7, cur = tb;
            float v[16];
#pragma unroll
            for (int k4 = 0; k4 < 4; ++k4) { const f32x4 x = *(const f32x4*)(imp + tk * 128 + 16 * k8 + 4 * k4); v[4 * k4] = x.x; v[4 * k4 + 1] = x.y; v[4 * k4 + 2] = x.z; v[4 * k4 + 3] = x.w; }
#pragma unroll
            for (int k = 0; k < 16; ++k) { const int s2 = 16 * k8 + k; const bool forced = (s2 == 0) || (s2 == cur) || (s2 == cur - 1), valid = s2 <= cur; v[k] = forced ? 1e9f : (valid ? v[k] : -1e9f); }
            unsigned bits = 0u;
#pragma unroll 1
            for (int it = 0; it < 16; ++it) {
                float bvv = v[0]; int bi = 0;
#pragma unroll
                for (int k = 1; k < 16; ++k) if (v[k] > bvv) { bvv = v[k]; bi = k; }
                bi += 16 * k8;
#define TK_STEP(CTRL) do { const float ov = __builtin_bit_cast(float, __builtin_amdgcn_update_dpp(0, __builtin_bit_cast(int, bvv), CTRL, 0xf, 0xf, true)); const int oi = __builtin_amdgcn_update_dpp(0, bi, CTRL, 0xf, 0xf, true); \
                    if (ov > bvv || (ov == bvv && oi < bi)) { bvv = ov; bi = oi; } } while (0)
                TK_STEP(0xB1); TK_STEP(0x4E); TK_STEP(0x141);
#undef TK_STEP
#pragma unroll
                for (int k = 0; k < 16; ++k) if (bi == 16 * k8 + k) { v[k] = -3e38f; if (16 * k8 + k <= cur) bits |= 1u << k; }
            }
            atomicOr(&selw[tk * 4 + (k8 >> 1)], bits << (16 * (k8 & 1)));
        }
        {
            const brsrc_t KS = nsa_rsrc((const bf16*)(a.ws + WS_KS) + (size_t)(b * 2 + g) * T * 64, T * 64 * 2);
            const brsrc_t VST = nsa_rsrc((const bf16*)(a.ws + WS_VST) + (size_t)(b * 2 + g) * 64 * T, T * 64 * 2);
            float lp = 0.f;
#pragma unroll
            for (int i = 0; i < 16; ++i) { O[0][i] = 0.f; O[1][i] = 0.f; }
            SlcIt it; it.half = 0; it.sblk = 0;
#pragma unroll
            for (int w = 0; w < 4; ++w) { unsigned uw = selw[(lane & 7) * 4 + w]; uw |= __shfl_xor(uw, 1); uw |= __shfl_xor(uw, 2); uw |= __shfl_xor(uw, 4); it.w[w] = (unsigned)__builtin_amdgcn_readfirstlane((int)uw); }
            const float cS = -sl2 * (float)t - Ccol;
#define SLC_C(PP, SB) (((selw[tq * 4 + ((SB) >> 5)] >> ((SB) & 31)) & 1u) ? cS + sl2 * (float)(PP) : -30000.f)
#define SLC_M(UU, PP) do { if ((PP) + 31 > t0) nsa_mask(UU, -1000, t - (PP) - 8 * h); } while (0)
            int P0 = slc_next(it, t0 + 7), sb0 = it.sblk;
            int P1 = P0 >= 0 ? slc_next(it, t0 + 7) : -1, sb1 = it.sblk;
            if (P0 >= 0) { nsa_ldk(kA, KS, P0 >> 5, voff); nsa_ldv(vA, VST, P0 >> 5, voff); }
            if (P1 >= 0) { nsa_ldk(kB, KS, P1 >> 5, voff); nsa_ldv(vB, VST, P1 >> 5, voff); }
            while (P0 >= 0) {
                const int P2 = P1 >= 0 ? slc_next(it, t0 + 7) : -1, sb2 = it.sblk;
                const int P3 = P2 >= 0 ? slc_next(it, t0 + 7) : -1, sb3 = it.sblk;
                f32x16 uA, uB, p;
                if (P1 >= 0) {
                    nsa_qk2(kA, kB, qf, kaug, slpk1, SLC_C(P0, sb0), SLC_C(P1, sb1), uA, uB);
                    if (P2 >= 0) nsa_ldk(kA, KS, P2 >> 5, voff);
                    if (P3 >= 0) nsa_ldk(kB, KS, P3 >> 5, voff);
                    SLC_M(uA, P0); SLC_M(uB, P1);
                    nsa_expv(uA, p, lp, O, vA);
                    if (P2 >= 0) nsa_ldv(vA, VST, P2 >> 5, voff);
                    nsa_expv(uB, p, lp, O, vB);
                    if (P3 >= 0) nsa_ldv(vB, VST, P3 >> 5, voff);
                } else {
                    nsa_qk(kA, qf, kaug, slpk1, SLC_C(P0, sb0), uA);
                    SLC_M(uA, P0);
                    nsa_expv(uA, p, lp, O, vA);
                }
                P0 = P2; sb0 = sb2; P1 = P3; sb1 = sb3;
            }
#undef SLC_C
#undef SLC_M
#define SLC_T(KF, VF, PP, SB)
#undef SLC_T
            lp += __shfl_xor(lp, 32);
            nsa_res(resL, voff, O, gates[m * 24 + 3 * hq + 1] * __builtin_amdgcn_rcpf(lp), false);
        }
        {
            const brsrc_t KW = nsa_rsrc((const bf16*)(a.ws + WS_KW) + (size_t)(b * 2 + g) * T * 64, T * 64 * 2);
            const brsrc_t VWT = nsa_rsrc((const bf16*)(a.ws + WS_VWT) + (size_t)(b * 2 + g) * 64 * T, T * 64 * 2);
            float lp = 0.f;
#pragma unroll
            for (int i = 0; i < 16; ++i) { O[0][i] = 0.f; O[1][i] = 0.f; }
            const int thi = (t0 + 7) >> 5, tlo = (t0 - 511) > 0 ? ((t0 - 511) >> 5) : 0;
            const float cS = -sl2 * (float)t - Ccol;
#define WIN_M(UU, PP) do { if ((PP) + 31 > t0 || (PP) < t0 + 7 - 511) nsa_mask(UU, t - 511 - (PP) - 8 * h, t - (PP) - 8 * h); } while (0)
            nsa_ldk(kA, KW, thi, voff); nsa_ldv(vA, VWT, thi, voff);
            if (thi - 1 >= tlo) { nsa_ldk(kB, KW, thi - 1, voff); nsa_ldv(vB, VWT, thi - 1, voff); }
#pragma unroll 1
            for (int ti = thi; ti >= tlo; ti -= 2) {
                f32x16 uA, uB, p;
                if (ti - 1 >= tlo) {
                    nsa_qk2(kA, kB, qf, kaug, slpk1, cS + sl2 * (float)(32 * ti), cS + sl2 * (float)(32 * ti - 32), uA, uB);
                    if (ti - 2 >= tlo) nsa_ldk(kA, KW, ti - 2, voff);
                    if (ti - 3 >= tlo) nsa_ldk(kB, KW, ti - 3, voff);
                    WIN_M(uA, 32 * ti); WIN_M(uB, 32 * ti - 32);
                    nsa_expv(uA, p, lp, O, vA);
                    if (ti - 2 >= tlo) nsa_ldv(vA, VWT, ti - 2, voff);
                    nsa_expv(uB, p, lp, O, vB);
                    if (ti - 3 >= tlo) nsa_ldv(vB, VWT, ti - 3, voff);
                } else {
                    nsa_qk(kA, qf, kaug, slpk1, cS + sl2 * (float)(32 * ti), uA);
                    WIN_M(uA, 32 * ti);
                    nsa_expv(uA, p, lp, O, vA);
                }
            }
#undef WIN_M
#define WIN_T(KF, VF, TI)
#undef WIN_T
            lp += __shfl_xor(lp, 32);
            nsa_res(resL, voff, O, gates[m * 24 + 3 * hq + 2] * __builtin_amdgcn_rcpf(lp), false);
        }
        { const int l3 = lane_id(), n3 = l3 & 31, h3 = l3 >> 5; const size_t m3 = (size_t)b * T + t0 + (n3 >> 2); const int hq3 = 4 * g + (n3 & 3);
#pragma unroll
            for (int q = 0; q < 8; ++q) { const f32x4 o = *(const f32x4*)(resL + (q * 64 + l3) * 4); u32x2 w; w.x = pk2(o.x, o.y); w.y = pk2(o.z, o.w);
                *(u32x2*)(mix + m3 * D + 64 * hq3 + 32 * (q >> 2) + 8 * (q & 3) + 4 * h3) = w; } }
    }
}
#undef kaug
#undef m

constexpr int NSA_RING_OFF = 98304, NSA_SLOT = 8192;
#define NSA_VMW(n) asm volatile("s_waitcnt vmcnt(" #n ")" ::: "memory")
__device__ __forceinline__ void nsa_dma(LAS unsigned char* ring, int slot, const bf16* Kb, const bf16* Vb, int tile, int wave, unsigned voff) {
    const char* src = (const char*)(wave < 4 ? Kb : Vb) + (size_t)tile * 4096 + (wave & 3) * 1024 + voff;
    __builtin_amdgcn_global_load_lds((const unsigned*)src, (LAS unsigned*)(ring + slot * NSA_SLOT + wave * 1024), 16, 0, 0);
}
__device__ __forceinline__ void nsa_frag(LAS unsigned char* ring, int slot, unsigned voff, bf16x8 (&kf)[4], bf16x8 (&vf)[4]) {
#pragma unroll
    for (int q = 0; q < 4; ++q) { kf[q] = *(const LAS bf16x8*)(ring + slot * NSA_SLOT + q * 1024 + voff); vf[q] = *(const LAS bf16x8*)(ring + slot * NSA_SLOT + 4096 + q * 1024 + voff); }
}
__device__ __forceinline__ void nsa_ls_phase(const Args& a, unsigned char* lds, int l, int blk, int G, int wave) {
    const bf16* proj = (const bf16*)(a.ws + WS_PROJ);
    const float* gates = (const float*)(a.ws + WS_GATES);
    bf16* mix = (bf16*)(a.ws + WS_HN);
    const int lane = lane_id(), n = lane & 31, h = lane >> 5, tq = n >> 2, r = n & 3;
    const int krow = (n & 0x13) | ((n & 4) << 1) | ((n & 8) >> 1);
    const unsigned voff = (unsigned)lane * 16u;
    float* imp = (float*)lds + wave * (8 * 128);
    float* resL = (float*)(lds + 32768) + wave * 2048;
    unsigned* selw = (unsigned*)(lds + SELM_OFF) + wave * 32;
    volatile unsigned* ubw = (volatile unsigned*)(lds + SELM_OFF + 1024);
    LAS unsigned char* ring = (LAS unsigned char*)lds + NSA_RING_OFF;
    const unsigned kapk = h ? 0u : pk2((float)krow, (float)krow);
#define kaug nsa_kaug(kapk, h)
    float gmax; { const float* kg = a.in[4] + l * 192; gmax = fmaxf(fmaxf(fabsf(kg[lane]), fabsf(kg[64 + lane])), fabsf(kg[128 + lane]));
#pragma unroll
        for (int o = 1; o < 64; o <<= 1) gmax = fmaxf(gmax, __shfl_xor(gmax, o));
        gmax = __builtin_bit_cast(float, __builtin_amdgcn_readfirstlane(__builtin_bit_cast(int, gmax))); }
    for (int u = blk; u < NB * 2 * 128; u += G) {
        const int b = u >> 8, g = (u >> 7) & 1, tb = ((u & 127) + 32 * (u >> 8)) & 127;
        const int hq = 4 * g + r, t0 = 64 * tb + 8 * wave, t = t0 + tq, tmaxB = 64 * tb + 63;
#define m ((size_t)b * T + t)
        const float sl2 = ex2(-(float)(hq + 1)) * LOG2E;
        bf16x8 qf[4];
#pragma unroll
        for (int ks = 0; ks < 4; ++ks) qf[ks] = *(const bf16x8*)(proj + m * PC + C_Q + 64 * hq + 16 * ks + 8 * h);
        float Ccol; { float qq = 0.f;
#pragma unroll
            for (int ks = 0; ks < 4; ++ks) { const u32x4 w = __builtin_bit_cast(u32x4, qf[ks]);
                qq += bflo(w.x) * bflo(w.x) + bfhi(w.x) * bfhi(w.x) + bflo(w.y) * bflo(w.y) + bfhi(w.y) * bfhi(w.y) + bflo(w.z) * bflo(w.z) + bfhi(w.z) * bfhi(w.z) + bflo(w.w) * bflo(w.w) + bfhi(w.w) * bfhi(w.w); }
            qq += __shfl_xor(qq, 32); Ccol = sqrtf(qq) * 8.f * gmax; }
        unsigned slpk1, slpk16; { const unsigned hp = pk2(sl2, sl2); const float hif = bflo(hp); slpk1 = pk2(hif, sl2 - hif); const float s16 = 16.f * sl2; const unsigned hq2 = pk2(s16, s16); const float h2 = bflo(hq2); slpk16 = pk2(h2, s16 - h2); }
        f32x16 O[2];
#pragma unroll
        for (int i = 0; i < 16; ++i) imp[lane + 64 * i] = 0.f;
        if (lane < 32) selw[lane] = 0u;
        if (wave == 0 && lane < 4) ubw[lane] = 0u;
        bf16x8 kc[4], vf[4];
#define NSA_WALK(KB, VB, NEXT, ...) do { \
            NSA_VMW(0); __builtin_amdgcn_s_barrier(); \
            int tA = NEXT, tB = tA >= 0 ? NEXT : -1, sl = 0; \
            if (tA >= 0) nsa_dma(ring, 0, KB, VB, tA, wave, voff); \
            if (tB >= 0) nsa_dma(ring, 1, KB, VB, tB, wave, voff); \
            while (tA >= 0) { \
                const int tC = tB >= 0 ? NEXT : -1; \
                if (tC >= 0) { nsa_dma(ring, (sl + 2) & 3, KB, VB, tC, wave, voff); NSA_VMW(2); } else if (tB >= 0) NSA_VMW(1); else NSA_VMW(0); \
                __builtin_amdgcn_s_barrier(); \
                { const int tile = tA; __VA_ARGS__ } \
                tA = tB; tB = tC; sl = (sl + 1) & 3; } } while (0)
        {
            const bf16* KC = (const bf16*)(a.ws + WS_KCF) + (size_t)(b * 2 + g) * NCB * 64;
            const bf16* VCT = (const bf16*)(a.ws + WS_VCT) + (size_t)(b * 2 + g) * 64 * NCB;
            const int ncv = t >= 31 ? ((t - 31) >> 4) + 1 : 0;
            const int tmax = t0 + 7, ncvmax = tmax >= 31 ? ((tmax - 31) >> 4) + 1 : 0, nct = (ncvmax + 31) >> 5;
            const int nctB = ((((tmaxB - 31) >> 4) + 1) + 31) >> 5;
            const float c0 = sl2 * (float)(31 - t) - Ccol, c1 = sl2 * 512.f;
            float lp = 0.f; int ci = 0;
            NSA_WALK(KC, VCT, (ci < nctB ? ci++ : -1), {
                if (tile < nct) { nsa_frag(ring, sl, voff, kc, vf);
                    f32x16 uu; nsa_qk(kc, qf, kaug, slpk16, c0 + (float)tile * c1, uu);
                    if (tile == nct - 1) nsa_mask(uu, -1000, ncv - 1 - 32 * tile - 8 * h);
                    float lt = 0.f; _Pragma("unroll") for (int i = 0; i < 16; ++i) lt += ex2(uu[i]); lp += lt; } });
            lp += __shfl_xor(lp, 32);
            const float cB = ncv > 0 ? c0 - __builtin_amdgcn_logf(lp) : -30000.f;
#pragma unroll
            for (int i = 0; i < 16; ++i) { O[0][i] = 0.f; O[1][i] = 0.f; }
            float dummy = 0.f; ci = 0;
            NSA_WALK(KC, VCT, (ci < nctB ? ci++ : -1), {
                if (tile < nct) { nsa_frag(ring, sl, voff, kc, vf);
                    f32x16 uu; nsa_qk(kc, qf, kaug, slpk16, cB + (float)tile * c1, uu);
                    if (tile == nct - 1) nsa_mask(uu, -1000, ncv - 1 - 32 * tile - 8 * h);
                    f32x16 p; nsa_expv(uu, p, dummy, O, vf);
                    float av[4], bv[4];
                    _Pragma("unroll") for (int q4 = 0; q4 < 4; ++q4) { const int i0 = 4 * q4; av[q4] = (p[i0] + p[i0 + 1]) + (p[i0 + 2] + 0.5f * p[i0 + 3]); bv[q4] = 0.5f * p[i0 + 3]; }
                    _Pragma("unroll") for (int q4 = 0; q4 < 4; ++q4) { av[q4] += dpp_xor1(av[q4]); av[q4] += dpp_xor2(av[q4]); bv[q4] += dpp_xor1(bv[q4]); bv[q4] += dpp_xor2(bv[q4]); }
                    const float am = r == 0 ? av[0] : r == 1 ? av[1] : r == 2 ? av[2] : av[3], bm = r == 0 ? bv[0] : r == 1 ? bv[1] : r == 2 ? bv[2] : bv[3];
                    const int sb = 8 * tile + 4 * (r >> 1) + 2 * h + (r & 1);
                    atomicAdd(&imp[tq * 128 + sb], am);
                    if (sb + 1 < 128) atomicAdd(&imp[tq * 128 + sb + 1], bm); } });
            nsa_res(resL, voff, O, gates[m * 24 + 3 * hq], true);
        }
        {
            const int l2 = lane_id(), tk = l2 >> 3, k8 = l2 & 7, cur = tb;
            float v[16];
#pragma unroll
            for (int k4 = 0; k4 < 4; ++k4) { const f32x4 x = *(const f32x4*)(imp + tk * 128 + 16 * k8 + 4 * k4); v[4 * k4] = x.x; v[4 * k4 + 1] = x.y; v[4 * k4 + 2] = x.z; v[4 * k4 + 3] = x.w; }
#pragma unroll
            for (int k = 0; k < 16; ++k) { const int s2 = 16 * k8 + k; const bool forced = (s2 == 0) || (s2 == cur) || (s2 == cur - 1), valid = s2 <= cur; v[k] = forced ? 1e9f : (valid ? v[k] : -1e9f); }
            unsigned bits = 0u;
#pragma unroll 1
            for (int it = 0; it < 16; ++it) {
                float bvv = v[0]; int bi = 0;
#pragma unroll
                for (int k = 1; k < 16; ++k) if (v[k] > bvv) { bvv = v[k]; bi = k; }
                bi += 16 * k8;
#define TK_STEP(CTRL) do { const float ov = __builtin_bit_cast(float, __builtin_amdgcn_update_dpp(0, __builtin_bit_cast(int, bvv), CTRL, 0xf, 0xf, true)); const int oi = __builtin_amdgcn_update_dpp(0, bi, CTRL, 0xf, 0xf, true); \
                    if (ov > bvv || (ov == bvv && oi < bi)) { bvv = ov; bi = oi; } } while (0)
                TK_STEP(0xB1); TK_STEP(0x4E); TK_STEP(0x141);
#undef TK_STEP
#pragma unroll
                for (int k = 0; k < 16; ++k) if (bi == 16 * k8 + k) { v[k] = -3e38f; if (16 * k8 + k <= cur) bits |= 1u << k; }
            }
            atomicOr(&selw[tk * 4 + (k8 >> 1)], bits << (16 * (k8 & 1)));
        }
        {
            const bf16* KS = (const bf16*)(a.ws + WS_KS) + (size_t)(b * 2 + g) * T * 64;
            const bf16* VST = (const bf16*)(a.ws + WS_VST) + (size_t)(b * 2 + g) * 64 * T;
            float lp = 0.f;
#pragma unroll
            for (int i = 0; i < 16; ++i) { O[0][i] = 0.f; O[1][i] = 0.f; }
            unsigned myu[4];
#pragma unroll
            for (int w = 0; w < 4; ++w) { unsigned uw = selw[(lane & 7) * 4 + w]; uw |= __shfl_xor(uw, 1); uw |= __shfl_xor(uw, 2); uw |= __shfl_xor(uw, 4); myu[w] = (unsigned)__builtin_amdgcn_readfirstlane((int)uw); }
            if (lane < 4) atomicOr((unsigned*)&ubw[lane], lane == 0 ? myu[0] : lane == 1 ? myu[1] : lane == 2 ? myu[2] : myu[3]);
            __builtin_amdgcn_s_waitcnt(0xc07f);
            __builtin_amdgcn_s_barrier();
            SlcIt it; it.half = 0; it.sblk = 0;
#pragma unroll
            for (int w = 0; w < 4; ++w) it.w[w] = (unsigned)__builtin_amdgcn_readfirstlane((int)ubw[w]);
            const float cS = -sl2 * (float)t - Ccol;
            NSA_WALK(KS, VST, (slc_next(it, tmaxB) >> 5), {
                const int PP = 32 * tile, sbk = tile >> 1;
                const unsigned wsel = (sbk >> 5) == 0 ? myu[0] : (sbk >> 5) == 1 ? myu[1] : (sbk >> 5) == 2 ? myu[2] : myu[3];
                if (((wsel >> (sbk & 31)) & 1u) && PP <= t0 + 7) { nsa_frag(ring, sl, voff, kc, vf);
                    const bool colsel = (selw[tq * 4 + (sbk >> 5)] >> (sbk & 31)) & 1u;
                    f32x16 uu; nsa_qk(kc, qf, kaug, slpk1, colsel ? cS + sl2 * (float)PP : -30000.f, uu);
                    if (PP + 31 > t0) nsa_mask(uu, -1000, t - PP - 8 * h);
                    f32x16 p; nsa_expv(uu, p, lp, O, vf); } });
            lp += __shfl_xor(lp, 32);
            nsa_res(resL, voff, O, gates[m * 24 + 3 * hq + 1] * __builtin_amdgcn_rcpf(lp), false);
        }
        {
            const bf16* KW = (const bf16*)(a.ws + WS_KW) + (size_t)(b * 2 + g) * T * 64;
            const bf16* VWT = (const bf16*)(a.ws + WS_VWT) + (size_t)(b * 2 + g) * 64 * T;
            float lp = 0.f;
#pragma unroll
            for (int i = 0; i < 16; ++i) { O[0][i] = 0.f; O[1][i] = 0.f; }
            const int thiB = tmaxB >> 5, tloB = (64 * tb - 511) > 0 ? ((64 * tb - 511) >> 5) : 0;
            const float cS = -sl2 * (float)t - Ccol;
            int wi = thiB;
            NSA_WALK(KW, VWT, (wi >= tloB ? wi-- : -1), {
                const int PP = 32 * tile;
                if (PP <= t0 + 7 && PP + 31 >= t0 - 511) { nsa_frag(ring, sl, voff, kc, vf);
                    f32x16 uu; nsa_qk(kc, qf, kaug, slpk1, cS + sl2 * (float)PP, uu);
                    if (PP + 31 > t0 || PP < t0 + 7 - 511) nsa_mask(uu, t - 511 - PP - 8 * h, t - PP - 8 * h);
                    f32x16 p; nsa_expv(uu, p, lp, O, vf); } });
            lp += __shfl_xor(lp, 32);
            nsa_res(resL, voff, O, gates[m * 24 + 3 * hq + 2] * __builtin_amdgcn_rcpf(lp), false);
        }
        { const int l3 = lane_id(), n3 = l3 & 31, h3 = l3 >> 5; const size_t m3 = (size_t)b * T + t0 + (n3 >> 2); const int hq3 = 4 * g + (n3 & 3);
#pragma unroll
            for (int q = 0; q < 8; ++q) { const f32x4 o = *(const f32x4*)(resL + (q * 64 + l3) * 4); u32x2 w; w.x = pk2(o.x, o.y); w.y = pk2(o.z, o.w);
                *(u32x2*)(mix + m3 * D + 64 * hq3 + 32 * (q >> 2) + 8 * (q & 3) + 4 * h3) = w; } }
    }
    NSA_VMW(0); __builtin_amdgcn_s_barrier();
}
#undef kaug
#undef m
#undef NSA_WALK

__device__ __forceinline__ void retout_phase(const Args& a, int l, int blk, int G, int tid) {
    const bf16* proj = (const bf16*)(a.ws + WS_PROJ);
    const float* rets = (const float*)(a.ws + WS_RETS);
    bf16* mix = (bf16*)(a.ws + WS_HN);
    const float* rng = a.in[7] + l * 512;
    const int i = tid >> 2, qd = tid & 3;
    for (int u = blk; u < NB * 8 * 64; u += G) {
        const int b = u >> 9, h = (u >> 6) & 7, c = u & 63;
        const float lg2 = log2f(1.f - exp2f(-5.f - (float)h));
        const bf16* base = proj + ((size_t)b * T + c * 128) * PC;
        float q[32], acc[16];
        { const u32x4* p = (const u32x4*)(base + (size_t)i * PC + C_RQ + 32 * h);
#pragma unroll
            for (int k = 0; k < 4; ++k) { const u32x4 uu = p[k]; q[8 * k] = bflo(uu.x); q[8 * k + 1] = bfhi(uu.x); q[8 * k + 2] = bflo(uu.y); q[8 * k + 3] = bfhi(uu.y); q[8 * k + 4] = bflo(uu.z); q[8 * k + 5] = bfhi(uu.z); q[8 * k + 6] = bflo(uu.w); q[8 * k + 7] = bfhi(uu.w); }
#pragma unroll
            for (int k = 0; k < 32; ++k) q[k] *= 0.17677669529663687f; }
#pragma unroll
        for (int k = 0; k < 16; ++k) acc[k] = 0.f;
        for (int j = 0; j <= i; ++j) {
            const float s = dot32(q, base + (size_t)j * PC + C_RK + 32 * h) * exp2f((float)(i - j) * lg2);
            const u32x4* vp = (const u32x4*)(base + (size_t)j * PC + C_RV + 64 * h + 16 * qd);
#pragma unroll
            for (int k = 0; k < 2; ++k) { const u32x4 uu = vp[k]; acc[8 * k] += s * bflo(uu.x); acc[8 * k + 1] += s * bfhi(uu.x); acc[8 * k + 2] += s * bflo(uu.y); acc[8 * k + 3] += s * bfhi(uu.y); acc[8 * k + 4] += s * bflo(uu.z); acc[8 * k + 5] += s * bfhi(uu.z); acc[8 * k + 6] += s * bflo(uu.w); acc[8 * k + 7] += s * bfhi(uu.w); }
        }
        { const float xi = exp2f((float)(i + 1) * lg2); const float* S = rets + ((size_t)(b * 8 + h) * 64 + c) * 2048 + 16 * qd;
#pragma unroll
            for (int d = 0; d < 32; ++d) { const float qx = q[d] * xi; const f32x4* sp = (const f32x4*)(S + d * 64);
#pragma unroll
                for (int k = 0; k < 4; ++k) { const f32x4 sv = sp[k]; acc[4 * k] += qx * sv.x; acc[4 * k + 1] += qx * sv.y; acc[4 * k + 2] += qx * sv.z; acc[4 * k + 3] += qx * sv.w; } } }
        float ss = 0.f;
#pragma unroll
        for (int k = 0; k < 16; ++k) ss += acc[k] * acc[k];
        ss += __shfl_xor(ss, 1); ss += __shfl_xor(ss, 2);
        const float rs = 1.f / sqrtf(ss * (1.f / 64.f) + EPS);
        const size_t m = (size_t)b * T + c * 128 + i;
        const u32x4* gp = (const u32x4*)(proj + m * PC + C_RG + 64 * h + 16 * qd);
        float y[16];
#pragma unroll
        for (int k = 0; k < 2; ++k) { const u32x4 uu = gp[k]; const float gg[8] = {bflo(uu.x), bfhi(uu.x), bflo(uu.y), bfhi(uu.y), bflo(uu.z), bfhi(uu.z), bflo(uu.w), bfhi(uu.w)};
#pragma unroll
            for (int z = 0; z < 8; ++z) { const float gz = gg[z]; y[8 * k + z] = acc[8 * k + z] * rs * rng[64 * h + 16 * qd + 8 * k + z] * (gz / (1.f + __expf(-gz))); } }
        u32x4* op = (u32x4*)(mix + m * D + 512 + 64 * h + 16 * qd);
#pragma unroll
        for (int k = 0; k < 2; ++k) { u32x4 w; w.x = pk2(y[8 * k], y[8 * k + 1]); w.y = pk2(y[8 * k + 2], y[8 * k + 3]); w.z = pk2(y[8 * k + 4], y[8 * k + 5]); w.w = pk2(y[8 * k + 6], y[8 * k + 7]); op[k] = w; }
    }
}

__device__ __forceinline__ void retout_fast_phase(const Args& a, unsigned char* lds, int l, int blk, int G, int wave) {
    const bf16* proj = (const bf16*)(a.ws + WS_PROJ);
    bf16* mix = (bf16*)(a.ws + WS_HN);
    const float* rng = a.in[7] + l * 512;
    const int lane = lane_id(), n = lane & 31, h = lane >> 5, tid = wave * 64 + lane, qt = wave & 3, dt = wave >> 2;
    const int krow = (n & 0x13) | ((n & 4) << 1) | ((n & 8) >> 1);
    bf16* Qs = (bf16*)lds;
    bf16* Ks = Qs + 128 * 32;
    bf16* VTs = Ks + 128 * 32;
    float* ssq = (float*)(lds + 8192 + 8192 + 64 * 136 * 2);
    for (int u = blk; u < NB * 8 * 64; u += G) {
        const int b = u >> 9, hh = (u >> 6) & 7, c = u & 63;
        const float lg2 = log2f(1.f - exp2f(-5.f - (float)hh));
        const size_t m0 = (size_t)b * T + c * 128;
        { const int row = tid >> 2, pc = tid & 3; const bf16* src = proj + (m0 + row) * PC + 32 * hh + 8 * pc;
            const u32x4 uq = *(const u32x4*)(src + C_RQ), uk = *(const u32x4*)(src + C_RK);
            const float sq = 0.17677669529663687f * exp2f((float)(row + 1) * lg2), sk = exp2f(-(float)(row + 1) * lg2);
            u32x4 o; o.x = pk2(bflo(uq.x) * sq, bfhi(uq.x) * sq); o.y = pk2(bflo(uq.y) * sq, bfhi(uq.y) * sq); o.z = pk2(bflo(uq.z) * sq, bfhi(uq.z) * sq); o.w = pk2(bflo(uq.w) * sq, bfhi(uq.w) * sq);
            *(u32x4*)(Qs + row * 32 + 8 * pc) = o;
            o.x = pk2(bflo(uk.x) * sk, bfhi(uk.x) * sk); o.y = pk2(bflo(uk.y) * sk, bfhi(uk.y) * sk); o.z = pk2(bflo(uk.z) * sk, bfhi(uk.z) * sk); o.w = pk2(bflo(uk.w) * sk, bfhi(uk.w) * sk);
            *(u32x4*)(Ks + row * 32 + 8 * pc) = o; }
#pragma unroll
        for (int it = 0; it < 2; ++it) { const int idx = tid + NTHR * it, row = idx >> 3, pc = idx & 7; const u32x4 uv = *(const u32x4*)(proj + (m0 + row) * PC + C_RV + 64 * hh + 8 * pc);
            bf16* d0 = VTs + (8 * pc) * 136 + row;
            d0[0] = (bf16)(uv.x & 0xffffu); d0[136] = (bf16)(uv.x >> 16); d0[2 * 136] = (bf16)(uv.y & 0xffffu); d0[3 * 136] = (bf16)(uv.y >> 16);
            d0[4 * 136] = (bf16)(uv.z & 0xffffu); d0[5 * 136] = (bf16)(uv.z >> 16); d0[6 * 136] = (bf16)(uv.w & 0xffffu); d0[7 * 136] = (bf16)(uv.w >> 16); }
        __syncthreads();
        bf16x8 qf[2];
#pragma unroll
        for (int ks = 0; ks < 2; ++ks) qf[ks] = *(const bf16x8*)(Qs + (32 * qt + n) * 32 + 16 * ks + 8 * h);
        f32x16 O;
#pragma unroll
        for (int i = 0; i < 16; ++i) O[i] = 0.f;
        for (int kt = 0; kt <= qt; ++kt) {
            f32x16 acc;
#pragma unroll
            for (int i = 0; i < 16; ++i) acc[i] = 0.f;
#pragma unroll
            for (int ks = 0; ks < 2; ++ks) { const bf16x8 af = *(const bf16x8*)(Ks + (32 * kt + krow) * 32 + 16 * ks + 8 * h); acc = MFMA32(af, qf[ks], acc); }
            if (kt == qt) {
#pragma unroll
                for (int i = 0; i < 16; ++i) { const int cc = 16 * (i >> 3) + (i & 7) + 8 * h; acc[i] = (cc <= n) ? acc[i] : 0.f; }
            }
#pragma unroll
            for (int j = 0; j < 2; ++j) { const bf16x8 pb = nsa_pack8(acc, j); const bf16x8 vf = *(const bf16x8*)(VTs + (32 * dt + n) * 136 + 32 * kt + 16 * j + 8 * h); O = MFMA32(vf, pb, O); }
        }
        { const bf16* ST = (const bf16*)(a.ws + WS_RST) + (((size_t)(b * 8 + hh) * 64 + c) * 64 + 32 * dt + n) * 32;
#pragma unroll
            for (int ks = 0; ks < 2; ++ks) { const bf16x8 sf = *(const bf16x8*)(ST + 16 * ks + 8 * h); O = MFMA32(sf, qf[ks], O); } }
        float ss = 0.f;
#pragma unroll
        for (int i = 0; i < 16; ++i) ss += O[i] * O[i];
        ss += __shfl_xor(ss, 32);
        if (h == 0) ssq[(dt * 4 + qt) * 32 + n] = ss;
        __syncthreads();
        const float rs = 1.f / sqrtf((ssq[qt * 32 + n] + ssq[(4 + qt) * 32 + n]) * (1.f / 64.f) + EPS);
        const size_t m = m0 + 32 * qt + n;
#pragma unroll
        for (int q4 = 0; q4 < 4; ++q4) { const int e0 = 32 * dt + 8 * q4 + 4 * h;
            const u32x2 ug = *(const u32x2*)(proj + m * PC + C_RG + 64 * hh + e0); const f32x4 gn = *(const f32x4*)(rng + 64 * hh + e0);
            const float z0 = bflo(ug.x), z1 = bfhi(ug.x), z2 = bflo(ug.y), z3 = bfhi(ug.y);
            const float y0 = O[4 * q4] * rs * gn.x * fsilu(z0), y1 = O[4 * q4 + 1] * rs * gn.y * fsilu(z1);
            const float y2 = O[4 * q4 + 2] * rs * gn.z * fsilu(z2), y3 = O[4 * q4 + 3] * rs * gn.w * fsilu(z3);
            u32x2 w; w.x = pk2(y0, y1); w.y = pk2(y2, y3);
            *(u32x2*)(mix + m * D + 512 + 64 * hh + e0) = w; }
        __syncthreads();
    }
}

struct Unit { int pm, pn, e, j, nvalid, li; };
struct DenseSched {
    const bf16* A; const bf16* Bt; int K, nM, nN, G, c;
    __device__ __forceinline__ bool next(int i, Unit& u) const { const int L = i * G + c; if (L >= nM * nN) return false; u.pm = L / nN; u.pn = L % nN; u.e = 0; u.j = u.pm; u.nvalid = 256; u.li = i; return true; }
    __device__ __forceinline__ size_t arow(const Unit& u, int r) const { return (size_t)u.pm * 256 + r; }
    __device__ __forceinline__ const bf16* bt(const Unit& u) const { return Bt + (size_t)u.pn * 256 * K; }
    static constexpr bool LOADS = false;
    __device__ __forceinline__ bool loads() const { return false; }
    __device__ __forceinline__ const char* a_base(const Unit& u) const { return (const char*)(A + (size_t)u.pm * 256 * K); }
    __device__ __forceinline__ void a_offs(const Unit& u, const int (&R)[2], const int (&C)[2], unsigned (&v0)[2], unsigned (&v1)[2]) const {
#pragma unroll
        for (int i = 0; i < 2; ++i) { v0[i] = (unsigned)(R[i] * K + C[i]) * 2u; v1[i] = (unsigned)((R[i] + 128) * K + C[i]) * 2u; }
    }
};
template <bool GATHER>
struct RoutedSched {
    const bf16* A; const bf16* Bt; size_t bstride; int K, nN, G, c, ne;
    const int* tok;
    const int* tstart;
    const int* cnt;
    __device__ __forceinline__ bool next(int i, Unit& u) const {
        const int L = i * G + c; const int rt = L / nN; if (rt >= tstart[ne]) return false;
        u.pm = rt; u.pn = L % nN; u.li = i; int e = 0;
        for (int k = 1; k < ne; ++k) e += (tstart[k] <= rt) ? 1 : 0;
        u.e = e; u.j = rt - tstart[e]; const int left = cnt[e] - 256 * u.j; u.nvalid = left < 256 ? left : 256; return true;
    }
    const int* tokl;
    __device__ __forceinline__ size_t arow(const Unit& u, int r) const {
        if (!GATHER) return (size_t)u.pm * 256 + r;
        if (tokl) return (size_t)tokl[u.li * 256 + r];
        const int i = 256 * u.j + (r < u.nvalid ? r : 0);
        return tok ? (size_t)tok[(size_t)u.e * M + i] : (size_t)i;
    }
    __device__ __forceinline__ const bf16* bt(const Unit& u) const { return Bt + (size_t)u.e * bstride + (size_t)u.pn * 256 * K; }
    static constexpr bool LOADS = GATHER;
    __device__ __forceinline__ bool loads() const { return GATHER && tok != nullptr && tokl == nullptr; }
    __device__ __forceinline__ const char* a_base(const Unit& u) const { return GATHER ? (const char*)A : (const char*)(A + (size_t)u.pm * 256 * K); }
    __device__ __forceinline__ void a_offs(const Unit& u, const int (&R)[2], const int (&C)[2], unsigned (&v0)[2], unsigned (&v1)[2]) const {
#pragma unroll
        for (int i = 0; i < 2; ++i) {
            if (GATHER) { v0[i] = (unsigned)(arow(u, R[i]) * K + C[i]) * 2u; v1[i] = (unsigned)(arow(u, R[i] + 128) * K + C[i]) * 2u; }
            else { v0[i] = (unsigned)(R[i] * K + C[i]) * 2u; v1[i] = (unsigned)((R[i] + 128) * K + C[i]) * 2u; }
        }
    }
};
__device__ __forceinline__ void fold_norm(const f32x4& n0, const f32x4& n1, const f32x4& n2, const f32x4& n3, size_t m, int col, bf16* xb, const float* gain, float* rowss) {
    float ss = (n0.x * n0.x + n0.y * n0.y + n0.z * n0.z + n0.w * n0.w) + (n1.x * n1.x + n1.y * n1.y + n1.z * n1.z + n1.w * n1.w)
             + (n2.x * n2.x + n2.y * n2.y + n2.z * n2.z + n2.w * n2.w) + (n3.x * n3.x + n3.y * n3.y + n3.z * n3.z + n3.w * n3.w);
    ss += __shfl_xor(ss, 16); ss += __shfl_xor(ss, 32);
    if (lane_id() < 16) rowss[m * 16 + 4 * (col >> 8) + ((col >> 5) & 3)] = ss;
    const f32x4 g0 = *(const f32x4*)(gain + col), g1 = *(const f32x4*)(gain + col + 4), g2 = *(const f32x4*)(gain + col + 128), g3 = *(const f32x4*)(gain + col + 132);
    u32x4 w; w.x = pk2(n0.x * g0.x, n0.y * g0.y); w.y = pk2(n0.z * g0.z, n0.w * g0.w); w.z = pk2(n1.x * g1.x, n1.y * g1.y); w.w = pk2(n1.z * g1.z, n1.w * g1.w);
    *(u32x4*)(xb + m * D + col) = w;
    w.x = pk2(n2.x * g2.x, n2.y * g2.y); w.y = pk2(n2.z * g2.z, n2.w * g2.w); w.z = pk2(n3.x * g3.x, n3.y * g3.y); w.w = pk2(n3.z * g3.z, n3.w * g3.w);
    *(u32x4*)(xb + m * D + col + 128) = w;
}
__device__ __forceinline__ float fold_rstd(const float* rowss, size_t m) {
    const f32x4* p = (const f32x4*)(rowss + m * 16); const f32x4 a = p[0], b = p[1], c = p[2], d = p[3];
    const float ss = (((a.x + a.y) + (a.z + a.w)) + ((b.x + b.y) + (b.z + b.w))) + (((c.x + c.y) + (c.z + c.w)) + ((d.x + d.y) + (d.z + d.w)));
    return 1.0f / sqrtf(ss * (1.f / D) + EPS);
}
struct EpiIn {
    bf16* proj; float* gates; const float* rowss;
    __device__ __forceinline__ void row8(const Unit& u, int r, int c8, const float (&lo_)[8], const float (&hi_)[8]) const {
        const size_t m = (size_t)u.pm * 256 + r;
        const float rs = rowss ? fold_rstd(rowss, m) : 1.f;
        float lo[8], hi[8];
#pragma unroll
        for (int i = 0; i < 8; ++i) { lo[i] = lo_[i] * rs; hi[i] = hi_[i] * rs; }
        if (u.pn < 11) {
            u32x4 w; w.x = pk2(lo[0], lo[1]); w.y = pk2(lo[2], lo[3]); w.z = pk2(lo[4], lo[5]); w.w = pk2(lo[6], lo[7]);
            *(u32x4*)(proj + m * PC + u.pn * 256 + c8) = w;
            w.x = pk2(hi[0], hi[1]); w.y = pk2(hi[2], hi[3]); w.z = pk2(hi[4], hi[5]); w.w = pk2(hi[6], hi[7]);
            *(u32x4*)(proj + m * PC + u.pn * 256 + 128 + c8) = w;
        } else if (c8 < 24) {
            f32x4 s0, s1;
            s0.x = fsigmoid(lo[0]); s0.y = fsigmoid(lo[1]); s0.z = fsigmoid(lo[2]); s0.w = fsigmoid(lo[3]);
            s1.x = fsigmoid(lo[4]); s1.y = fsigmoid(lo[5]); s1.z = fsigmoid(lo[6]); s1.w = fsigmoid(lo[7]);
            *(f32x4*)(gates + m * 24 + c8) = s0; *(f32x4*)(gates + m * 24 + c8 + 4) = s1;
        }
    }
};
struct EpiRes {
    const float* base; float* out; bf16* xb; const float* gain; float* rowss;
    __device__ __forceinline__ void row8(const Unit& u, int r, int c8, const float (&lo)[8], const float (&hi)[8]) const {
        const size_t o = ((size_t)u.pm * 256 + r) * D + u.pn * 256 + c8;
        const f32x4 b0 = *(const f32x4*)(base + o), b1 = *(const f32x4*)(base + o + 4), b2 = *(const f32x4*)(base + o + 128), b3 = *(const f32x4*)(base + o + 132);
        const f32x4 n0 = (f32x4){b0.x + lo[0], b0.y + lo[1], b0.z + lo[2], b0.w + lo[3]}, n1 = (f32x4){b1.x + lo[4], b1.y + lo[5], b1.z + lo[6], b1.w + lo[7]};
        const f32x4 n2 = (f32x4){b2.x + hi[0], b2.y + hi[1], b2.z + hi[2], b2.w + hi[3]}, n3 = (f32x4){b3.x + hi[4], b3.y + hi[5], b3.z + hi[6], b3.w + hi[7]};
        *(f32x4*)(out + o) = n0; *(f32x4*)(out + o + 4) = n1; *(f32x4*)(out + o + 128) = n2; *(f32x4*)(out + o + 132) = n3;
        if (xb) fold_norm(n0, n1, n2, n3, (size_t)u.pm * 256 + r, u.pn * 256 + c8, xb, gain, rowss);
    }
};
struct EpiGU {
    bf16* hid; const float* rowss;
    __device__ __forceinline__ void row8(const Unit& u, int r, int c8, const float (&lo)[8], const float (&hi)[8]) const {
        float h[8];
        const float rs = rowss ? fold_rstd(rowss, (size_t)u.pm * 256 + r) : 1.f;
#pragma unroll
        for (int i = 0; i < 8; ++i) { const float gt = lo[i] * rs; h[i] = fsilu(gt) * (hi[i] * rs); }
        u32x4 w; w.x = pk2(h[0], h[1]); w.y = pk2(h[2], h[3]); w.z = pk2(h[4], h[5]); w.w = pk2(h[6], h[7]);
        *(u32x4*)(hid + ((size_t)u.pm * 256 + r) * FF + u.pn * 128 + c8) = w;
    }
};
struct EpiGU8 {
    unsigned char* hid;
    __device__ __forceinline__ void row8(const Unit& u, int r, int c8, const float (&lo)[8], const float (&hi)[8]) const {
        constexpr float inv = 1.f / (F8_SA * F8_SW);
        float h[8];
#pragma unroll
        for (int i = 0; i < 8; ++i) { const float gt = lo[i] * inv; h[i] = fsilu(gt) * (hi[i] * (inv * F8_SH)); }
        u32x2 w; w.x = pk4_fp8(h[0], h[1], h[2], h[3]); w.y = pk4_fp8(h[4], h[5], h[6], h[7]);
        *(u32x2*)(hid + ((size_t)u.pm * 256 + r) * FF + u.pn * 128 + c8) = w;
    }
};
struct EpiDown {
    float* x; const int* tok; const float* wt; float scale; bf16* xb; const float* gain; float* rowss;
    __device__ __forceinline__ void row8(const Unit& u, int r, int c8, const float (&lo)[8], const float (&hi)[8]) const {
        if (r >= u.nvalid) return;
        const int i = 256 * u.j + r; size_t m; float w;
        if (tok) { m = (size_t)tok[(size_t)u.e * M + i]; w = wt[(size_t)u.e * M + i] * scale; } else { m = (size_t)i; w = scale; }
        float* o = x + m * D + u.pn * 256 + c8;
        f32x4 b0 = *(f32x4*)(o), b1 = *(f32x4*)(o + 4), b2 = *(f32x4*)(o + 128), b3 = *(f32x4*)(o + 132);
        b0.x += w * lo[0]; b0.y += w * lo[1]; b0.z += w * lo[2]; b0.w += w * lo[3]; b1.x += w * lo[4]; b1.y += w * lo[5]; b1.z += w * lo[6]; b1.w += w * lo[7];
        b2.x += w * hi[0]; b2.y += w * hi[1]; b2.z += w * hi[2]; b2.w += w * hi[3]; b3.x += w * hi[4]; b3.y += w * hi[5]; b3.z += w * hi[6]; b3.w += w * hi[7];
        *(f32x4*)(o) = b0; *(f32x4*)(o + 4) = b1; *(f32x4*)(o + 128) = b2; *(f32x4*)(o + 132) = b3;
        if (xb) fold_norm(b0, b1, b2, b3, m, u.pn * 256 + c8, xb, gain, rowss);
    }
};

template <class Sched, class Epi>
__device__ __forceinline__ void gemm_naive(unsigned char* lds, const Sched& S, const Epi& E, int tid) {
    float* As = (float*)lds;
    float* Bs = As + 32 * 132;
    const int tr = tid >> 4, tc = tid & 15;
    const int lr = tid >> 2, lk = (tid & 3) * 8;
    const int K = S.K;
    Unit u;
    for (int it = 0; S.next(it, u); ++it) {
        const bf16* Btile = S.bt(u);
        for (int hf = 0; hf < 2; ++hf) {
            float lo[4][8], hi[4][8];
#pragma unroll
            for (int i = 0; i < 4; ++i)
#pragma unroll
                for (int j = 0; j < 8; ++j) { lo[i][j] = 0.f; hi[i][j] = 0.f; }
            const bf16* arow = S.A + S.arow(u, hf * 128 + lr) * K + lk;
            const bf16* brow0 = Btile + (size_t)lr * K + lk; const bf16* brow1 = Btile + (size_t)(lr + 128) * K + lk;
            for (int k0 = 0; k0 < K; k0 += 32) {
                const u32x4 av = *(const u32x4*)(arow + k0), b0 = *(const u32x4*)(brow0 + k0), b1 = *(const u32x4*)(brow1 + k0);
                __syncthreads();
                As[(lk + 0) * 132 + lr] = bflo(av.x); As[(lk + 1) * 132 + lr] = bfhi(av.x); As[(lk + 2) * 132 + lr] = bflo(av.y); As[(lk + 3) * 132 + lr] = bfhi(av.y);
                As[(lk + 4) * 132 + lr] = bflo(av.z); As[(lk + 5) * 132 + lr] = bfhi(av.z); As[(lk + 6) * 132 + lr] = bflo(av.w); As[(lk + 7) * 132 + lr] = bfhi(av.w);
                Bs[(lk + 0) * 260 + lr] = bflo(b0.x); Bs[(lk + 1) * 260 + lr] = bfhi(b0.x); Bs[(lk + 2) * 260 + lr] = bflo(b0.y); Bs[(lk + 3) * 260 + lr] = bfhi(b0.y);
                Bs[(lk + 4) * 260 + lr] = bflo(b0.z); Bs[(lk + 5) * 260 + lr] = bfhi(b0.z); Bs[(lk + 6) * 260 + lr] = bflo(b0.w); Bs[(lk + 7) * 260 + lr] = bfhi(b0.w);
                Bs[(lk + 0) * 260 + lr + 128] = bflo(b1.x); Bs[(lk + 1) * 260 + lr + 128] = bfhi(b1.x); Bs[(lk + 2) * 260 + lr + 128] = bflo(b1.y); Bs[(lk + 3) * 260 + lr + 128] = bfhi(b1.y);
                Bs[(lk + 4) * 260 + lr + 128] = bflo(b1.z); Bs[(lk + 5) * 260 + lr + 128] = bfhi(b1.z); Bs[(lk + 6) * 260 + lr + 128] = bflo(b1.w); Bs[(lk + 7) * 260 + lr + 128] = bfhi(b1.w);
                __syncthreads();
#pragma unroll 4
                for (int k = 0; k < 32; ++k) {
                    const f32x4 av4 = *(const f32x4*)(As + k * 132 + 4 * tr);
                    const f32x4 l0 = *(const f32x4*)(Bs + k * 260 + 8 * tc), l1 = *(const f32x4*)(Bs + k * 260 + 8 * tc + 4);
                    const f32x4 h0 = *(const f32x4*)(Bs + k * 260 + 128 + 8 * tc), h1 = *(const f32x4*)(Bs + k * 260 + 128 + 8 * tc + 4);
                    const float aa[4] = {av4.x, av4.y, av4.z, av4.w};
                    const float bl[8] = {l0.x, l0.y, l0.z, l0.w, l1.x, l1.y, l1.z, l1.w}, bh[8] = {h0.x, h0.y, h0.z, h0.w, h1.x, h1.y, h1.z, h1.w};
#pragma unroll
                    for (int i = 0; i < 4; ++i)
#pragma unroll
                        for (int j = 0; j < 8; ++j) { lo[i][j] += aa[i] * bl[j]; hi[i][j] += aa[i] * bh[j]; }
                }
            }
#pragma unroll
            for (int i = 0; i < 4; ++i) E.row8(u, hf * 128 + 4 * tr + i, 8 * tc, lo[i], hi[i]);
        }
    }
    __syncthreads();
}

namespace pg8 {
constexpr int BK = 64, HALF = 128, HTB = HALF * BK * 2;
__device__ __forceinline__ int lds_byte(int r, int c) { const int st = (r >> 4) * 2 + (c >> 5), rr = r & 15, cc = c & 31, ob = rr * 64 + cc * 2; return st * 1024 + (ob ^ (((ob >> 9) & 1) << 5)); }
__device__ __forceinline__ void stage_rc(int b, int& R, int& C) { const int st = b / 1024, sb = b % 1024, swz = sb ^ (((sb >> 9) & 1) << 5); R = (st >> 1) * 16 + swz / 64; C = (st & 1) * 32 + (swz % 64) / 2; }
__device__ __forceinline__ int perm32(int rho) { const int n = rho >> 4, i = rho & 15; return 8 * (i >> 2) + 4 * n + (i & 3); }
}
template <bool FP8, class Sched, class Epi>
__device__ __forceinline__ void gemm_fast(LAS unsigned char* lds, const Sched& S, const Epi& E, int wid) {
    using namespace pg8;
    const int lane = lane_id(), tid = wid * 64 + lane, wr = wid >> 2, wc = wid & 3, fr = lane & 15, fq = lane >> 4;
    const int K = S.K, nt = K / BK;
    volatile LAS unsigned* nvs = (volatile LAS unsigned*)(lds + NVOFF_OFF) + tid * 4;
    unsigned voffB[2];
#pragma unroll
    for (int i = 0; i < 2; ++i) { int R, C; stage_rc(tid * 16 + i * 8192, R, C); const int Rb = (R & ~31) + perm32(R & 31); voffB[i] = (unsigned)(Rb * K + C) * 2u; }
#define PG8_AOFFS(u, o0, o1) do { int _t = tid; asm volatile("" : "+v"(_t)); int _R[2], _C[2]; stage_rc(_t * 16, _R[0], _C[0]); stage_rc(_t * 16 + 8192, _R[1], _C[1]); S.a_offs(u, _R, _C, o0, o1); } while (0)
    const size_t kstep = (size_t)(BK * 2);
    const size_t hstep = (size_t)HALF * K * 2;
    const unsigned ldsw = (unsigned)wid * 1024u;
    const int aoff = lds_byte(wr * 64 + fr, fq * 8), boff = lds_byte(wc * 32 + fr, fq * 8);
    const int c8f = 32 * (fq >> 1) + 16 * (fq & 1);
    const int aoff0 = FP8 ? lds_byte(wr * 64 + fr, c8f) : 0, boff0 = FP8 ? lds_byte(wc * 32 + fr, c8f) : 0;
    int boffH = (FP8 ? boff0 : boff) + 4 * HTB; asm volatile("" : "+v"(boffH));
#define PG8_SA(b, h) (((b) * 2 + (h)) * HTB)
#define PG8_SB(b, h) ((4 + (b) * 2 + (h)) * HTB)
#define PG8_STAGE(bufoff, gbase, voff) do { _Pragma("unroll") for (int _i = 0; _i < 2; ++_i) \
        __builtin_amdgcn_global_load_lds((const unsigned*)((const char*)(gbase) + (voff)[_i]), (LAS unsigned*)(lds + (bufoff) + ldsw + _i * 8192), 16, 0, 0); } while (0)
#define PG8_STAGE_A1(bufoff, gbase) do { if constexpr (Sched::LOADS) PG8_STAGE(bufoff, gbase, cv1); else PG8_STAGE(bufoff, (gbase) + hstep, cv0); } while (0)
#define PG8_LDA(dst, b, h) do { _Pragma("unroll") for (int m = 0; m < 4; ++m) _Pragma("unroll") for (int k = 0; k < 2; ++k) dst[m][k] = *(const LAS bf16x8*)(lds + PG8_SA(b, h) + aoff + m * 2048 + k * 1024); } while (0)
#define PG8_LDB(dst, b, h) do { _Pragma("unroll") for (int n = 0; n < 2; ++n) _Pragma("unroll") for (int k = 0; k < 2; ++k) dst[n][k] = *(const LAS bf16x8*)(lds + boffH + (PG8_SB(b, h) - 4 * HTB) + n * 2048 + k * 1024); } while (0)
#define PG8_MMA(ai, bj, At, Bt) do { __builtin_amdgcn_s_setprio(1); _Pragma("unroll") for (int m = 0; m < 4; ++m) _Pragma("unroll") for (int n = 0; n < 2; ++n) _Pragma("unroll") for (int k = 0; k < 2; ++k) \
        acc[ai][bj][m][n] = __builtin_amdgcn_mfma_f32_16x16x32_bf16(Bt[n][k], At[m][k], acc[ai][bj][m][n], 0, 0, 0); __builtin_amdgcn_s_setprio(0); } while (0)
#define PG8_RD8(dst, o0) do { const v4i _l = *(const LAS v4i*)(lds + (o0)), _h = *(const LAS v4i*)(lds + (o0) + 16); dst = __builtin_shufflevector(_l, _h, 0, 1, 2, 3, 4, 5, 6, 7); } while (0)
#define PG8_LDA8(dst, b, h) do { _Pragma("unroll") for (int m = 0; m < 4; ++m) PG8_RD8(dst[m], PG8_SA(b, h) + aoff0 + m * 2048); } while (0)
#define PG8_LDB8(dst, b, h) do { _Pragma("unroll") for (int n = 0; n < 2; ++n) PG8_RD8(dst[n], boffH + (PG8_SB(b, h) - 4 * HTB) + n * 2048); } while (0)
#define PG8_MMA8(ai, bj, At, Bt) do { __builtin_amdgcn_s_setprio(1); _Pragma("unroll") for (int m = 0; m < 4; ++m) _Pragma("unroll") for (int n = 0; n < 2; ++n) \
        asm volatile("v_mfma_scale_f32_16x16x128_f8f6f4 %0, %1, %2, %0, %3, %3 op_sel_hi:[0,0,0]" : "+v"(acc[ai][bj][m][n]) : "v"(Bt[n]), "v"(At[m]), "v"(f8scale)); __builtin_amdgcn_s_setprio(0); } while (0)
#define PG8_WAIT_V(n) asm volatile("s_waitcnt vmcnt(" #n ")" ::: "memory")
#define PG8_WAIT_L(n) asm volatile("s_waitcnt lgkmcnt(" #n ")" ::: "memory")
#define PG8_BAR __builtin_amdgcn_s_barrier()
#define PG8_SCHED __builtin_amdgcn_sched_barrier(0)
#define XLDA(b, h) do { if constexpr (FP8) PG8_LDA8(At8, b, h); else PG8_LDA(At, b, h); } while (0)
#define XLDB0(b, h) do { if constexpr (FP8) PG8_LDB8(B08, b, h); else PG8_LDB(B0, b, h); } while (0)
#define XLDB1(b, h) do { if constexpr (FP8) PG8_LDB8(B18, b, h); else PG8_LDB(B1, b, h); } while (0)
#define XMMA(ai, bj, w) do { if constexpr (FP8) { if (w) PG8_MMA8(ai, bj, At8, B18); else PG8_MMA8(ai, bj, At8, B08); } else { if (w) PG8_MMA(ai, bj, At, B1); else PG8_MMA(ai, bj, At, B0); } } while (0)
    Unit cur, nxt; int ui = 0;
    if (!S.next(0, cur)) return;
    f32x4 acc[2][2][4][2];
#pragma unroll
    for (int a = 0; a < 2; ++a)
#pragma unroll
        for (int b = 0; b < 2; ++b)
#pragma unroll
            for (int m = 0; m < 4; ++m)
#pragma unroll
                for (int n = 0; n < 2; ++n) acc[a][b][m][n] = (f32x4){0.f, 0.f, 0.f, 0.f};
    bf16x8 At[4][2], B0[2][2], B1[2][2];
    v8i At8[4], B08[2], B18[2];
    const int f8scale = 0x7f7f7f7f;
    unsigned cv0[2], cv1[2];
    const char* cA = S.a_base(cur); const char* cB = (const char*)S.bt(cur);
    PG8_AOFFS(cur, cv0, cv1);
    if (Sched::LOADS && S.loads()) PG8_WAIT_V(0);
    PG8_STAGE(PG8_SB(0, 0), cB, voffB); PG8_STAGE(PG8_SB(0, 1), cB + hstep, voffB); PG8_STAGE(PG8_SA(0, 0), cA, cv0); PG8_STAGE_A1(PG8_SA(0, 1), cA);
    if (wr == 1) PG8_BAR;
    PG8_WAIT_V(2); PG8_BAR;
    PG8_STAGE(PG8_SB(1, 0), cB + kstep, voffB); PG8_STAGE(PG8_SA(1, 0), cA + kstep, cv0); PG8_STAGE(PG8_SB(1, 1), cB + hstep + kstep, voffB);
    PG8_WAIT_V(6); PG8_BAR;
    for (;;) {
        const bool has_next = S.next(ui + 1, nxt);
        const char* nA = cA; const char* nB = cB;
        if (has_next) { nA = S.a_base(nxt); nB = (const char*)S.bt(nxt);
            if (Sched::LOADS) { unsigned n0[2], n1[2]; PG8_AOFFS(nxt, n0, n1); if (S.loads()) PG8_WAIT_V(0); nvs[0] = n0[0]; nvs[1] = n0[1]; nvs[2] = n1[0]; nvs[3] = n1[1]; } }
        for (int t = 0; t < nt; t += 2) {
            const bool last = (t == nt - 2);
            const char* a1 = cA + (size_t)(t + 1) * kstep;
            const char* a2 = last ? nA : cA + (size_t)(t + 2) * kstep; const char* b2 = last ? nB : cB + (size_t)(t + 2) * kstep;
            const char* a3 = a2 + kstep; const char* b3 = b2 + kstep;
            XLDB0(0, 0); XLDB1(0, 1); PG8_SCHED; XLDA(0, 0); PG8_STAGE_A1(PG8_SA(1, 1), a1);
            if (Sched::LOADS) { if (last && has_next) { cv0[0] = nvs[0]; cv0[1] = nvs[1]; cv1[0] = nvs[2]; cv1[1] = nvs[3]; } }
            PG8_WAIT_V(8); PG8_WAIT_L(0); PG8_BAR; XMMA(0, 0, 0); XMMA(0, 1, 1); PG8_BAR; PG8_SCHED;
            XLDA(0, 1); PG8_STAGE(PG8_SB(0, 0), b2, voffB); PG8_STAGE(PG8_SB(0, 1), b2 + hstep, voffB); PG8_STAGE(PG8_SA(0, 0), a2, cv0);
            PG8_WAIT_V(8); PG8_WAIT_L(0); PG8_BAR; XMMA(1, 0, 0); XMMA(1, 1, 1); PG8_BAR; PG8_SCHED;
            XLDB0(1, 0); XLDB1(1, 1); PG8_SCHED; XLDA(1, 0); PG8_STAGE_A1(PG8_SA(0, 1), a2);
            PG8_WAIT_V(8); PG8_WAIT_L(0); PG8_BAR; XMMA(0, 0, 0); XMMA(0, 1, 1); PG8_BAR; PG8_SCHED;
            XLDA(1, 1); PG8_STAGE(PG8_SB(1, 0), b3, voffB); PG8_STAGE(PG8_SB(1, 1), b3 + hstep, voffB); PG8_STAGE(PG8_SA(1, 0), a3, cv0);
            PG8_WAIT_V(8); PG8_WAIT_L(0); PG8_BAR; XMMA(1, 0, 0); XMMA(1, 1, 1); PG8_BAR; PG8_SCHED;
        }
        if (wr == 0) PG8_BAR;
        {
            int frl = fr, c8 = wc * 32 + 8 * fq;
            asm volatile("" : "+v"(frl), "+v"(c8));
#pragma unroll
            for (int ai = 0; ai < 2; ++ai)
#pragma unroll
                for (int m = 0; m < 4; ++m) {
                    const float lo[8] = {acc[ai][0][m][0][0], acc[ai][0][m][0][1], acc[ai][0][m][0][2], acc[ai][0][m][0][3], acc[ai][0][m][1][0], acc[ai][0][m][1][1], acc[ai][0][m][1][2], acc[ai][0][m][1][3]};
                    const float hi[8] = {acc[ai][1][m][0][0], acc[ai][1][m][0][1], acc[ai][1][m][0][2], acc[ai][1][m][0][3], acc[ai][1][m][1][0], acc[ai][1][m][1][1], acc[ai][1][m][1][2], acc[ai][1][m][1][3]};
                    E.row8(cur, ai * HALF + wr * 64 + m * 16 + frl, c8, lo, hi);
                }
        }
        if (!has_next) break;
#pragma unroll
        for (int a = 0; a < 2; ++a)
#pragma unroll
            for (int b = 0; b < 2; ++b)
#pragma unroll
                for (int m = 0; m < 4; ++m)
#pragma unroll
                    for (int n = 0; n < 2; ++n) acc[a][b][m][n] = (f32x4){0.f, 0.f, 0.f, 0.f};
        cur = nxt; cA = nA; cB = nB; ++ui;
        if (wr == 1) PG8_BAR;
    }
    PG8_WAIT_V(0);
    PG8_BAR;
#undef XLDA
#undef XLDB0
#undef XLDB1
#undef XMMA
#undef PG8_RD8
#undef PG8_LDA8
#undef PG8_LDB8
#undef PG8_MMA8
#undef PG8_STAGE_A1
#undef PG8_AOFFS
#undef PG8_SA
#undef PG8_SB
#undef PG8_STAGE
#undef PG8_LDA
#undef PG8_LDB
#undef PG8_MMA
#undef PG8_WAIT_V
#undef PG8_WAIT_L
#undef PG8_BAR
#undef PG8_SCHED
}

template <class Sched>
__device__ __forceinline__ const int* routed_tokens(unsigned char* lds, const Sched& S, int tid) {
    int* tl = (int*)(lds + TOKL_OFF);
    if (S.tok == nullptr) return nullptr;
    Unit u;
    for (int i = 0; i < TOKL_MAXU && S.next(i, u); ++i)
        if (tid < 256) { const int ii = 256 * u.j + (tid < u.nvalid ? tid : 0); tl[i * 256 + tid] = S.tok[(size_t)u.e * M + ii]; }
    { Unit v; if (S.next(TOKL_MAXU, v)) return nullptr; }
    __syncthreads();
    return tl;
}
__device__ __forceinline__ void routed_setup(unsigned char* lds, const int* cnt_g, int ne, bool dense, int tid, int*& tstart, int*& cnt) {
    tstart = (int*)(lds + MISC_OFF + 64); cnt = tstart + 16;
    __syncthreads();
    if (tid == 0) { int acc = 0; for (int e = 0; e < ne; ++e) { const int n = dense ? M : __hip_atomic_load(cnt_g + e, __ATOMIC_RELAXED, __HIP_MEMORY_SCOPE_AGENT); cnt[e] = n; tstart[e] = acc; acc += (n + 255) >> 8; } tstart[ne] = acc; }
    __syncthreads();
}

constexpr int PH_PER_LAYER = 11, NPHASE = 2 * PH_PER_LAYER;
#if FAST_GEMM
#define GEMM_CALL(S, E) gemm_fast<false>((LAS unsigned char*)lds, S, E, wave)
#define GEMM_CALL8(S, E) gemm_fast<true>((LAS unsigned char*)lds, S, E, wave)
#else
#define GEMM_CALL(S, E) gemm_naive(lds, S, E, wave * 64 + lane_id())
#endif
#define IN(k) (lo <= (k) && (k) < hi)
#define SEAM(k) do { if (IN(k) && IN((k) + 1)) xcd_barrier(bar); } while (0)
template <int L>
__device__ __forceinline__ void layer(const Args& a, unsigned char* lds, const XcdBarrier& bar, int wave, int G, int blk) {
#define lane lane_id()
#define tid (wave * 64 + lane_id())
    unsigned char* ws = a.ws;
    const int lo = a.ph_lo, hi = a.ph_hi;
    bf16* hn = (bf16*)(ws + WS_HN); bf16* proj = (bf16*)(ws + WS_PROJ); float* gates = (float*)(ws + WS_GATES);
    int* cntg = (int*)(ws + WS_CTL) + CW_CNT;
    {
        constexpr int l = L; constexpr int P = l * PH_PER_LAYER;
        const float* xin = (l == 0) ? a.in[0] : a.out;
        constexpr bool FUSED = FUSE_NORM && FAST_GEMM;
        float* rowss0 = (float*)(ws + WS_ROWP); float* rowss1 = rowss0 + (size_t)M * 16;
        bf16* x2 = (bf16*)(ws + WS_X2);
        if (IN(P + 0)) {
            if (l == 0) conv_phase(a, lds, blk * NWAVES + wave, G * NWAVES, wave, lane);
            if (l == 0) { const int gw = blk * NWAVES + wave;
                if (gw < 256) { const int lw = gw >> 6, nn = gw & 63, ln = lane; const float* pos = a.in[5] + (size_t)lw * 2048; const float* w = a.in[6] + (size_t)lw * 2048 * 64;
                    float sacc = 0.f;
                    for (int i = 0; i < 32; ++i) sacc += pos[64 * i + ln] * w[(size_t)(64 * i + ln) * 64 + nn];
                    sacc = wave_sum(sacc);
                    if (ln == 0) ((float*)(ws + WS_CTL) + CW_CBIAS)[lw * 64 + nn] = sacc; } }
            if (!(FUSED && l == 1)) norm_phase<false>(a, lds, xin, a.in[1] + l * D, hn, blk, G, wave, lane, tid);
        }
        if (!(FUSED && l == 1)) SEAM(P + 0);
        if (IN(P + 1)) {
            DenseSched S{hn, (const bf16*)(ws + WS_WIN) + (size_t)l * NIN * D, D, M / 256, NIN / 256, G, blk};
            EpiIn E{proj, gates, (FUSED && l == 1) ? rowss1 : nullptr};
            GEMM_CALL(S, E);
        }
        SEAM(P + 1);
        if (IN(P + 2)) post_phase(a, lds, l, blk, G, wave, lane, tid);
        SEAM(P + 2);
        if (IN(P + 3)) { scan_phase(a, blk, G, tid);
#if NSA_FAST && NSA_LS
            nsa_ls_phase(a, lds, l, blk, G, wave);
#elif NSA_FAST
            nsa_fast_phase(a, lds, l, blk, G, wave);
#else
            nsa_phase(a, lds, blk, G, tid);
#endif
        }
        SEAM(P + 3);
        if (IN(P + 4)) {
#if RET_FAST
            retout_fast_phase(a, lds, l, blk, G, wave);
#else
            retout_phase(a, l, blk, G, tid);
#endif
        }
        SEAM(P + 4);
        if (IN(P + 5)) {
            DenseSched S{hn, (const bf16*)(ws + WS_WOUT) + (size_t)l * D * D, D, M / 256, D / 256, G, blk};
            EpiRes E{xin, a.out, (FUSED && l == 0) ? x2 : nullptr, a.in[9] + l * D, rowss0};
            GEMM_CALL(S, E);
        }
        SEAM(P + 5);
        if (IN(P + 6)) {
            if (l == 0) { if (!FUSED) norm_phase<false, DENSE_FP8 && FAST_GEMM>(a, lds, a.out, a.in[9] + l * D, hn, blk, G, wave, lane, tid); }
            else norm_phase<true, MOE_FP8 && FAST_GEMM>(a, lds, a.out, a.in[9] + l * D, hn, blk, G, wave, lane, tid);
        }
        if (!(FUSED && l == 0)) SEAM(P + 6);
#pragma unroll
        for (int s = 0; s < 2; ++s) {
            const bool dense = (l == 0);
            if (dense && s == 1) break;
            const int ne = dense ? 1 : NE;
            const int* tok = dense ? nullptr : (const int*)(ws + WS_RTOK) + (size_t)s * NE * M;
            const float* wt = dense ? nullptr : (const float*)(ws + WS_RWT) + (size_t)s * NE * M;
            if (IN(P + 7 + 2 * s)) {
                int *tstart, *cnt; routed_setup(lds, cntg + s * 8, ne, dense, tid, tstart, cnt);
                if (!(FAST_GEMM && (dense ? DENSE_FP8 : MOE_FP8))) {
                    RoutedSched<true> S{(FUSED && dense) ? x2 : hn, (const bf16*)(ws + (dense ? WS_WGU : WS_MGU)), (size_t)2 * FF * D, D, 2 * FF / 256, G, blk, ne, tok, tstart, cnt};
                    S.tokl = routed_tokens(lds, S, tid);
                    EpiGU E{proj, (FUSED && dense) ? rowss0 : nullptr};
                    GEMM_CALL(S, E);
                } else {
#if (MOE_FP8 || DENSE_FP8) && FAST_GEMM
                    RoutedSched<true> S{hn, (const bf16*)(ws + (dense ? WS_WGU : WS_MGU)), (size_t)2 * FF * D / 2, D / 2, 2 * FF / 256, G, blk, ne, tok, tstart, cnt};
                    S.tokl = routed_tokens(lds, S, tid);
                    EpiGU8 E{(unsigned char*)proj};
                    GEMM_CALL8(S, E);
#endif
                }
            }
            SEAM(P + 7 + 2 * s);
            if (IN(P + 8 + 2 * s)) {
                int *tstart, *cnt; routed_setup(lds, cntg + s * 8, ne, dense, tid, tstart, cnt);
                if (!(FAST_GEMM && (dense ? DENSE_FP8 : MOE_FP8))) {
                    RoutedSched<false> S{proj, (const bf16*)(ws + (dense ? WS_WDN : WS_MDN)), (size_t)D * FF, FF, D / 256, G, blk, ne, tok, tstart, cnt};
                    EpiDown E{a.out, tok, wt, 1.f, (FUSED && dense) ? hn : nullptr, a.in[1] + D, rowss1};
                    GEMM_CALL(S, E);
                } else {
#if (MOE_FP8 || DENSE_FP8) && FAST_GEMM
                    RoutedSched<false> S{proj, (const bf16*)(ws + (dense ? WS_WDN : WS_MDN)), (size_t)D * FF / 2, FF / 2, D / 256, G, blk, ne, tok, tstart, cnt};
                    EpiDown E{a.out, tok, wt, 1.f / (F8_SH * F8_SW), nullptr, nullptr, nullptr};
                    GEMM_CALL8(S, E);
#endif
                }
            }
            if (!(l == 1 && s == 1)) SEAM(P + 8 + 2 * s);
        }
    }
}
#undef lane
#undef tid
#undef IN
#undef SEAM
__global__ void __launch_bounds__(NTHR, 2) fwd(Args a) {
    extern __shared__ __attribute__((aligned(16))) unsigned char lds[];
    const int wave = __builtin_amdgcn_readfirstlane(threadIdx.x >> 6);
    const int G = gridDim.x, blk = blockIdx.x;
    unsigned char* ws = a.ws;
    volatile LAS unsigned* misc = (volatile LAS unsigned*)((LAS unsigned char*)lds + MISC_OFF);
    if (wave == 0) misc[lane_id()] = 0u;
    __syncthreads();
    XcdBarrier bar; bar.bar = (unsigned*)(ws + WS_CTL) + CW_BAR; bar.x = 0; bar.st = nullptr;
    const bool multi = (a.ph_hi - a.ph_lo) > 1;
    bar.wave = wave;
    if (multi) bar = xcd_barrier_post((unsigned*)(ws + WS_CTL) + CW_BAR, misc + 8, wave);
    layer<0>(a, lds, bar, wave, G, blk);
    layer<1>(a, lds, bar, wave, G, blk);
}

extern "C" void kernel_launch(void* const* d_in, const int* in_sizes, int n_in, void* d_out, int out_size, void* d_ws, size_t ws_size, hipStream_t stream) {
    static int grid = 0;
    if (grid == 0) {
        if (n_in != 18 || out_size != M * D || ws_size < WS_END) { fprintf(stderr, "kernel_launch: unexpected problem (n_in %d out %d ws %zu)\n", n_in, out_size, ws_size); grid = -1; return; }
        int dev = 0, cus = 0;
        if (hipGetDevice(&dev) != hipSuccess || hipDeviceGetAttribute(&cus, hipDeviceAttributeMultiprocessorCount, dev) != hipSuccess) { grid = -1; return; }
        if (hipFuncSetAttribute((const void*)fwd, hipFuncAttributeMaxDynamicSharedMemorySize, LDS_BYTES) != hipSuccess) { grid = -1; return; }
        int per_cu = 0;
        if (hipOccupancyMaxActiveBlocksPerMultiprocessor(&per_cu, (const void*)fwd, NTHR, LDS_BYTES) != hipSuccess || per_cu < 1) fprintf(stderr, "kernel_launch: occupancy query says %d\n", per_cu);
        (void)hipGetLastError();
        grid = 256;
        if (cus < 256) { fprintf(stderr, "kernel_launch: needs 256 CUs, device has %d\n", cus); grid = -1; return; }
    }
    if (grid < 0) return;
    (void)hipMemsetAsync((char*)d_ws + WS_CTL, 0, CTL_BYTES, stream);
    Args a{};
    for (int i = 0; i < 18; ++i) a.in[i] = (const float*)d_in[i];
    a.out = (float*)d_out; a.ws = (unsigned char*)d_ws;
#if ONE_LAUNCH
    a.ph_lo = 0; a.ph_hi = NPHASE;
    hipLaunchKernelGGL(fwd, dim3(grid), dim3(NTHR), LDS_BYTES, stream, a);
#else
    for (int p = 0; p < NPHASE; ++p) {
        if (p == 9 || p == 10) continue;
        a.ph_lo = p; a.ph_hi = p + 1;
        hipLaunchKernelGGL(fwd, dim3(grid), dim3(NTHR), LDS_BYTES, stream, a);
    }
#endif
}
```

```cpp
#include <hip/hip_runtime.h>
#include <cstdio>
#include <cstdint>

#ifndef FAST_GEMM
#define FAST_GEMM 1
#endif
#ifndef NSA_FAST
#define NSA_FAST 1
#endif
#ifndef MOE_FP8
#define MOE_FP8 1
#endif
#ifndef DENSE_FP8
#define DENSE_FP8 0
#endif
#ifndef FUSE_NORM
#define FUSE_NORM 0
#endif
#ifndef NSA_LS
#define NSA_LS 0
#endif
#ifndef RET_FAST
#define RET_FAST 1
#endif
#ifndef ONE_LAUNCH
#define ONE_LAUNCH 1
#endif

#define LAS __attribute__((address_space(3)))
typedef unsigned short bf16;
typedef float f32x4 __attribute__((ext_vector_type(4)));
typedef unsigned u32x4 __attribute__((ext_vector_type(4)));
typedef unsigned u32x2 __attribute__((ext_vector_type(2)));
typedef short bf16x8 __attribute__((ext_vector_type(8)));
typedef float f32x16 __attribute__((ext_vector_type(16)));
typedef int v8i __attribute__((ext_vector_type(8)));
typedef int v4i __attribute__((ext_vector_type(4)));

constexpr int NB = 4, T = 8192, D = 1024, M = NB * T;
constexpr int PC = 2816;
constexpr int NIN = 3072;
constexpr int INC = 2840;
constexpr int FF = 2816, NE = 8;
constexpr int C_Q = 0, C_KC = 512, C_VC = 640, C_KS = 768, C_VS = 896, C_KW = 1024, C_VW = 1152, C_RQ = 1280, C_RK = 1536, C_RV = 1792, C_RG = 2304;
constexpr int NCB = 512;
constexpr float EPS = 1e-6f;
constexpr float LOG2E = 1.4426950408889634f;
constexpr int NTHR = 512, NWAVES = 8;
constexpr int HROWS = M + NE * 256;

constexpr size_t MiB = 1u << 20;
constexpr size_t WS_CTL = 0, CTL_BYTES = 1 * MiB;
constexpr size_t WS_WIN = 2 * MiB;
constexpr size_t WS_WOUT = 14 * MiB;
constexpr size_t WS_WGU = 18 * MiB;
constexpr size_t WS_WDN = 29 * MiB;
constexpr size_t WS_MGU = 35 * MiB;
constexpr size_t WS_MDN = (MOE_FP8 && FAST_GEMM ? 79 : 123) * MiB;
constexpr size_t WS_X2 = 102 * MiB;
static_assert(!FUSE_NORM || (MOE_FP8 && FAST_GEMM && !DENSE_FP8), "FUSE_NORM uses workspace freed by MOE_FP8 and the bf16 dense FFN");
static_assert(!FUSE_NORM || (WS_X2 >= WS_MDN + (size_t)8 * FF * D && WS_X2 + (size_t)M * D * 2 <= 168 * MiB), "X2 region");
constexpr size_t WS_HN = 168 * MiB;
constexpr size_t WS_PROJ = 232 * MiB;
constexpr size_t WS_GATES = 420 * MiB;
constexpr size_t WS_KCMP = 423 * MiB;
constexpr size_t WS_VCMP = WS_KCMP + 512 * 1024;
constexpr size_t WS_RETS = 424 * MiB;
constexpr size_t WS_RTOK = 440 * MiB;
constexpr size_t WS_RWT = 442 * MiB;
constexpr size_t WS_KS = 444 * MiB;
constexpr size_t WS_KW = 452 * MiB;
constexpr size_t WS_VST = 460 * MiB;
constexpr size_t WS_VWT = 468 * MiB;
constexpr size_t WS_VCT = 476 * MiB;
constexpr size_t WS_WCT = 477 * MiB;
constexpr size_t WS_RST = 478 * MiB;
constexpr size_t WS_KCF = 486 * MiB;
constexpr size_t WS_ROWP = 487 * MiB;
constexpr size_t WS_END = 491 * MiB;
static_assert(WS_PROJ + (size_t)HROWS * FF * 2 <= WS_GATES, "hidden overlay fits");
constexpr int CW_BAR = 4096;
constexpr int CW_CNT = 16384;
constexpr int CW_ROWSS = 32768;
constexpr int CW_CBIAS = 196608;

constexpr int LDS_BYTES = 147456;
constexpr int MISC_OFF = 131072;
constexpr int SELM_OFF = 131072 + 1024;
constexpr int NVOFF_OFF = 131072 + 2048;

__device__ __forceinline__ unsigned f2bf(float f) { unsigned u = __builtin_bit_cast(unsigned, f); return (u + 0x7fffu + ((u >> 16) & 1u)) >> 16; }
typedef float f32x2_t __attribute__((ext_vector_type(2)));
typedef __bf16 bf16x2_t __attribute__((ext_vector_type(2)));
__device__ __forceinline__ unsigned pk2(float lo, float hi) { const f32x2_t v = {lo, hi}; const bf16x2_t b = __builtin_convertvector(v, bf16x2_t); return __builtin_bit_cast(unsigned, b); }
__device__ __forceinline__ float bflo(unsigned u) { return __builtin_bit_cast(float, u << 16); }
__device__ __forceinline__ float bfhi(unsigned u) { return __builtin_bit_cast(float, u & 0xffff0000u); }
__device__ __forceinline__ float bf2f(bf16 h) { return __builtin_bit_cast(float, (unsigned)h << 16); }
__device__ __forceinline__ float wave_sum(float v) {
#pragma unroll
    for (int o = 1; o < 64; o <<= 1) v += __shfl_xor(v, o);
    return v;
}
__device__ __forceinline__ unsigned pk4_fp8(float a, float b, float c, float d) {
    a = __builtin_amdgcn_fmed3f(a, -448.f, 448.f); b = __builtin_amdgcn_fmed3f(b, -448.f, 448.f); c = __builtin_amdgcn_fmed3f(c, -448.f, 448.f); d = __builtin_amdgcn_fmed3f(d, -448.f, 448.f);
    int w = 0; w = __builtin_amdgcn_cvt_pk_fp8_f32(a, b, w, false); w = __builtin_amdgcn_cvt_pk_fp8_f32(c, d, w, true); return (unsigned)w;
}
constexpr float F8_SA = 16.f, F8_SW = 256.f, F8_SH = 8.f;
#define LDS_WAIT() asm volatile("s_waitcnt lgkmcnt(0)" ::: "memory")
__device__ __forceinline__ float fsigmoid(float x) { return __builtin_amdgcn_rcpf(1.f + __builtin_amdgcn_exp2f(x * -1.4426950408889634f)); }
__device__ __forceinline__ float fsilu(float x) { return x * fsigmoid(x); }
__device__ __forceinline__ int lane_id() { int l; asm volatile("v_mbcnt_lo_u32_b32 %0, -1, 0\n\tv_mbcnt_hi_u32_b32 %0, -1, %0" : "=v"(l)); return l; }

#define XB_TMO      128
#define XB_XCNT(j)  (256  + 64 * (j))
#define XB_XSUB(j)  (1280 + 64 * (j))
#define XB_XGEN(j)  (2304 + 64 * (j))
#define XB_TOP      3328
#define XB_TOPGEN   3392
#define XCD_BAR_WORDS 3456
#define XB_SPIN_CAP (1u << 18)
__device__ __forceinline__ unsigned xb_ld(unsigned* p)              { return __hip_atomic_load(p, __ATOMIC_RELAXED, __HIP_MEMORY_SCOPE_AGENT); }
__device__ __forceinline__ unsigned xb_add(unsigned* p, unsigned v) { return __hip_atomic_fetch_add(p, v, __ATOMIC_RELAXED, __HIP_MEMORY_SCOPE_AGENT); }
__device__ __forceinline__ unsigned xb_xcc_id() { return (unsigned)__builtin_amdgcn_s_getreg((3 << 11) | 20) & 0xFu; }
#define XB_SPIN(cond, bar) do { unsigned _sp = 0; while (cond) { __builtin_amdgcn_s_sleep(1); \
    if ((++_sp & 255u) == 0u) { if (xb_ld(&(bar)[XB_TMO])) break; if (_sp > XB_SPIN_CAP) { atomicAdd(&(bar)[XB_TMO], 1u); break; } } } } while (0)
struct XcdBarrier { unsigned* bar; unsigned x; volatile LAS unsigned* st; int wave; };
__device__ __forceinline__ XcdBarrier xcd_barrier_post(unsigned* bar, volatile LAS unsigned* st, int wave) {
    XcdBarrier b; b.bar = bar; b.x = xb_xcc_id(); b.st = st; b.wave = wave;
    if (wave == 0 && lane_id() == 0) (void)xb_add(&bar[XB_XCNT(b.x)], 1u);
    return b;
}
__device__ __forceinline__ void xcd_barrier_complete(unsigned* bar, unsigned x, unsigned& nloc, unsigned& nx) {
    const unsigned G = gridDim.x * gridDim.y * gridDim.z;
    unsigned sum, cnt, mine, sp = 0u;
    for (;;) {
        sum = 0u; cnt = 0u; mine = 0u;
#pragma unroll
        for (unsigned j = 0; j < 16; ++j) { const unsigned c = xb_ld(&bar[XB_XCNT(j)]); sum += c; cnt += (c > 0u) ? 1u : 0u; mine = (j == x) ? c : mine; }
        if (sum == G) break;
        __builtin_amdgcn_s_sleep(1);
        if ((++sp & 255u) == 0u) { if (xb_ld(&bar[XB_TMO])) break; if (sp > XB_SPIN_CAP) { atomicAdd(&bar[XB_TMO], 1u); break; } }
    }
    nloc = mine > 0u ? mine : 1u; nx = cnt > 0u ? cnt : 1u;
}
__device__ __forceinline__ void xcd_barrier(const XcdBarrier& b) {
    asm volatile("s_waitcnt vmcnt(0)" ::: "memory");
    __syncthreads();
    if (b.wave == 0 && lane_id() == 0) {
        unsigned* bar = b.bar;
        __builtin_amdgcn_s_waitcnt(0);
        unsigned nloc = b.st[0], nx = b.st[1];
        if (nloc == 0u) { xcd_barrier_complete(bar, b.x, nloc, nx); b.st[0] = nloc; b.st[1] = nx; }
        const unsigned old = xb_add(&bar[XB_XSUB(b.x)], 1u);
        const unsigned gen = old / nloc;
        if (old + 1u == (gen + 1u) * nloc) {
            __builtin_amdgcn_fence(__ATOMIC_RELEASE, "agent");
            asm volatile("s_waitcnt vmcnt(0)" ::: "memory");
            const unsigned og = xb_add(&bar[XB_TOP], 1u);
            const unsigned tg = og / nx;
            if (og + 1u == (tg + 1u) * nx) xb_add(&bar[XB_TOPGEN], 1u);
            else XB_SPIN(xb_ld(&bar[XB_TOPGEN]) == tg, bar);
            __builtin_amdgcn_fence(__ATOMIC_ACQUIRE, "agent");
            xb_add(&bar[XB_XGEN(b.x)], 1u);
            asm volatile("s_waitcnt vmcnt(0)" ::: "memory");
        } else {
            XB_SPIN(xb_ld(&bar[XB_XGEN(b.x)]) == gen, bar);
            __builtin_amdgcn_fence(__ATOMIC_ACQUIRE, "agent");
            asm volatile("s_waitcnt vmcnt(0)" ::: "memory");
        }
    }
    __syncthreads();
}

struct Args {
    const float* in[18];
    float* out;
    unsigned char* ws;
    int ph_lo, ph_hi;
};

__device__ __forceinline__ void tr_item(const float* __restrict__ src, int ld, int k0, int c0, int nvalid, bf16* dst, int Kd, float* scr, int lane) {
#pragma unroll 8
    for (int i = 0; i < 32; ++i) { const int kk = 2 * i + (lane >> 5), n = lane & 31; scr[kk * 33 + n] = (n < nvalid) ? src[(size_t)(k0 + kk) * ld + c0 + n] : 0.f; }
    LDS_WAIT();
    const int c = lane & 7;
#pragma unroll
    for (int j = 0; j < 4; ++j) { const int n = (lane >> 3) + 8 * j; const float* s = scr + (8 * c) * 33 + n;
        u32x4 o; o.x = pk2(s[0 * 33], s[1 * 33]); o.y = pk2(s[2 * 33], s[3 * 33]); o.z = pk2(s[4 * 33], s[5 * 33]); o.w = pk2(s[6 * 33], s[7 * 33]);
        *(u32x4*)(dst + (size_t)n * Kd + k0 + 8 * c) = o; }
    LDS_WAIT();
}
__device__ __forceinline__ void tr_item8(const float* __restrict__ src, int ld, int k0, int c0, unsigned char* dst, int Kd, float* scr, int lane) {
#pragma unroll 8
    for (int i = 0; i < 32; ++i) { const int kk = 2 * i + (lane >> 5), n = lane & 31; scr[kk * 33 + n] = src[(size_t)(k0 + kk) * ld + c0 + n] * F8_SW; }
    LDS_WAIT();
    const int c = lane & 7;
#pragma unroll
    for (int j = 0; j < 4; ++j) { const int n = (lane >> 3) + 8 * j; const float* sp = scr + (8 * c) * 33 + n;
        u32x2 o; o.x = pk4_fp8(sp[0 * 33], sp[1 * 33], sp[2 * 33], sp[3 * 33]); o.y = pk4_fp8(sp[4 * 33], sp[5 * 33], sp[6 * 33], sp[7 * 33]);
        *(u32x2*)(dst + (size_t)n * Kd + k0 + 8 * c) = o; }
    LDS_WAIT();
}
__device__ __forceinline__ void conv_phase(const Args& a, unsigned char* lds, int gw, int NGW, int wave, int lane) {
    float* scr = (float*)lds + wave * (64 * 33);
    unsigned char* ws = a.ws;
    constexpr int I_IN = (NIN / 32) * (D / 64);
    constexpr int I_OUT = (D / 32) * (D / 64);
    constexpr int I_GU = (2 * FF / 32) * (D / 64);
    constexpr int I_DN = (D / 32) * (FF / 64);
    constexpr int I_CMP = 2 * 32;
    constexpr int NITEMS = 2 * I_IN + 2 * I_OUT + I_GU + I_DN + NE * (I_GU + I_DN) + 4 * I_CMP;
    for (int it0 = gw; it0 < NITEMS; it0 += NGW) {
        int it = it0;
        if (it < 2 * I_IN) { const int l = it / I_IN, r = it % I_IN, nb = r % (NIN / 32), kb = r / (NIN / 32), n0 = 32 * nb;
            int c0, nv; if (n0 < 1280) { c0 = n0; nv = 32; } else if (n0 < 2816) { c0 = n0 + 24; nv = 32; } else if (n0 == 2816) { c0 = 1280; nv = 24; } else { c0 = 0; nv = 0; }
            tr_item(a.in[2] + (size_t)l * D * INC, INC, 64 * kb, c0, nv, (bf16*)(ws + WS_WIN) + ((size_t)l * NIN + n0) * D, D, scr, lane); continue; }
        it -= 2 * I_IN;
        if (it < 2 * I_OUT) { const int l = it / I_OUT, r = it % I_OUT, nb = r % (D / 32), kb = r / (D / 32), n0 = 32 * nb;
            tr_item(a.in[8] + (size_t)l * D * D, D, 64 * kb, n0, 32, (bf16*)(ws + WS_WOUT) + ((size_t)l * D + n0) * D, D, scr, lane); continue; }
        it -= 2 * I_OUT;
        if (it < I_GU) { const int nb = it % (2 * FF / 32), kb = it / (2 * FF / 32), n0 = 32 * nb, p = n0 >> 8, c = n0 & 255;
#if DENSE_FP8
            tr_item8(c < 128 ? a.in[10] : a.in[11], FF, 64 * kb, 128 * p + (c & 127), (unsigned char*)(ws + WS_WGU) + (size_t)n0 * D, D, scr, lane); continue; }
#else
            tr_item(c < 128 ? a.in[10] : a.in[11], FF, 64 * kb, 128 * p + (c & 127), 32, (bf16*)(ws + WS_WGU) + (size_t)n0 * D, D, scr, lane); continue; }
#endif
        it -= I_GU;
        if (it < I_DN) { const int nb = it % (D / 32), kb = it / (D / 32), n0 = 32 * nb;
#if DENSE_FP8
            tr_item8(a.in[12], D, 64 * kb, n0, (unsigned char*)(ws + WS_WDN) + (size_t)n0 * FF, FF, scr, lane); continue; }
#else
            tr_item(a.in[12], D, 64 * kb, n0, 32, (bf16*)(ws + WS_WDN) + (size_t)n0 * FF, FF, scr, lane); continue; }
#endif
        it -= I_DN;
        if (it < NE * I_GU) { const int e = it / I_GU, r = it % I_GU, nb = r % (2 * FF / 32), kb = r / (2 * FF / 32), n0 = 32 * nb, p = n0 >> 8, c = n0 & 255;
#if MOE_FP8
            tr_item8((c < 128 ? a.in[15] : a.in[16]) + (size_t)e * D * FF, FF, 64 * kb, 128 * p + (c & 127), (unsigned char*)(ws + WS_MGU) + ((size_t)e * 2 * FF + n0) * D, D, scr, lane); continue; }
#else
            tr_item((c < 128 ? a.in[15] : a.in[16]) + (size_t)e * D * FF, FF, 64 * kb, 128 * p + (c & 127), 32, (bf16*)(ws + WS_MGU) + ((size_t)e * 2 * FF + n0) * D, D, scr, lane); continue; }
#endif
        it -= NE * I_GU;
        if (it >= NE * I_DN) { it -= NE * I_DN; const int lw = it / I_CMP, r = it % I_CMP, nb = r & 1, kb = r >> 1;
            tr_item(a.in[6] + (size_t)lw * 2048 * 64, 64, 64 * kb, 32 * nb, 32, (bf16*)(ws + WS_WCT) + ((size_t)lw * 64 + 32 * nb) * 2048, 2048, scr, lane); continue; }
        { const int e = it / I_DN, r = it % I_DN, nb = r % (D / 32), kb = r / (D / 32), n0 = 32 * nb;
#if MOE_FP8
            tr_item8(a.in[17] + (size_t)e * FF * D, D, 64 * kb, n0, (unsigned char*)(ws + WS_MDN) + ((size_t)e * D + n0) * FF, FF, scr, lane); }
#else
            tr_item(a.in[17] + (size_t)e * FF * D, D, 64 * kb, n0, 32, (bf16*)(ws + WS_MDN) + ((size_t)e * D + n0) * FF, FF, scr, lane); }
#endif
    }
}

template <bool ROUTE, bool OUT8 = false>
__device__ __forceinline__ void norm_phase(const Args& a, unsigned char* lds, const float* x, const float* g, bf16* out, int blk, int G, int wave, int lane, int tid) {
    const int RPB = M / G;
    int* r_e = (int*)lds;
    float* r_w = (float*)(lds + 8192);
    const float* router = a.in[13]; const float* rb = a.in[14];
    f32x4 gv[4];
#pragma unroll
    for (int j = 0; j < 4; ++j) gv[j] = ((const f32x4*)g)[64 * j + lane];
    f32x4 vn[4];
    { const f32x4* xr0 = (const f32x4*)(x + (size_t)(blk * RPB + wave) * D) + lane;
#pragma unroll
        for (int j = 0; j < 4; ++j) vn[j] = xr0[64 * j]; }
    for (int rl = wave; rl < RPB; rl += NWAVES) {
        const int m = blk * RPB + rl;
        f32x4 v[4]; float ss = 0.f;
#pragma unroll
        for (int j = 0; j < 4; ++j) v[j] = vn[j];
        if (rl + NWAVES < RPB) { const f32x4* xr1 = (const f32x4*)(x + (size_t)(m + NWAVES) * D) + lane;
#pragma unroll
            for (int j = 0; j < 4; ++j) vn[j] = xr1[64 * j]; }
#pragma unroll
        for (int j = 0; j < 4; ++j) ss += (v[j].x * v[j].x + v[j].y * v[j].y) + (v[j].z * v[j].z + v[j].w * v[j].w);
        const float rstd = 1.0f / sqrtf(wave_sum(ss) * (1.f / D) + EPS);
        if (OUT8) {
            unsigned* o4 = (unsigned*)((unsigned char*)out + (size_t)m * D) + lane;
#pragma unroll
            for (int j = 0; j < 4; ++j) { v[j] = v[j] * rstd * gv[j]; o4[64 * j] = pk4_fp8(v[j].x * F8_SA, v[j].y * F8_SA, v[j].z * F8_SA, v[j].w * F8_SA); }
        } else {
        u32x2* o8 = (u32x2*)(out + (size_t)m * D) + lane;
#pragma unroll
        for (int j = 0; j < 4; ++j) { v[j] = v[j] * rstd * gv[j]; u32x2 w; w.x = pk2(v[j].x, v[j].y); w.y = pk2(v[j].z, v[j].w); o8[64 * j] = w; }
        }
        if (ROUTE) {
            float lg[8];
#pragma unroll
            for (int e = 0; e < 8; ++e) lg[e] = 0.f;
#pragma unroll
            for (int j = 0; j < 4; ++j) {
#pragma unroll
                for (int i = 0; i < 4; ++i) { const int k = 4 * (64 * j + lane) + i; const f32x4 r0 = *(const f32x4*)(router + (size_t)k * 8), r1 = *(const f32x4*)(router + (size_t)k * 8 + 4); const float xv = v[j][i];
                    lg[0] += xv * r0.x; lg[1] += xv * r0.y; lg[2] += xv * r0.z; lg[3] += xv * r0.w; lg[4] += xv * r1.x; lg[5] += xv * r1.y; lg[6] += xv * r1.z; lg[7] += xv * r1.w; }
            }
#pragma unroll
            for (int e = 0; e < 8; ++e) lg[e] = wave_sum(lg[e]) + rb[e];
            int i0 = 0; float v0 = lg[0];
#pragma unroll
            for (int e = 1; e < 8; ++e) if (lg[e] > v0) { v0 = lg[e]; i0 = e; }
            int i1 = -1; float v1 = -3.0e38f;
#pragma unroll
            for (int e = 0; e < 8; ++e) if (e != i0 && lg[e] > v1) { v1 = lg[e]; i1 = e; }
            const float w1 = 1.f / (1.f + __expf(v0 - v1)), w0 = 1.f - w1;
            if (lane == 0) { r_e[2 * rl] = i0; r_e[2 * rl + 1] = i1; r_w[2 * rl] = w0; r_w[2 * rl + 1] = w1; }
        }
    }
    if (ROUTE) {
        __syncthreads();
        if (tid < 16) {
            const int s = tid >> 3, e = tid & 7; int n = 0;
            for (int rl = 0; rl < RPB; ++rl) n += (r_e[2 * rl + s] == e) ? 1 : 0;
            int* cnt = (int*)(a.ws + WS_CTL) + CW_CNT;
            int base = n ? atomicAdd(&cnt[s * 8 + e], n) : 0;
            int* tok = (int*)(a.ws + WS_RTOK) + (size_t)(s * 8 + e) * M; float* wt = (float*)(a.ws + WS_RWT) + (size_t)(s * 8 + e) * M;
            for (int rl = 0; rl < RPB; ++rl) if (r_e[2 * rl + s] == e) { tok[base] = blk * RPB + rl; wt[base] = r_w[2 * rl + s]; ++base; }
        }
        __syncthreads();
    }
}

__device__ __forceinline__ void post_phase(const Args& a, unsigned char* lds, int l, int blk, int G, int wave, int lane, int tid) {
    bf16* proj = (bf16*)(a.ws + WS_PROJ);
    const int gw = blk * NWAVES + wave, NGW = G * NWAVES;
    {
        const float* qg = a.in[3] + l * 64; const float* kg = a.in[4] + l * 192;
        const int sub = lane & 7;
        for (int v0 = gw * 8; v0 < M * 12; v0 += NGW * 8) {
            const int vec = v0 + (lane >> 3), m = vec / 12, j = vec % 12;
            int col; const float* gp; float sc = 1.f;
            if (j < 8) { col = C_Q + 64 * j; gp = qg; sc = 0.125f * LOG2E; } else if (j < 10) { col = C_KS + 64 * (j - 8); gp = kg + 64; } else { col = C_KW + 64 * (j - 10); gp = kg + 128; }
            u32x4* p = (u32x4*)(proj + (size_t)m * PC + col + 8 * sub);
            const u32x4 u = *p;
            float f[8] = {bflo(u.x), bfhi(u.x), bflo(u.y), bfhi(u.y), bflo(u.z), bfhi(u.z), bflo(u.w), bfhi(u.w)};
            float ss = 0.f;
#pragma unroll
            for (int i = 0; i < 8; ++i) ss += f[i] * f[i];
            ss += __shfl_xor(ss, 1); ss += __shfl_xor(ss, 2); ss += __shfl_xor(ss, 4);
            const float rs = sc / sqrtf(ss * (1.f / 64.f) + EPS);
            const f32x4 g0 = *(const f32x4*)(gp + 8 * sub), g1 = *(const f32x4*)(gp + 8 * sub + 4);
            u32x4 o; o.x = pk2(f[0] * rs * g0.x, f[1] * rs * g0.y); o.y = pk2(f[2] * rs * g0.z, f[3] * rs * g0.w); o.z = pk2(f[4] * rs * g1.x, f[5] * rs * g1.y); o.w = pk2(f[6] * rs * g1.z, f[7] * rs * g1.w);
            *p = o;
            if (j >= 8) { const int gg = (j - 8) & 1, bb = m / T, tt = m % T, kk = tt & 31, nn = (kk & 0x13) | ((kk & 4) << 1) | ((kk & 8) >> 1);
                *(u32x4*)((bf16*)(a.ws + (j < 10 ? WS_KS : WS_KW)) + (size_t)(bb * 2 + gg) * T * 64 + ((size_t)((tt >> 5) * 4 + (sub >> 1)) * 64 + (sub & 1) * 32 + nn) * 8) = o; }
        }
    }
    {
        const int dim = tid & 63, tq = tid >> 6;
        for (int u = blk; u < 2 * NB * 2 * 128; u += G) {
            const int which = u >> 10, b = (u >> 8) & 3, g = (u >> 7) & 1, ch = u & 127;
            const bf16* src = proj + ((size_t)b * T + ch * 64 + 8 * tq) * PC + (which ? C_VW : C_VS) + 64 * g + dim;
            unsigned short v[8];
#pragma unroll
            for (int i = 0; i < 8; ++i) v[i] = src[(size_t)i * PC];
            u32x4 o; o.x = v[0] | ((unsigned)v[1] << 16); o.y = v[2] | ((unsigned)v[3] << 16); o.z = v[4] | ((unsigned)v[5] << 16); o.w = v[6] | ((unsigned)v[7] << 16);
            { const int t8 = ch * 64 + 8 * tq, tile = t8 >> 5, ko = t8 & 31;
                *(u32x4*)((bf16*)(a.ws + (which ? WS_VWT : WS_VST)) + (size_t)(b * 2 + g) * 64 * T + ((size_t)((tile * 2 + (ko >> 4)) * 2 + (dim >> 5)) * 64 + ((ko >> 3) & 1) * 32 + (dim & 31)) * 8) = o; }
        }
    }
    {
        const float* kg0 = a.in[4] + l * 192;
        const float* cbias = (const float*)(a.ws + WS_CTL) + CW_CBIAS + l * 128;
        float* red = (float*)lds;
        const int n = lane & 31, h = lane >> 5;
        for (int u = blk; u < 2 * NB * 2 * 16; u += G) {
            const int which = u >> 7, b = (u >> 5) & 3, g = (u >> 4) & 1, rt = u & 15;
            const bf16* arow = proj + ((size_t)b * T + 16 * (32 * rt + n) + 4 * wave) * PC + (which ? C_VC : C_KC) + g * 64 + 8 * h;
            const bf16* wt = (const bf16*)(a.ws + WS_WCT) + ((size_t)(l * 2 + which) * 64 + n) * 2048 + 256 * wave + 8 * h;
            f32x16 acc0, acc1;
#pragma unroll
            for (int i = 0; i < 16; ++i) { acc0[i] = 0.f; acc1[i] = 0.f; }
#pragma unroll
            for (int ks = 0; ks < 16; ++ks) {
                const bf16x8 af = *(const bf16x8*)(arow + (size_t)(ks >> 2) * PC + 16 * (ks & 3));
                const bf16x8 b0 = *(const bf16x8*)(wt + 16 * ks), b1 = *(const bf16x8*)(wt + 32 * 2048 + 16 * ks);
                acc0 = __builtin_amdgcn_mfma_f32_32x32x16_bf16(af, b0, acc0, 0, 0, 0); acc1 = __builtin_amdgcn_mfma_f32_32x32x16_bf16(af, b1, acc1, 0, 0, 0);
            }
            __syncthreads();
#pragma unroll
            for (int i = 0; i < 16; ++i) { const int row = 8 * (i >> 2) + 4 * h + (i & 3); red[(wave * 32 + row) * 64 + n] = acc0[i]; red[(wave * 32 + row) * 64 + 32 + n] = acc1[i]; }
            __syncthreads();
            { const int row = tid >> 4, n4 = (tid & 15) * 4, c = 32 * rt + row;
                f32x4 sum = *(const f32x4*)(cbias + which * 64 + n4);
#pragma unroll
                for (int w = 0; w < 8; ++w) sum = sum + *(const f32x4*)(red + (w * 32 + row) * 64 + n4);
                if (which == 0) { float ss = sum.x * sum.x + sum.y * sum.y + sum.z * sum.z + sum.w * sum.w;
                    ss += __shfl_xor(ss, 1); ss += __shfl_xor(ss, 2); ss += __shfl_xor(ss, 4); ss += __shfl_xor(ss, 8);
                    const float rs = 1.f / sqrtf(ss * (1.f / 64.f) + EPS); const f32x4 gg = *(const f32x4*)(kg0 + n4); sum = sum * rs * gg; }
                if (c >= 511) sum = (f32x4){0.f, 0.f, 0.f, 0.f};
                u32x2 o; o.x = pk2(sum.x, sum.y); o.y = pk2(sum.z, sum.w);
                *(u32x2*)((bf16*)(a.ws + (which ? WS_VCMP : WS_KCMP)) + ((size_t)(b * 2 + g) * NCB + c) * 64 + n4) = o;
                const int ko = c & 31;
                if (which) {
                    bf16* dT = (bf16*)(a.ws + WS_VCT) + (size_t)(b * 2 + g) * 64 * NCB + ((size_t)(((c >> 5) * 2 + (ko >> 4)) * 2 + (n4 >> 5)) * 64 + ((ko >> 3) & 1) * 32 + (n4 & 31)) * 8 + (ko & 7);
                    dT[0] = (bf16)(o.x & 0xffffu); dT[8] = (bf16)(o.x >> 16); dT[16] = (bf16)(o.y & 0xffffu); dT[24] = (bf16)(o.y >> 16);
                } else {
                    const int nn = (ko & 0x13) | ((ko & 4) << 1) | ((ko & 8) >> 1);
                    *(u32x2*)((bf16*)(a.ws + WS_KCF) + (size_t)(b * 2 + g) * NCB * 64 + ((size_t)((c >> 5) * 4 + (n4 >> 4)) * 64 + ((n4 >> 3) & 1) * 32 + nn) * 8 + (n4 & 7)) = o; } }
        }
        __syncthreads();
    }
    {
        float* rets = (float*)(a.ws + WS_RETS);
        float* Ksf = (float*)lds;
        float* Vsf = Ksf + 128 * 32;
        const int d = tid >> 4, e4 = (tid & 15) * 4;
        for (int u = blk; u < NB * 8 * 64; u += G) {
            const int b = u >> 9, h = (u >> 6) & 7, c = u & 63;
            const float lg2 = log2f(1.f - exp2f(-5.f - (float)h));
            const bf16* base = proj + ((size_t)b * T + c * 128) * PC;
            __syncthreads();
            { const int row = tid >> 2, pc = tid & 3; const u32x4 uk = *(const u32x4*)(base + (size_t)row * PC + C_RK + 32 * h + 8 * pc); const float z = exp2f((float)(127 - row) * lg2);
                *(f32x4*)(Ksf + row * 32 + 8 * pc) = (f32x4){bflo(uk.x) * z, bfhi(uk.x) * z, bflo(uk.y) * z, bfhi(uk.y) * z};
                *(f32x4*)(Ksf + row * 32 + 8 * pc + 4) = (f32x4){bflo(uk.z) * z, bfhi(uk.z) * z, bflo(uk.w) * z, bfhi(uk.w) * z}; }
#pragma unroll
            for (int it = 0; it < 2; ++it) { const int idx = tid + NTHR * it, row = idx >> 3, pc = idx & 7; const u32x4 uv = *(const u32x4*)(base + (size_t)row * PC + C_RV + 64 * h + 8 * pc);
                *(f32x4*)(Vsf + row * 64 + 8 * pc) = (f32x4){bflo(uv.x), bfhi(uv.x), bflo(uv.y), bfhi(uv.y)};
                *(f32x4*)(Vsf + row * 64 + 8 * pc + 4) = (f32x4){bflo(uv.z), bfhi(uv.z), bflo(uv.w), bfhi(uv.w)}; }
            __syncthreads();
            f32x4 acc = (f32x4){0.f, 0.f, 0.f, 0.f};
#pragma unroll 8
            for (int j = 0; j < 128; ++j) { const float kz = Ksf[j * 32 + d]; acc = acc + *(const f32x4*)(Vsf + j * 64 + e4) * kz; }
            *(f32x4*)(rets + ((size_t)(b * 8 + h) * 64 + c) * 2048 + d * 64 + e4) = acc;
        }
        __syncthreads();
    }
}

__device__ __forceinline__ void scan_phase(const Args& a, int blk, int G, int tid) {
    float* rets = (float*)(a.ws + WS_RETS);
    if (tid < 256) {
        const int i = blk * 256 + tid;
        if (i < 32 * 2048) {
            const int bh = i >> 11, idx = i & 2047, h = bh & 7;
            const float gc = exp2f(128.f * log2f(1.f - exp2f(-5.f - (float)h)));
            float* p = rets + (size_t)bh * 64 * 2048 + idx;
            bf16* st = (bf16*)(a.ws + WS_RST) + (size_t)bh * 64 * 2048 + (idx & 63) * 32 + (idx >> 6);
            float tv[64];
#pragma unroll
            for (int c = 0; c < 64; ++c) tv[c] = p[(size_t)c * 2048];
            float S = 0.f;
#pragma unroll
            for (int c = 0; c < 64; ++c) { p[(size_t)c * 2048] = S; st[(size_t)c * 2048] = (bf16)f2bf(S); S = S * gc + tv[c]; }
        }
    }
}

__device__ __forceinline__ float dot32(const float (&q)[32], const bf16* kp) {
    const u32x4* p = (const u32x4*)kp; float s = 0.f;
#pragma unroll
    for (int i = 0; i < 4; ++i) { const u32x4 u = p[i];
        s += q[8 * i + 0] * bflo(u.x) + q[8 * i + 1] * bfhi(u.x) + q[8 * i + 2] * bflo(u.y) + q[8 * i + 3] * bfhi(u.y) + q[8 * i + 4] * bflo(u.z) + q[8 * i + 5] * bfhi(u.z) + q[8 * i + 6] * bflo(u.w) + q[8 * i + 7] * bfhi(u.w); }
    return s;
}
__device__ __forceinline__ float dot16(const float (&q)[16], const bf16* kp) {
    const u32x4* p = (const u32x4*)kp; float s = 0.f;
#pragma unroll
    for (int i = 0; i < 2; ++i) { const u32x4 u = p[i];
        s += q[8 * i + 0] * bflo(u.x) + q[8 * i + 1] * bfhi(u.x) + q[8 * i + 2] * bflo(u.y) + q[8 * i + 3] * bfhi(u.y) + q[8 * i + 4] * bflo(u.z) + q[8 * i + 5] * bfhi(u.z) + q[8 * i + 6] * bflo(u.w) + q[8 * i + 7] * bfhi(u.w); }
    return s;
}
__device__ __forceinline__ void axpy16(float (&o)[16], float p, const bf16* vp) {
    const u32x4* q = (const u32x4*)vp;
#pragma unroll
    for (int i = 0; i < 2; ++i) { const u32x4 u = q[i];
        o[8 * i + 0] += p * bflo(u.x); o[8 * i + 1] += p * bfhi(u.x); o[8 * i + 2] += p * bflo(u.y); o[8 * i + 3] += p * bfhi(u.y); o[8 * i + 4] += p * bflo(u.z); o[8 * i + 5] += p * bfhi(u.z); o[8 * i + 6] += p * bflo(u.w); o[8 * i + 7] += p * bfhi(u.w); }
}
__device__ __forceinline__ void nsa_phase(const Args& a, unsigned char* lds, int blk, int G, int tid) {
    const bf16* proj = (const bf16*)(a.ws + WS_PROJ);
    const float* gates = (const float*)(a.ws + WS_GATES);
    bf16* mix = (bf16*)(a.ws + WS_HN);
    float* impH = (float*)lds;
    unsigned* selm = (unsigned*)(lds + SELM_OFF);
    const int tl = tid >> 4, r = (tid >> 2) & 3, qt = tid & 3;
    for (int u = blk; u < NB * 2 * 256; u += G) {
        const int b = u >> 9, g = (u >> 8) & 1, tb = u & 255, cur = tb >> 1;
        const int hq = 4 * g + r, t = 32 * tb + tl; const size_t m = (size_t)b * T + t;
        const float slope = exp2f(-(float)(hq + 1)) * LOG2E;
        float q[16], res[16], o[16];
        { const u32x4* p = (const u32x4*)(proj + m * PC + C_Q + 64 * hq + 16 * qt);
#pragma unroll
            for (int i = 0; i < 2; ++i) { const u32x4 uu = p[i]; q[8 * i] = bflo(uu.x); q[8 * i + 1] = bfhi(uu.x); q[8 * i + 2] = bflo(uu.y); q[8 * i + 3] = bfhi(uu.y); q[8 * i + 4] = bflo(uu.z); q[8 * i + 5] = bfhi(uu.z); q[8 * i + 6] = bflo(uu.w); q[8 * i + 7] = bfhi(uu.w); } }
#pragma unroll
        for (int i = 0; i < 16; ++i) res[i] = 0.f;
        const float g0 = gates[m * 24 + 3 * hq], g1 = gates[m * 24 + 3 * hq + 1], g2 = gates[m * 24 + 3 * hq + 2];
        float* myimp = impH + (tl * 4 + r) * 128;
        for (int s = 32 * qt; s < 32 * qt + 32; ++s) myimp[s] = 0.f;
        if (tid < 128) selm[tid] = 0u;
        __syncthreads();
        const int ncv = t >= 31 ? ((t - 31) >> 4) + 1 : 0;
        const bf16* kc = (const bf16*)(a.ws + WS_KCMP) + (size_t)(b * 2 + g) * NCB * 64 + 16 * qt;
        const bf16* vc = (const bf16*)(a.ws + WS_VCMP) + (size_t)(b * 2 + g) * NCB * 64 + 16 * qt;
        float mx = -1e30f, lsum = 0.f;
        for (int c = 0; c < ncv; ++c) {
            float s = dot16(q, kc + c * 64); s += __shfl_xor(s, 1); s += __shfl_xor(s, 2); s -= slope * (float)(t - 16 * c - 31);
            const float mn = fmaxf(mx, s); lsum = lsum * exp2f(mx - mn) + exp2f(s - mn); mx = mn;
        }
        const float il = 1.f / lsum;
        for (int c = 0; c < ncv; ++c) {
            float s = dot16(q, kc + c * 64); s += __shfl_xor(s, 1); s += __shfl_xor(s, 2); s -= slope * (float)(t - 16 * c - 31);
            const float p = exp2f(s - mx) * il;
            axpy16(res, g0 * p, vc + c * 64);
            if (qt == 0) { const int sb = c >> 2; if ((c & 3) == 3) { myimp[sb] += 0.5f * p; if (sb + 1 < 128) myimp[sb + 1] += 0.5f * p; } else myimp[sb] += p; }
        }
        __syncthreads();
        for (int idx = tid; idx < 32 * 128; idx += NTHR) {
            const int tl2 = idx >> 7, s = idx & 127; float* p = impH + tl2 * 512 + s;
            const float v = (p[0] + p[128]) + (p[256] + p[384]);
            const bool forced = (s == 0) || (s == cur) || (s == cur - 1), valid = s <= cur;
            p[0] = forced ? 1e9f : (valid ? v : -1e9f);
        }
        __syncthreads();
        { const int k16 = tid & 15; const float* val = impH + tl * 512; unsigned bits = 0u;
#pragma unroll 1
            for (int ii = 0; ii < 8; ++ii) { const int i = 8 * k16 + ii; const float vi = val[i]; int rank = 0;
#pragma unroll 4
                for (int j = 0; j < 128; ++j) { const float vj = val[j]; rank += ((vj > vi) || (vj == vi && j < i)) ? 1 : 0; }
                if (rank < 16 && i <= cur) bits |= 1u << ii; }
            atomicOr(&selm[tl * 4 + (k16 >> 2)], bits << (8 * (k16 & 3))); }
        __syncthreads();
        {
            const bf16* kb = proj + (size_t)b * T * PC + C_KS + 64 * g + 16 * qt; const bf16* vb = proj + (size_t)b * T * PC + C_VS + 64 * g + 16 * qt;
            mx = -1e30f; lsum = 0.f;
#pragma unroll
            for (int i = 0; i < 16; ++i) o[i] = 0.f;
            for (int w = 0; w < 4; ++w) { unsigned word = selm[tl * 4 + w];
                while (word) { const int bit = __ffs(word) - 1; word &= word - 1u; const int sblk = 32 * w + bit;
                    const int pend = min(64 * sblk + 63, t);
                    for (int pos = 64 * sblk; pos <= pend; ++pos) {
                        float s = dot16(q, kb + (size_t)pos * PC); s += __shfl_xor(s, 1); s += __shfl_xor(s, 2); s -= slope * (float)(t - pos);
                        const float mn = fmaxf(mx, s), cr = exp2f(mx - mn), p = exp2f(s - mn); lsum = lsum * cr + p; mx = mn;
#pragma unroll
                        for (int i = 0; i < 16; ++i) o[i] *= cr;
                        axpy16(o, p, vb + (size_t)pos * PC);
                    } } }
            const float sc = g1 / lsum;
#pragma unroll
            for (int i = 0; i < 16; ++i) res[i] += sc * o[i];
        }
        {
            const bf16* kb = proj + (size_t)b * T * PC + C_KW + 64 * g + 16 * qt; const bf16* vb = proj + (size_t)b * T * PC + C_VW + 64 * g + 16 * qt;
            mx = -1e30f; lsum = 0.f;
#pragma unroll
            for (int i = 0; i < 16; ++i) o[i] = 0.f;
            for (int pos = max(0, t - 511); pos <= t; ++pos) {
                float s = dot16(q, kb + (size_t)pos * PC); s += __shfl_xor(s, 1); s += __shfl_xor(s, 2); s -= slope * (float)(t - pos);
                const float mn = fmaxf(mx, s), cr = exp2f(mx - mn), p = exp2f(s - mn); lsum = lsum * cr + p; mx = mn;
#pragma unroll
                for (int i = 0; i < 16; ++i) o[i] *= cr;
                axpy16(o, p, vb + (size_t)pos * PC);
            }
            const float sc = g2 / lsum;
#pragma unroll
            for (int i = 0; i < 16; ++i) res[i] += sc * o[i];
        }
        { u32x4* op = (u32x4*)(mix + m * D + 64 * hq + 16 * qt);
#pragma unroll
            for (int i = 0; i < 2; ++i) { u32x4 w; w.x = pk2(res[8 * i], res[8 * i + 1]); w.y = pk2(res[8 * i + 2], res[8 * i + 3]); w.z = pk2(res[8 * i + 4], res[8 * i + 5]); w.w = pk2(res[8 * i + 6], res[8 * i + 7]); op[i] = w; } }
        __syncthreads();
    }
}
#define MFMA32(a, b, c) __builtin_amdgcn_mfma_f32_32x32x16_bf16(a, b, c, 0, 0, 0)
constexpr float NSA_NEG = -1e30f;
__device__ __forceinline__ float ex2(float x) { return __builtin_amdgcn_exp2f(x); }
typedef __amdgpu_buffer_rsrc_t brsrc_t;
__device__ __forceinline__ brsrc_t nsa_rsrc(const bf16* base, int nbytes) { return __builtin_amdgcn_make_buffer_rsrc((void*)base, (short)0, nbytes, 0x00020000); }
__device__ __forceinline__ void nsa_ldk(bf16x8 (&kf)[4], brsrc_t rs, int tile, unsigned voff) {
#pragma unroll
    for (int ks = 0; ks < 4; ++ks) kf[ks] = __builtin_bit_cast(bf16x8, __builtin_amdgcn_raw_buffer_load_b128(rs, voff + 1024u * ks, tile * 4096, 0));
}
__device__ __forceinline__ void nsa_ldv(bf16x8 (&vf)[4], brsrc_t rs, int tile, unsigned voff) {
#pragma unroll
    for (int q = 0; q < 4; ++q) vf[q] = __builtin_bit_cast(bf16x8, __builtin_amdgcn_raw_buffer_load_b128(rs, voff + 1024u * q, tile * 4096, 0));
}
__device__ __forceinline__ void nsa_qk(const bf16x8 (&kf)[4], const bf16x8 (&qf)[4], const bf16x8& kaug, unsigned slpk, float c, f32x16& u) {
    f32x16 acc;
#pragma unroll
    for (int i = 0; i < 16; ++i) acc[i] = 0.f;
    const unsigned hp = pk2(c, c); const float hif = bflo(hp);
    u32x4 w; w.x = slpk; w.y = pk2(hif, c - hif); w.z = 0u; w.w = 0u;
    acc = MFMA32(kaug, __builtin_bit_cast(bf16x8, w), acc);
#pragma unroll
    for (int ks = 0; ks < 4; ++ks) acc = MFMA32(kf[ks], qf[ks], acc);
    u = acc;
}
__device__ __forceinline__ void nsa_qk2(const bf16x8 (&kA)[4], const bf16x8 (&kB)[4], const bf16x8 (&qf)[4], const bf16x8& kaug, unsigned slpk, float cA, float cB, f32x16& uA, f32x16& uB) {
    f32x16 a0, a1;
#pragma unroll
    for (int i = 0; i < 16; ++i) { a0[i] = 0.f; a1[i] = 0.f; }
    u32x4 wA, wB;
    { const unsigned hp = pk2(cA, cA); const float hif = bflo(hp); wA.x = slpk; wA.y = pk2(hif, cA - hif); wA.z = 0u; wA.w = 0u; }
    { const unsigned hp = pk2(cB, cB); const float hif = bflo(hp); wB.x = slpk; wB.y = pk2(hif, cB - hif); wB.z = 0u; wB.w = 0u; }
    a0 = MFMA32(kaug, __builtin_bit_cast(bf16x8, wA), a0); a1 = MFMA32(kaug, __builtin_bit_cast(bf16x8, wB), a1);
#pragma unroll
    for (int ks = 0; ks < 4; ++ks) { a0 = MFMA32(kA[ks], qf[ks], a0); a1 = MFMA32(kB[ks], qf[ks], a1); }
    uA = a0; uB = a1;
}
__device__ __forceinline__ void nsa_mask(f32x16& u, int kminp, int kmaxp) {
#pragma unroll
    for (int i = 0; i < 16; ++i) { const int c = 16 * (i >> 3) + (i & 7); u[i] = (c >= kminp && c <= kmaxp) ? u[i] : NSA_NEG; }
}
__device__ __forceinline__ bf16x8 nsa_pack8(const f32x16& p, int j) {
    u32x4 w; w.x = pk2(p[8 * j], p[8 * j + 1]); w.y = pk2(p[8 * j + 2], p[8 * j + 3]); w.z = pk2(p[8 * j + 4], p[8 * j + 5]); w.w = pk2(p[8 * j + 6], p[8 * j + 7]);
    return __builtin_bit_cast(bf16x8, w);
}
__device__ __forceinline__ void nsa_pv(const bf16x8 (&vf)[4], const f32x16& p, f32x16 (&O)[2]) {
#pragma unroll
    for (int j = 0; j < 2; ++j) { const bf16x8 pb = nsa_pack8(p, j);
#pragma unroll
        for (int dt = 0; dt < 2; ++dt) O[dt] = MFMA32(vf[2 * j + dt], pb, O[dt]); }
}
__device__ __forceinline__ void nsa_expv(const f32x16& u, f32x16& p, float& lpart, f32x16 (&O)[2], const bf16x8 (&vf)[4]) {
    float lt = 0.f;
#pragma unroll
    for (int i = 0; i < 8; ++i) { p[i] = ex2(u[i]); lt += p[i]; }
    { const bf16x8 pb = nsa_pack8(p, 0); O[0] = MFMA32(vf[0], pb, O[0]); O[1] = MFMA32(vf[1], pb, O[1]); }
    __builtin_amdgcn_sched_barrier(0);
#pragma unroll
    for (int i = 8; i < 16; ++i) { p[i] = ex2(u[i]); lt += p[i]; }
    { const bf16x8 pb = nsa_pack8(p, 1); O[0] = MFMA32(vf[2], pb, O[0]); O[1] = MFMA32(vf[3], pb, O[1]); }
    lpart += lt;
}
struct SlcIt { unsigned w[4]; int sblk, half; };
__device__ __forceinline__ int slc_next(SlcIt& it, int tmax) {
    if (it.half == 1) { it.half = 0; return 64 * it.sblk; }
    int wi = it.w[3] ? 3 : it.w[2] ? 2 : it.w[1] ? 1 : it.w[0] ? 0 : -1;
    if (wi < 0) return -1;
    const unsigned word = wi == 3 ? it.w[3] : wi == 2 ? it.w[2] : wi == 1 ? it.w[1] : it.w[0];
    const int bit = 31 - __builtin_clz(word); const unsigned nw = word & ~(1u << bit);
    if (wi == 3) it.w[3] = nw; else if (wi == 2) it.w[2] = nw; else if (wi == 1) it.w[1] = nw; else it.w[0] = nw;
    it.sblk = 32 * wi + bit;
    if (64 * it.sblk + 32 <= tmax) { it.half = 1; return 64 * it.sblk + 32; }
    it.half = 0; return 64 * it.sblk;
}
__device__ __forceinline__ float dpp_xor1(float x) { return __builtin_bit_cast(float, __builtin_amdgcn_update_dpp(0, __builtin_bit_cast(int, x), 0xB1, 0xf, 0xf, true)); }
__device__ __forceinline__ float dpp_xor2(float x) { return __builtin_bit_cast(float, __builtin_amdgcn_update_dpp(0, __builtin_bit_cast(int, x), 0x4E, 0xf, 0xf, true)); }
__device__ __forceinline__ void nsa_res(float* resL, unsigned voff, const f32x16 (&O)[2], float sc, bool first) {
#pragma unroll
    for (int q = 0; q < 8; ++q) { f32x4* p = (f32x4*)((char*)resL + q * 1024 + voff);
        const f32x4 o = (f32x4){O[q >> 2][4 * (q & 3)], O[q >> 2][4 * (q & 3) + 1], O[q >> 2][4 * (q & 3) + 2], O[q >> 2][4 * (q & 3) + 3]} * sc;
        *p = first ? o : (*p + o);
        if (q & 1) asm volatile("" ::: "memory"); }
}
__device__ __forceinline__ bf16x8 nsa_kaug(unsigned kapk, int h) { u32x4 w; w.x = kapk; w.y = h ? 0u : 0x3f803f80u; w.z = 0u; w.w = 0u; return __builtin_bit_cast(bf16x8, w); }
__device__ __forceinline__ void nsa_fast_phase(const Args& a, unsigned char* lds, int l, int blk, int G, int wave) {
    const bf16* proj = (const bf16*)(a.ws + WS_PROJ);
    const float* gates = (const float*)(a.ws + WS_GATES);
    bf16* mix = (bf16*)(a.ws + WS_HN);
    const int lane = lane_id(), n = lane & 31, h = lane >> 5, tq = n >> 2, r = n & 3;
    const int krow = (n & 0x13) | ((n & 4) << 1) | ((n & 8) >> 1);
    const unsigned voff = (unsigned)lane * 16u;
    float* imp = (float*)lds + wave * (8 * 128);
    float* resL = (float*)(lds + 32768) + wave * 2048;
    unsigned* selw = (unsigned*)(lds + SELM_OFF) + wave * 32;
    const unsigned kapk = h ? 0u : pk2((float)krow, (float)krow);
#define kaug nsa_kaug(kapk, h)
    float gmax; { const float* kg = a.in[4] + l * 192; gmax = fmaxf(fmaxf(fabsf(kg[lane]), fabsf(kg[64 + lane])), fabsf(kg[128 + lane]));
#pragma unroll
        for (int o = 1; o < 64; o <<= 1) gmax = fmaxf(gmax, __shfl_xor(gmax, o));
        gmax = __builtin_bit_cast(float, __builtin_amdgcn_readfirstlane(__builtin_bit_cast(int, gmax))); }
    for (int u = blk; u < NB * 2 * 128; u += G) {
        const int b = u >> 8, g = (u >> 7) & 1, tb = ((u & 127) + 32 * (u >> 8)) & 127;
        const int hq = 4 * g + r, t0 = 64 * tb + 8 * wave, t = t0 + tq;
#define m ((size_t)b * T + t)
        const float sl2 = ex2(-(float)(hq + 1)) * LOG2E;
        bf16x8 qf[4];
#pragma unroll
        for (int ks = 0; ks < 4; ++ks) qf[ks] = *(const bf16x8*)(proj + m * PC + C_Q + 64 * hq + 16 * ks + 8 * h);
        float Ccol; { float qq = 0.f;
#pragma unroll
            for (int ks = 0; ks < 4; ++ks) { const u32x4 w = __builtin_bit_cast(u32x4, qf[ks]);
                qq += bflo(w.x) * bflo(w.x) + bfhi(w.x) * bfhi(w.x) + bflo(w.y) * bflo(w.y) + bfhi(w.y) * bfhi(w.y) + bflo(w.z) * bflo(w.z) + bfhi(w.z) * bfhi(w.z) + bflo(w.w) * bflo(w.w) + bfhi(w.w) * bfhi(w.w); }
            qq += __shfl_xor(qq, 32); Ccol = sqrtf(qq) * 8.f * gmax; }
        unsigned slpk1, slpk16; { const unsigned hp = pk2(sl2, sl2); const float hif = bflo(hp); slpk1 = pk2(hif, sl2 - hif); const float s16 = 16.f * sl2; const unsigned hq2 = pk2(s16, s16); const float h2 = bflo(hq2); slpk16 = pk2(h2, s16 - h2); }
        f32x16 O[2];
#pragma unroll
        for (int i = 0; i < 16; ++i) imp[lane + 64 * i] = 0.f;
        if (lane < 32) selw[lane] = 0u;
        bf16x8 kA[4], kB[4], vA[4], vB[4];
        {
            const brsrc_t KC = nsa_rsrc((const bf16*)(a.ws + WS_KCF) + (size_t)(b * 2 + g) * NCB * 64, NCB * 64 * 2);
            const brsrc_t VCT = nsa_rsrc((const bf16*)(a.ws + WS_VCT) + (size_t)(b * 2 + g) * 64 * NCB, NCB * 64 * 2);
            const int ncv = t >= 31 ? ((t - 31) >> 4) + 1 : 0;
            const int tmax = t0 + 7, ncvmax = tmax >= 31 ? ((tmax - 31) >> 4) + 1 : 0, nct = (ncvmax + 31) >> 5;
            const float c0 = sl2 * (float)(31 - t) - Ccol, c1 = sl2 * 512.f;
            float lp = 0.f;
#define CMP_A(KF, TI) do { f32x16 uu; nsa_qk(KF, qf, kaug, slpk16, c0 + (float)(TI) * c1, uu); \
                if ((TI) == nct - 1) nsa_mask(uu, -1000, ncv - 1 - 32 * (TI) - 8 * h); \
                float lt = 0.f; _Pragma("unroll") for (int i = 0; i < 16; ++i) lt += ex2(uu[i]); lp += lt; } while (0)
            if (nct > 0) nsa_ldk(kA, KC, 0, voff);
            for (int ti = 0; ti < nct; ti += 2) {
                if (ti + 1 < nct) nsa_ldk(kB, KC, ti + 1, voff);
                CMP_A(kA, ti);
                if (ti + 1 >= nct) break;
                if (ti + 2 < nct) nsa_ldk(kA, KC, ti + 2, voff);
                CMP_A(kB, ti + 1);
            }
#undef CMP_A
            lp += __shfl_xor(lp, 32);
            const float cB = ncv > 0 ? c0 - __builtin_amdgcn_logf(lp) : -30000.f;
#pragma unroll
            for (int i = 0; i < 16; ++i) { O[0][i] = 0.f; O[1][i] = 0.f; }
            float dummy = 0.f;
#define CMP_B(KF, VF, TI) do { f32x16 uu; nsa_qk(KF, qf, kaug, slpk16, cB + (float)(TI) * c1, uu); \
                if ((TI) == nct - 1) nsa_mask(uu, -1000, ncv - 1 - 32 * (TI) - 8 * h); \
                f32x16 p; nsa_expv(uu, p, dummy, O, VF); \
                float av[4], bv[4]; \
                _Pragma("unroll") for (int q4 = 0; q4 < 4; ++q4) { const int i0 = 4 * q4; av[q4] = (p[i0] + p[i0 + 1]) + (p[i0 + 2] + 0.5f * p[i0 + 3]); bv[q4] = 0.5f * p[i0 + 3]; } \
                _Pragma("unroll") for (int q4 = 0; q4 < 4; ++q4) { av[q4] += dpp_xor1(av[q4]); av[q4] += dpp_xor2(av[q4]); bv[q4] += dpp_xor1(bv[q4]); bv[q4] += dpp_xor2(bv[q4]); } \
                const float am = r == 0 ? av[0] : r == 1 ? av[1] : r == 2 ? av[2] : av[3], bm = r == 0 ? bv[0] : r == 1 ? bv[1] : r == 2 ? bv[2] : bv[3]; \
                const int sb = 8 * (TI) + 4 * (r >> 1) + 2 * h + (r & 1); \
                atomicAdd(&imp[tq * 128 + sb], am); \
                if (sb + 1 < 128) atomicAdd(&imp[tq * 128 + sb + 1], bm); } while (0)
            if (nct > 0) { nsa_ldk(kA, KC, 0, voff); nsa_ldv(vA, VCT, 0, voff); }
            for (int ti = 0; ti < nct; ti += 2) {
                if (ti + 1 < nct) { nsa_ldk(kB, KC, ti + 1, voff); nsa_ldv(vB, VCT, ti + 1, voff); }
                CMP_B(kA, vA, ti);
                if (ti + 1 >= nct) break;
                if (ti + 2 < nct) { nsa_ldk(kA, KC, ti + 2, voff); nsa_ldv(vA, VCT, ti + 2, voff); }
                CMP_B(kB, vB, ti + 1);
            }
#undef CMP_B
            nsa_res(resL, voff, O, gates[m * 24 + 3 * hq], true);
        }
        {
            const int l2 = lane_id(), tk = l2 >> 3, k8 = l2 & 7, cur = tb;
            float v[16];
#pragma unroll
            for (int k4 = 0; k4 < 4; ++k4) { const f32x4 x = *(const f32x4*)(imp + tk * 128 + 16 * k8 + 4 * k4); v[4 * k4] = x.x; v[4 * k4 + 1] = x.y; v[4 * k4 + 2] = x.z; v[4 * k4 + 3] = x.w; }
#pragma unroll
            for (int k = 0; k < 16; ++k) { const int s2 = 16 * k8 + k; const bool forced = (s2 == 0) || (s2 == cur) || (s2 == cur - 1), valid = s2 <= cur; v[k] = forced ? 1e9f : (valid ? v[k] : -1e9f); }
            unsigned bits = 0u;
#pragma unroll 1
            for (int it = 0; it < 16; ++it) {
                float bvv = v[0]; int bi = 0;
#pragma unroll
                for (int k = 1; k < 16; ++k) if (v[k] > bvv) { bvv = v[k]; bi = k; }
                bi += 16 * k8;
#define TK_STEP(CTRL) do { const float ov = __builtin_bit_cast(float, __builtin_amdgcn_update_dpp(0, __builtin_bit_cast(int, bvv), CTRL, 0xf, 0xf, true)); const int oi = __builtin_amdgcn_update_dpp(0, bi, CTRL, 0xf, 0xf, true); \
                    if (ov > bvv || (ov == bvv && oi < bi)) { bvv = ov; bi = oi; } } while (0)
                TK_STEP(0xB1); TK_STEP(0x4E); TK_STEP(0x141);
#undef TK_STEP
#pragma unroll
                for (int k = 0; k < 16; ++k) if (bi == 16 * k8 + k) { v[k] = -3e38f; if (16 * k8 + k <= cur) bits |= 1u << k; }
            }
            atomicOr(&selw[tk * 4 + (k8 >> 1)], bits << (16 * (k8 & 1)));
        }
        {
            const brsrc_t KS = nsa_rsrc((const bf16*)(a.ws + WS_KS) + (size_t)(b * 2 + g) * T * 64, T * 64 * 2);
            const brsrc_t VST = nsa_rsrc((const bf16*)(a.ws + WS_VST) + (size_t)(b * 2 + g) * 64 * T, T * 64 * 2);
            float lp = 0.f;
#pragma unroll
            for (int i = 0; i < 16; ++i) { O[0][i] = 0.f; O[1][i] = 0.f; }
            SlcIt it; it.half = 0; it.sblk = 0;
#pragma unroll
            for (int w = 0; w < 4; ++w) { unsigned uw = selw[(lane & 7) * 4 + w]; uw |= __shfl_xor(uw, 1); uw |= __shfl_xor(uw, 2); uw |= __shfl_xor(uw, 4); it.w[w] = (unsigned)__builtin_amdgcn_readfirstlane((int)uw); }
            const float cS = -sl2 * (float)t - Ccol;
#define SLC_C(PP, SB) (((selw[tq * 4 + ((SB) >> 5)] >> ((SB) & 31)) & 1u) ? cS + sl2 * (float)(PP) : -30000.f)
#define SLC_M(UU, PP) do { if ((PP) + 31 > t0) nsa_mask(UU, -1000, t - (PP) - 8 * h); } while (0)
            int P0 = slc_next(it, t0 + 7), sb0 = it.sblk;
            int P1 = P0 >= 0 ? slc_next(it, t0 + 7) : -1, sb1 = it.sblk;
            if (P0 >= 0) { nsa_ldk(kA, KS, P0 >> 5, voff); nsa_ldv(vA, VST, P0 >> 5, voff); }
            if (P1 >= 0) { nsa_ldk(kB, KS, P1 >> 5, voff); nsa_ldv(vB, VST, P1 >> 5, voff); }
            while (P0 >= 0) {
                const int P2 = P1 >= 0 ? slc_next(it, t0 + 7) : -1, sb2 = it.sblk;
                const int P3 = P2 >= 0 ? slc_next(it, t0 + 7) : -1, sb3 = it.sblk;
                f32x16 uA, uB, p;
                if (P1 >= 0) {
                    nsa_qk2(kA, kB, qf, kaug, slpk1, SLC_C(P0, sb0), SLC_C(P1, sb1), uA, uB);
                    if (P2 >= 0) nsa_ldk(kA, KS, P2 >> 5, voff);
                    if (P3 >= 0) nsa_ldk(kB, KS, P3 >> 5, voff);
                    SLC_M(uA, P0); SLC_M(uB, P1);
                    nsa_expv(uA, p, lp, O, vA);
                    if (P2 >= 0) nsa_ldv(vA, VST, P2 >> 5, voff);
                    nsa_expv(uB, p, lp, O, vB);
                    if (P3 >= 0) nsa_ldv(vB, VST, P3 >> 5, voff);
                } else {
                    nsa_qk(kA, qf, kaug, slpk1, SLC_C(P0, sb0), uA);
                    SLC_M(uA, P0);
                    nsa_expv(uA, p, lp, O, vA);
                }
                P0 = P2; sb0 = sb2; P1 = P3; sb1 = sb3;
            }
#undef SLC_C
#undef SLC_M
#define SLC_T(KF, VF, PP, SB)
#undef SLC_T
            lp += __shfl_xor(lp, 32);
            nsa_res(resL, voff, O, gates[m * 24 + 3 * hq + 1] * __builtin_amdgcn_rcpf(lp), false);
        }
        {
            const brsrc_t KW = nsa_rsrc((const bf16*)(a.ws + WS_KW) + (size_t)(b * 2 + g) * T * 64, T * 64 * 2);
            const brsrc_t VWT = nsa_rsrc((const bf16*)(a.ws + WS_VWT) + (size_t)(b * 2 + g) * 64 * T, T * 64 * 2);
            float lp = 0.f;
#pragma unroll
            for (int i = 0; i < 16; ++i) { O[0][i] = 0.f; O[1][i] = 0.f; }
            const int thi = (t0 + 7) >> 5, tlo = (t0 - 511) > 0 ? ((t0 - 511) >> 5) : 0;
            const float cS = -sl2 * (float)t - Ccol;
#define WIN_M(UU, PP) do { if ((PP) + 31 > t0 || (PP) < t0 + 7 - 511) nsa_mask(UU, t - 511 - (PP) - 8 * h, t - (PP) - 8 * h); } while (0)
            nsa_ldk(kA, KW, thi, voff); nsa_ldv(vA, VWT, thi, voff);
            if (thi - 1 >= tlo) { nsa_ldk(kB, KW, thi - 1, voff); nsa_ldv(vB, VWT, thi - 1, voff); }
#pragma unroll 1
            for (int ti = thi; ti >= tlo; ti -= 2) {
                f32x16 uA, uB, p;
                if (ti - 1 >= tlo) {
                    nsa_qk2(kA, kB, qf, kaug, slpk1, cS + sl2 * (float)(32 * ti), cS + sl2 * (float)(32 * ti - 32), uA, uB);
                    if (ti - 2 >= tlo) nsa_ldk(kA, KW, ti - 2, voff);
                    if (ti - 3 >= tlo) nsa_ldk(kB, KW, ti - 3, voff);
                    WIN_M(uA, 32 * ti); WIN_M(uB, 32 * ti - 32);
                    nsa_expv(uA, p, lp, O, vA);
                    if (ti - 2 >= tlo) nsa_ldv(vA, VWT, ti - 2, voff);
                    nsa_expv(uB, p, lp, O, vB);
                    if (ti - 3 >= tlo) nsa_ldv(vB, VWT, ti - 3, voff);
                } else {
                    nsa_qk(kA, qf, kaug, slpk1, cS + sl2 * (float)(32 * ti), uA);
                    WIN_M(uA, 32 * ti);
                    nsa_expv(uA, p, lp, O, vA);
                }
            }
#undef WIN_M
#define WIN_T(KF, VF, TI)
#undef WIN_T
            lp += __shfl_xor(lp, 32);
            nsa_res(resL, voff, O, gates[m * 24 + 3 * hq + 2] * __builtin_amdgcn_rcpf(lp), false);
        }
        { const int l3 = lane_id(), n3 = l3 & 31, h3 = l3 >> 5; const size_t m3 = (size_t)b * T + t0 + (n3 >> 2); const int hq3 = 4 * g + (n3 & 3);
#pragma unroll
            for (int q = 0; q < 8; ++q) { const f32x4 o = *(const f32x4*)(resL + (q * 64 + l3) * 4); u32x2 w; w.x = pk2(o.x, o.y); w.y = pk2(o.z, o.w);
                *(u32x2*)(mix + m3 * D + 64 * hq3 + 32 * (q >> 2) + 8 * (q & 3) + 4 * h3) = w; } }
    }
}
#undef kaug
#undef m

constexpr int NSA_RING_OFF = 98304, NSA_SLOT = 8192;
#define NSA_VMW(n) asm volatile("s_waitcnt vmcnt(" #n ")" ::: "memory")
__device__ __forceinline__ void nsa_dma(LAS unsigned char* ring, int slot, const bf16* Kb, const bf16* Vb, int tile, int wave, unsigned voff) {
    const char* src = (const char*)(wave < 4 ? Kb : Vb) + (size_t)tile * 4096 + (wave & 3) * 1024 + voff;
    __builtin_amdgcn_global_load_lds((const unsigned*)src, (LAS unsigned*)(ring + slot * NSA_SLOT + wave * 1024), 16, 0, 0);
}
__device__ __forceinline__ void nsa_frag(LAS unsigned char* ring, int slot, unsigned voff, bf16x8 (&kf)[4], bf16x8 (&vf)[4]) {
#pragma unroll
    for (int q = 0; q < 4; ++q) { kf[q] = *(const LAS bf16x8*)(ring + slot * NSA_SLOT + q * 1024 + voff); vf[q] = *(const LAS bf16x8*)(ring + slot * NSA_SLOT + 4096 + q * 1024 + voff); }
}
__device__ __forceinline__ void nsa_ls_phase(const Args& a, unsigned char* lds, int l, int blk, int G, int wave) {
    const bf16* proj = (const bf16*)(a.ws + WS_PROJ);
    const float* gates = (const float*)(a.ws + WS_GATES);
    bf16* mix = (bf16*)(a.ws + WS_HN);
    const int lane = lane_id(), n = lane & 31, h = lane >> 5, tq = n >> 2, r = n & 3;
    const int krow = (n & 0x13) | ((n & 4) << 1) | ((n & 8) >> 1);
    const unsigned voff = (unsigned)lane * 16u;
    float* imp = (float*)lds + wave * (8 * 128);
    float* resL = (float*)(lds + 32768) + wave * 2048;
    unsigned* selw = (unsigned*)(lds + SELM_OFF) + wave * 32;
    volatile unsigned* ubw = (volatile unsigned*)(lds + SELM_OFF + 1024);
    LAS unsigned char* ring = (LAS unsigned char*)lds + NSA_RING_OFF;
    const unsigned kapk = h ? 0u : pk2((float)krow, (float)krow);
#define kaug nsa_kaug(kapk, h)
    float gmax; { const float* kg = a.in[4] + l * 192; gmax = fmaxf(fmaxf(fabsf(kg[lane]), fabsf(kg[64 + lane])), fabsf(kg[128 + lane]));
#pragma unroll
        for (int o = 1; o < 64; o <<= 1) gmax = fmaxf(gmax, __shfl_xor(gmax, o));
        gmax = __builtin_bit_cast(float, __builtin_amdgcn_readfirstlane(__builtin_bit_cast(int, gmax))); }
    for (int u = blk; u < NB * 2 * 128; u += G) {
        const int b = u >> 8, g = (u >> 7) & 1, tb = ((u & 127) + 32 * (u >> 8)) & 127;
        const int hq = 4 * g + r, t0 = 64 * tb + 8 * wave, t = t0 + tq, tmaxB = 64 * tb + 63;
#define m ((size_t)b * T + t)
        const float sl2 = ex2(-(float)(hq + 1)) * LOG2E;
        bf16x8 qf[4];
#pragma unroll
        for (int ks = 0; ks < 4; ++ks) qf[ks] = *(const bf16x8*)(proj + m * PC + C_Q + 64 * hq + 16 * ks + 8 * h);
        float Ccol; { float qq = 0.f;
#pragma unroll
            for (int ks = 0; ks < 4; ++ks) { const u32x4 w = __builtin_bit_cast(u32x4, qf[ks]);
                qq += bflo(w.x) * bflo(w.x) + bfhi(w.x) * bfhi(w.x) + bflo(w.y) * bflo(w.y) + bfhi(w.y) * bfhi(w.y) + bflo(w.z) * bflo(w.z) + bfhi(w.z) * bfhi(w.z) + bflo(w.w) * bflo(w.w) + bfhi(w.w) * bfhi(w.w); }
            qq += __shfl_xor(qq, 32); Ccol = sqrtf(qq) * 8.f * gmax; }
        unsigned slpk1, slpk16; { const unsigned hp = pk2(sl2, sl2); const float hif = bflo(hp); slpk1 = pk2(hif, sl2 - hif); const float s16 = 16.f * sl2; const unsigned hq2 = pk2(s16, s16); const float h2 = bflo(hq2); slpk16 = pk2(h2, s16 - h2); }
        f32x16 O[2];
#pragma unroll
        for (int i = 0; i < 16; ++i) imp[lane + 64 * i] = 0.f;
        if (lane < 32) selw[lane] = 0u;
        if (wave == 0 && lane < 4) ubw[lane] = 0u;
        bf16x8 kc[4], vf[4];
#define NSA_WALK(KB, VB, NEXT, ...) do { \
            NSA_VMW(0); __builtin_amdgcn_s_barrier(); \
            int tA = NEXT, tB = tA >= 0 ? NEXT : -1, sl = 0; \
            if (tA >= 0) nsa_dma(ring, 0, KB, VB, tA, wave, voff); \
            if (tB >= 0) nsa_dma(ring, 1, KB, VB, tB, wave, voff); \
            while (tA >= 0) { \
                const int tC = tB >= 0 ? NEXT : -1; \
                if (tC >= 0) { nsa_dma(ring, (sl + 2) & 3, KB, VB, tC, wave, voff); NSA_VMW(2); } else if (tB >= 0) NSA_VMW(1); else NSA_VMW(0); \
                __builtin_amdgcn_s_barrier(); \
                { const int tile = tA; __VA_ARGS__ } \
                tA = tB; tB = tC; sl = (sl + 1) & 3; } } while (0)
        {
            const bf16* KC = (const bf16*)(a.ws + WS_KCF) + (size_t)(b * 2 + g) * NCB * 64;
            const bf16* VCT = (const bf16*)(a.ws + WS_VCT) + (size_t)(b * 2 + g) * 64 * NCB;
            const int ncv = t >= 31 ? ((t - 31) >> 4) + 1 : 0;
            const int tmax = t0 + 7, ncvmax = tmax >= 31 ? ((tmax - 31) >> 4) + 1 : 0, nct = (ncvmax + 31) >> 5;
            const int nctB = ((((tmaxB - 31) >> 4) + 1) + 31) >> 5;
            const float c0 = sl2 * (float)(31 - t) - Ccol, c1 = sl2 * 512.f;
            float lp = 0.f; int ci = 0;
            NSA_WALK(KC, VCT, (ci < nctB ? ci++ : -1), {
                if (tile < nct) { nsa_frag(ring, sl, voff, kc, vf);
                    f32x16 uu; nsa_qk(kc, qf, kaug, slpk16, c0 + (float)tile * c1, uu);
                    if (tile == nct - 1) nsa_mask(uu, -1000, ncv - 1 - 32 * tile - 8 * h);
                    float lt = 0.f; _Pragma("unroll") for (int i = 0; i < 16; ++i) lt += ex2(uu[i]); lp += lt; } });
            lp += __shfl_xor(lp, 32);
            const float cB = ncv > 0 ? c0 - __builtin_amdgcn_logf(lp) : -30000.f;
#pragma unroll
            for (int i = 0; i < 16; ++i) { O[0][i] = 0.f; O[1][i] = 0.f; }
            float dummy = 0.f; ci = 0;
            NSA_WALK(KC, VCT, (ci < nctB ? ci++ : -1), {
                if (tile < nct) { nsa_frag(ring, sl, voff, kc, vf);
                    f32x16 uu; nsa_qk(kc, qf, kaug, slpk16, cB + (float)tile * c1, uu);
                    if (tile == nct - 1) nsa_mask(uu, -1000, ncv - 1 - 32 * tile - 8 * h);
                    f32x16 p; nsa_expv(uu, p, dummy, O, vf);
                    float av[4], bv[4];
                    _Pragma("unroll") for (int q4 = 0; q4 < 4; ++q4) { const int i0 = 4 * q4; av[q4] = (p[i0] + p[i0 + 1]) + (p[i0 + 2] + 0.5f * p[i0 + 3]); bv[q4] = 0.5f * p[i0 + 3]; }
                    _Pragma("unroll") for (int q4 = 0; q4 < 4; ++q4) { av[q4] += dpp_xor1(av[q4]); av[q4] += dpp_xor2(av[q4]); bv[q4] += dpp_xor1(bv[q4]); bv[q4] += dpp_xor2(bv[q4]); }
                    const float am = r == 0 ? av[0] : r == 1 ? av[1] : r == 2 ? av[2] : av[3], bm = r == 0 ? bv[0] : r == 1 ? bv[1] : r == 2 ? bv[2] : bv[3];
                    const int sb = 8 * tile + 4 * (r >> 1) + 2 * h + (r & 1);
                    atomicAdd(&imp[tq * 128 + sb], am);
                    if (sb + 1 < 128) atomicAdd(&imp[tq * 128 + sb + 1], bm); } });
            nsa_res(resL, voff, O, gates[m * 24 + 3 * hq], true);
        }
        {
            const int l2 = lane_id(), tk = l2 >> 3, k8 = l2 & 7, cur = tb;
            float v[16];
#pragma unroll
            for (int k4 = 0; k4 < 4; ++k4) { const f32x4 x = *(const f32x4*)(imp + tk * 128 + 16 * k8 + 4 * k4); v[4 * k4] = x.x; v[4 * k4 + 1] = x.y; v[4 * k4 + 2] = x.z; v[4 * k4 + 3] = x.w; }
#pragma unroll
            for (int k = 0; k < 16; ++k) { const int s2 = 16 * k8 + k; const bool forced = (s2 == 0) || (s2 == cur) || (s2 == cur - 1), valid = s2 <= cur; v[k] = forced ? 1e9f : (valid ? v[k] : -1e9f); }
            unsigned bits = 0u;
#pragma unroll 1
            for (int it = 0; it < 16; ++it) {
                float bvv = v[0]; int bi = 0;
#pragma unroll
                for (int k = 1; k < 16; ++k) if (v[k] > bvv) { bvv = v[k]; bi = k; }
                bi += 16 * k8;
#define TK_STEP(CTRL) do { const float ov = __builtin_bit_cast(float, __builtin_amdgcn_update_dpp(0, __builtin_bit_cast(int, bvv), CTRL, 0xf, 0xf, true)); const int oi = __builtin_amdgcn_update_dpp(0, bi, CTRL, 0xf, 0xf, true); \
                    if (ov > bvv || (ov == bvv && oi < bi)) { bvv = ov; bi = oi; } } while (0)
                TK_STEP(0xB1); TK_STEP(0x4E); TK_STEP(0x141);
#undef TK_STEP
#pragma unroll
                for (int k = 0; k < 16; ++k) if (bi == 16 * k8 + k) { v[k] = -3e38f; if (16 * k8 + k <= cur) bits |= 1u << k; }
            }
            atomicOr(&selw[tk * 4 + (k8 >> 1)], bits << (16 * (k8 & 1)));
        }
        {
            const bf16* KS = (const bf16*)(a.ws + WS_KS) + (size_t)(b * 2 + g) * T * 64;
            const bf16* VST = (const bf16*)(a.ws + WS_VST) + (size_t)(b * 2 + g) * 64 * T;
            float lp = 0.f;
#pragma unroll
            for (int i = 0; i < 16; ++i) { O[0][i] = 0.f; O[1][i] = 0.f; }
            unsigned myu[4];
#pragma unroll
            for (int w = 0; w < 4; ++w) { unsigned uw = selw[(lane & 7) * 4 + w]; uw |= __shfl_xor(uw, 1); uw |= __shfl_xor(uw, 2); uw |= __shfl_xor(uw, 4); myu[w] = (unsigned)__builtin_amdgcn_readfirstlane((int)uw); }
            if (lane < 4) atomicOr((unsigned*)&ubw[lane], lane == 0 ? myu[0] : lane == 1 ? myu[1] : lane == 2 ? myu[2] : myu[3]);
            __builtin_amdgcn_s_waitcnt(0xc07f);
            __builtin_amdgcn_s_barrier();
            SlcIt it; it.half = 0; it.sblk = 0;
#pragma unroll
            for (int w = 0; w < 4; ++w) it.w[w] = (unsigned)__builtin_amdgcn_readfirstlane((int)ubw[w]);
            const float cS = -sl2 * (float)t - Ccol;
            NSA_WALK(KS, VST, (slc_next(it, tmaxB) >> 5), {
                const int PP = 32 * tile, sbk = tile >> 1;
                const unsigned wsel = (sbk >> 5) == 0 ? myu[0] : (sbk >> 5) == 1 ? myu[1] : (sbk >> 5) == 2 ? myu[2] : myu[3];
                if (((wsel >> (sbk & 31)) & 1u) && PP <= t0 + 7) { nsa_frag(ring, sl, voff, kc, vf);
                    const bool colsel = (selw[tq * 4 + (sbk >> 5)] >> (sbk & 31)) & 1u;
                    f32x16 uu; nsa_qk(kc, qf, kaug, slpk1, colsel ? cS + sl2 * (float)PP : -30000.f, uu);
                    if (PP + 31 > t0) nsa_mask(uu, -1000, t - PP - 8 * h);
                    f32x16 p; nsa_expv(uu, p, lp, O, vf); } });
            lp += __shfl_xor(lp, 32);
            nsa_res(resL, voff, O, gates[m * 24 + 3 * hq + 1] * __builtin_amdgcn_rcpf(lp), false);
        }
        {
            const bf16* KW = (const bf16*)(a.ws + WS_KW) + (size_t)(b * 2 + g) * T * 64;
            const bf16* VWT = (const bf16*)(a.ws + WS_VWT) + (size_t)(b * 2 + g) * 64 * T;
            float lp = 0.f;
#pragma unroll
            for (int i = 0; i < 16; ++i) { O[0][i] = 0.f; O[1][i] = 0.f; }
            const int thiB = tmaxB >> 5, tloB = (64 * tb - 511) > 0 ? ((64 * tb - 511) >> 5) : 0;
            const float cS = -sl2 * (float)t - Ccol;
            int wi = thiB;
            NSA_WALK(KW, VWT, (wi >= tloB ? wi-- : -1), {
                const int PP = 32 * tile;
                if (PP <= t0 + 7 && PP + 31 >= t0 - 511) { nsa_frag(ring, sl, voff, kc, vf);
                    f32x16 uu; nsa_qk(kc, qf, kaug, slpk1, cS + sl2 * (float)PP, uu);
                    if (PP + 31 > t0 || PP < t0 + 7 - 511) nsa_mask(uu, t - 511 - PP - 8 * h, t - PP - 8 * h);
                    f32x16 p; nsa_expv(uu, p, lp, O, vf); } });
            lp += __shfl_xor(lp, 32);
            nsa_res(resL, voff, O, gates[m * 24 + 3 * hq + 2] * __builtin_amdgcn_rcpf(lp), false);
        }
        { const int l3 = lane_id(), n3 = l3 & 31, h3 = l3 >> 5; const size_t m3 = (size_t)b * T + t0 + (n3 >> 2); const int hq3 = 4 * g + (n3 & 3);
#pragma unroll
            for (int q = 0; q < 8; ++q) { const f32x4 o = *(const f32x4*)(resL + (q * 64 + l3) * 4); u32x2 w; w.x = pk2(o.x, o.y); w.y = pk2(o.z, o.w);
                *(u32x2*)(mix + m3 * D + 64 * hq3 + 32 * (q >> 2) + 8 * (q & 3) + 4 * h3) = w; } }
    }
    NSA_VMW(0); __builtin_amdgcn_s_barrier();
}
#undef kaug
#undef m
#undef NSA_WALK

__device__ __forceinline__ void retout_phase(const Args& a, int l, int blk, int G, int tid) {
    const bf16* proj = (const bf16*)(a.ws + WS_PROJ);
    const float* rets = (const float*)(a.ws + WS_RETS);
    bf16* mix = (bf16*)(a.ws + WS_HN);
    const float* rng = a.in[7] + l * 512;
    const int i = tid >> 2, qd = tid & 3;
    for (int u = blk; u < NB * 8 * 64; u += G) {
        const int b = u >> 9, h = (u >> 6) & 7, c = u & 63;
        const float lg2 = log2f(1.f - exp2f(-5.f - (float)h));
        const bf16* base = proj + ((size_t)b * T + c * 128) * PC;
        float q[32], acc[16];
        { const u32x4* p = (const u32x4*)(base + (size_t)i * PC + C_RQ + 32 * h);
#pragma unroll
            for (int k = 0; k < 4; ++k) { const u32x4 uu = p[k]; q[8 * k] = bflo(uu.x); q[8 * k + 1] = bfhi(uu.x); q[8 * k + 2] = bflo(uu.y); q[8 * k + 3] = bfhi(uu.y); q[8 * k + 4] = bflo(uu.z); q[8 * k + 5] = bfhi(uu.z); q[8 * k + 6] = bflo(uu.w); q[8 * k + 7] = bfhi(uu.w); }
#pragma unroll
            for (int k = 0; k < 32; ++k) q[k] *= 0.17677669529663687f; }
#pragma unroll
        for (int k = 0; k < 16; ++k) acc[k] = 0.f;
        for (int j = 0; j <= i; ++j) {
            const float s = dot32(q, base + (size_t)j * PC + C_RK + 32 * h) * exp2f((float)(i - j) * lg2);
            const u32x4* vp = (const u32x4*)(base + (size_t)j * PC + C_RV + 64 * h + 16 * qd);
#pragma unroll
            for (int k = 0; k < 2; ++k) { const u32x4 uu = vp[k]; acc[8 * k] += s * bflo(uu.x); acc[8 * k + 1] += s * bfhi(uu.x); acc[8 * k + 2] += s * bflo(uu.y); acc[8 * k + 3] += s * bfhi(uu.y); acc[8 * k + 4] += s * bflo(uu.z); acc[8 * k + 5] += s * bfhi(uu.z); acc[8 * k + 6] += s * bflo(uu.w); acc[8 * k + 7] += s * bfhi(uu.w); }
        }
        { const float xi = exp2f((float)(i + 1) * lg2); const float* S = rets + ((size_t)(b * 8 + h) * 64 + c) * 2048 + 16 * qd;
#pragma unroll
            for (int d = 0; d < 32; ++d) { const float qx = q[d] * xi; const f32x4* sp = (const f32x4*)(S + d * 64);
#pragma unroll
                for (int k = 0; k < 4; ++k) { const f32x4 sv = sp[k]; acc[4 * k] += qx * sv.x; acc[4 * k + 1] += qx * sv.y; acc[4 * k + 2] += qx * sv.z; acc[4 * k + 3] += qx * sv.w; } } }
        float ss = 0.f;
#pragma unroll
        for (int k = 0; k < 16; ++k) ss += acc[k] * acc[k];
        ss += __shfl_xor(ss, 1); ss += __shfl_xor(ss, 2);
        const float rs = 1.f / sqrtf(ss * (1.f / 64.f) + EPS);
        const size_t m = (size_t)b * T + c * 128 + i;
        const u32x4* gp = (const u32x4*)(proj + m * PC + C_RG + 64 * h + 16 * qd);
        float y[16];
#pragma unroll
        for (int k = 0; k < 2; ++k) { const u32x4 uu = gp[k]; const float gg[8] = {bflo(uu.x), bfhi(uu.x), bflo(uu.y), bfhi(uu.y), bflo(uu.z), bfhi(uu.z), bflo(uu.w), bfhi(uu.w)};
#pragma unroll
            for (int z = 0; z < 8; ++z) { const float gz = gg[z]; y[8 * k + z] = acc[8 * k + z] * rs * rng[64 * h + 16 * qd + 8 * k + z] * (gz / (1.f + __expf(-gz))); } }
        u32x4* op = (u32x4*)(mix + m * D + 512 + 64 * h + 16 * qd);
#pragma unroll
        for (int k = 0; k < 2; ++k) { u32x4 w; w.x = pk2(y[8 * k], y[8 * k + 1]); w.y = pk2(y[8 * k + 2], y[8 * k + 3]); w.z = pk2(y[8 * k + 4], y[8 * k + 5]); w.w = pk2(y[8 * k + 6], y[8 * k + 7]); op[k] = w; }
    }
}

__device__ __forceinline__ void retout_fast_phase(const Args& a, unsigned char* lds, int l, int blk, int G, int wave) {
    const bf16* proj = (const bf16*)(a.ws + WS_PROJ);
    bf16* mix = (bf16*)(a.ws + WS_HN);
    const float* rng = a.in[7] + l * 512;
    const int lane = lane_id(), n = lane & 31, h = lane >> 5, tid = wave * 64 + lane, qt = wave & 3, dt = wave >> 2;
    const int krow = (n & 0x13) | ((n & 4) << 1) | ((n & 8) >> 1);
    bf16* Qs = (bf16*)lds;
    bf16* Ks = Qs + 128 * 32;
    bf16* VTs = Ks + 128 * 32;
    float* ssq = (float*)(lds + 8192 + 8192 + 64 * 136 * 2);
    for (int u = blk; u < NB * 8 * 64; u += G) {
        const int b = u >> 9, hh = (u >> 6) & 7, c = u & 63;
        const float lg2 = log2f(1.f - exp2f(-5.f - (float)hh));
        const size_t m0 = (size_t)b * T + c * 128;
        { const int row = tid >> 2, pc = tid & 3; const bf16* src = proj + (m0 + row) * PC + 32 * hh + 8 * pc;
            const u32x4 uq = *(const u32x4*)(src + C_RQ), uk = *(const u32x4*)(src + C_RK);
            const float sq = 0.17677669529663687f * exp2f((float)(row + 1) * lg2), sk = exp2f(-(float)(row + 1) * lg2);
            u32x4 o; o.x = pk2(bflo(uq.x) * sq, bfhi(uq.x) * sq); o.y = pk2(bflo(uq.y) * sq, bfhi(uq.y) * sq); o.z = pk2(bflo(uq.z) * sq, bfhi(uq.z) * sq); o.w = pk2(bflo(uq.w) * sq, bfhi(uq.w) * sq);
            *(u32x4*)(Qs + row * 32 + 8 * pc) = o;
            o.x = pk2(bflo(uk.x) * sk, bfhi(uk.x) * sk); o.y = pk2(bflo(uk.y) * sk, bfhi(uk.y) * sk); o.z = pk2(bflo(uk.z) * sk, bfhi(uk.z) * sk); o.w = pk2(bflo(uk.w) * sk, bfhi(uk.w) * sk);
            *(u32x4*)(Ks + row * 32 + 8 * pc) = o; }
#pragma unroll
        for (int it = 0; it < 2; ++it) { const int idx = tid + NTHR * it, row = idx >> 3, pc = idx & 7; const u32x4 uv = *(const u32x4*)(proj + (m0 + row) * PC + C_RV + 64 * hh + 8 * pc);
            bf16* d0 = VTs + (8 * pc) * 136 + row;
            d0[0] = (bf16)(uv.x & 0xffffu); d0[136] = (bf16)(uv.x >> 16); d0[2 * 136] = (bf16)(uv.y & 0xffffu); d0[3 * 136] = (bf16)(uv.y >> 16);
            d0[4 * 136] = (bf16)(uv.z & 0xffffu); d0[5 * 136] = (bf16)(uv.z >> 16); d0[6 * 136] = (bf16)(uv.w & 0xffffu); d0[7 * 136] = (bf16)(uv.w >> 16); }
        __syncthreads();
        bf16x8 qf[2];
#pragma unroll
        for (int ks = 0; ks < 2; ++ks) qf[ks] = *(const bf16x8*)(Qs + (32 * qt + n) * 32 + 16 * ks + 8 * h);
        f32x16 O;
#pragma unroll
        for (int i = 0; i < 16; ++i) O[i] = 0.f;
        for (int kt = 0; kt <= qt; ++kt) {
            f32x16 acc;
#pragma unroll
            for (int i = 0; i < 16; ++i) acc[i] = 0.f;
#pragma unroll
            for (int ks = 0; ks < 2; ++ks) { const bf16x8 af = *(const bf16x8*)(Ks + (32 * kt + krow) * 32 + 16 * ks + 8 * h); acc = MFMA32(af, qf[ks], acc); }
            if (kt == qt) {
#pragma unroll
                for (int i = 0; i < 16; ++i) { const int cc = 16 * (i >> 3) + (i & 7) + 8 * h; acc[i] = (cc <= n) ? acc[i] : 0.f; }
            }
#pragma unroll
            for (int j = 0; j < 2; ++j) { const bf16x8 pb = nsa_pack8(acc, j); const bf16x8 vf = *(const bf16x8*)(VTs + (32 * dt + n) * 136 + 32 * kt + 16 * j + 8 * h); O = MFMA32(vf, pb, O); }
        }
        { const bf16* ST = (const bf16*)(a.ws + WS_RST) + (((size_t)(b * 8 + hh) * 64 + c) * 64 + 32 * dt + n) * 32;
#pragma unroll
            for (int ks = 0; ks < 2; ++ks) { const bf16x8 sf = *(const bf16x8*)(ST + 16 * ks + 8 * h); O = MFMA32(sf, qf[ks], O); } }
        float ss = 0.f;
#pragma unroll
        for (int i = 0; i < 16; ++i) ss += O[i] * O[i];
        ss += __shfl_xor(ss, 32);
        if (h == 0) ssq[(dt * 4 + qt) * 32 + n] = ss;
        __syncthreads();
        const float rs = 1.f / sqrtf((ssq[qt * 32 + n] + ssq[(4 + qt) * 32 + n]) * (1.f / 64.f) + EPS);
        const size_t m = m0 + 32 * qt + n;
#pragma unroll
        for (int q4 = 0; q4 < 4; ++q4) { const int e0 = 32 * dt + 8 * q4 + 4 * h;
            const u32x2 ug = *(const u32x2*)(proj + m * PC + C_RG + 64 * hh + e0); const f32x4 gn = *(const f32x4*)(rng + 64 * hh + e0);
            const float z0 = bflo(ug.x), z1 = bfhi(ug.x), z2 = bflo(ug.y), z3 = bfhi(ug.y);
            const float y0 = O[4 * q4] * rs * gn.x * fsilu(z0), y1 = O[4 * q4 + 1] * rs * gn.y * fsilu(z1);
            const float y2 = O[4 * q4 + 2] * rs * gn.z * fsilu(z2), y3 = O[4 * q4 + 3] * rs * gn.w * fsilu(z3);
            u32x2 w; w.x = pk2(y0, y1); w.y = pk2(y2, y3);
            *(u32x2*)(mix + m * D + 512 + 64 * hh + e0) = w; }
        __syncthreads();
    }
}

struct Unit { int pm, pn, e, j, nvalid; };
struct DenseSched {
    const bf16* A; const bf16* Bt; int K, nM, nN, G, c;
    __device__ __forceinline__ bool next(int i, Unit& u) const {
        const int nwg = nM * nN; const int L = i * G + c; if (L >= nwg) return false;
        int wgid = L;
        if ((G & 7) == 0) { const int q = nwg >> 3, r = nwg & 7, xcd = L & 7, off = L >> 3; wgid = (xcd < r ? xcd * (q + 1) : r * (q + 1) + (xcd - r) * q) + off; }
        const int nig = 8 * nN, gid = wgid / nig, fm = gid * 8, gsz = (nM - fm) < 8 ? (nM - fm) : 8;
        u.pm = fm + ((wgid % nig) % gsz); u.pn = (wgid % nig) / gsz; u.e = 0; u.j = u.pm; u.nvalid = 256; return true;
    }
    __device__ __forceinline__ size_t arow(const Unit& u, int r) const { return (size_t)u.pm * 256 + r; }
    __device__ __forceinline__ const bf16* bt(const Unit& u) const { return Bt + (size_t)u.pn * 256 * K; }
    static constexpr bool LOADS = false;
    __device__ __forceinline__ bool loads() const { return false; }
    __device__ __forceinline__ const char* a_base(const Unit& u) const { return (const char*)(A + (size_t)u.pm * 256 * K); }
    __device__ __forceinline__ void a_offs(const Unit& u, const int (&R)[2], const int (&C)[2], unsigned (&v0)[2], unsigned (&v1)[2]) const {
#pragma unroll
        for (int i = 0; i < 2; ++i) { v0[i] = (unsigned)(R[i] * K + C[i]) * 2u; v1[i] = (unsigned)((R[i] + 128) * K + C[i]) * 2u; }
    }
};
template <bool GATHER>
struct RoutedSched {
    const bf16* A; const bf16* Bt; size_t bstride; int K, nN, G, c, ne;
    const int* tok;
    const int* tstart;
    const int* cnt;
    __device__ __forceinline__ bool next(int i, Unit& u) const {
        const int L = i * G + c; const int rt = L / nN; if (rt >= tstart[ne]) return false;
        u.pm = rt; u.pn = L % nN; int e = 0;
        for (int k = 1; k < ne; ++k) e += (tstart[k] <= rt) ? 1 : 0;
        u.e = e; u.j = rt - tstart[e]; const int left = cnt[e] - 256 * u.j; u.nvalid = left < 256 ? left : 256; return true;
    }
    __device__ __forceinline__ size_t arow(const Unit& u, int r) const {
        if (!GATHER) return (size_t)u.pm * 256 + r;
        const int i = 256 * u.j + (r < u.nvalid ? r : 0);
        return tok ? (size_t)tok[(size_t)u.e * M + i] : (size_t)i;
    }
    __device__ __forceinline__ const bf16* bt(const Unit& u) const { return Bt + (size_t)u.e * bstride + (size_t)u.pn * 256 * K; }
    static constexpr bool LOADS = GATHER;
    __device__ __forceinline__ bool loads() const { return GATHER && tok != nullptr; }
    __device__ __forceinline__ const char* a_base(const Unit& u) const { return GATHER ? (const char*)A : (const char*)(A + (size_t)u.pm * 256 * K); }
    __device__ __forceinline__ void a_offs(const Unit& u, const int (&R)[2], const int (&C)[2], unsigned (&v0)[2], unsigned (&v1)[2]) const {
#pragma unroll
        for (int i = 0; i < 2; ++i) {
            if (GATHER) { v0[i] = (unsigned)(arow(u, R[i]) * K + C[i]) * 2u; v1[i] = (unsigned)(arow(u, R[i] + 128) * K + C[i]) * 2u; }
            else { v0[i] = (unsigned)(R[i] * K + C[i]) * 2u; v1[i] = (unsigned)((R[i] + 128) * K + C[i]) * 2u; }
        }
    }
};
__device__ __forceinline__ void fold_norm(const f32x4& n0, const f32x4& n1, const f32x4& n2, const f32x4& n3, size_t m, int col, bf16* xb, const float* gain, float* rowss) {
    float ss = (n0.x * n0.x + n0.y * n0.y + n0.z * n0.z + n0.w * n0.w) + (n1.x * n1.x + n1.y * n1.y + n1.z * n1.z + n1.w * n1.w)
             + (n2.x * n2.x + n2.y * n2.y + n2.z * n2.z + n2.w * n2.w) + (n3.x * n3.x + n3.y * n3.y + n3.z * n3.z + n3.w * n3.w);
    ss += __shfl_xor(ss, 16); ss += __shfl_xor(ss, 32);
    if (lane_id() < 16) rowss[m * 16 + 4 * (col >> 8) + ((col >> 5) & 3)] = ss;
    const f32x4 g0 = *(const f32x4*)(gain + col), g1 = *(const f32x4*)(gain + col + 4), g2 = *(const f32x4*)(gain + col + 128), g3 = *(const f32x4*)(gain + col + 132);
    u32x4 w; w.x = pk2(n0.x * g0.x, n0.y * g0.y); w.y = pk2(n0.z * g0.z, n0.w * g0.w); w.z = pk2(n1.x * g1.x, n1.y * g1.y); w.w = pk2(n1.z * g1.z, n1.w * g1.w);
    *(u32x4*)(xb + m * D + col) = w;
    w.x = pk2(n2.x * g2.x, n2.y * g2.y); w.y = pk2(n2.z * g2.z, n2.w * g2.w); w.z = pk2(n3.x * g3.x, n3.y * g3.y); w.w = pk2(n3.z * g3.z, n3.w * g3.w);
    *(u32x4*)(xb + m * D + col + 128) = w;
}
__device__ __forceinline__ float fold_rstd(const float* rowss, size_t m) {
    const f32x4* p = (const f32x4*)(rowss + m * 16); const f32x4 a = p[0], b = p[1], c = p[2], d = p[3];
    const float ss = (((a.x + a.y) + (a.z + a.w)) + ((b.x + b.y) + (b.z + b.w))) + (((c.x + c.y) + (c.z + c.w)) + ((d.x + d.y) + (d.z + d.w)));
    return 1.0f / sqrtf(ss * (1.f / D) + EPS);
}
struct EpiIn {
    bf16* proj; float* gates; const float* rowss;
    __device__ __forceinline__ void row8(const Unit& u, int r, int c8, const float (&lo_)[8], const float (&hi_)[8]) const {
        const size_t m = (size_t)u.pm * 256 + r;
        const float rs = rowss ? fold_rstd(rowss, m) : 1.f;
        float lo[8], hi[8];
#pragma unroll
        for (int i = 0; i < 8; ++i) { lo[i] = lo_[i] * rs; hi[i] = hi_[i] * rs; }
        if (u.pn < 11) {
            u32x4 w; w.x = pk2(lo[0], lo[1]); w.y = pk2(lo[2], lo[3]); w.z = pk2(lo[4], lo[5]); w.w = pk2(lo[6], lo[7]);
            *(u32x4*)(proj + m * PC + u.pn * 256 + c8) = w;
            w.x = pk2(hi[0], hi[1]); w.y = pk2(hi[2], hi[3]); w.z = pk2(hi[4], hi[5]); w.w = pk2(hi[6], hi[7]);
            *(u32x4*)(proj + m * PC + u.pn * 256 + 128 + c8) = w;
        } else if (c8 < 24) {
            f32x4 s0, s1;
            s0.x = fsigmoid(lo[0]); s0.y = fsigmoid(lo[1]); s0.z = fsigmoid(lo[2]); s0.w = fsigmoid(lo[3]);
            s1.x = fsigmoid(lo[4]); s1.y = fsigmoid(lo[5]); s1.z = fsigmoid(lo[6]); s1.w = fsigmoid(lo[7]);
            *(f32x4*)(gates + m * 24 + c8) = s0; *(f32x4*)(gates + m * 24 + c8 + 4) = s1;
        }
    }
};
struct EpiRes {
    const float* base; float* out; bf16* xb; const float* gain; float* rowss;
    __device__ __forceinline__ void row8(const Unit& u, int r, int c8, const float (&lo)[8], const float (&hi)[8]) const {
        const size_t o = ((size_t)u.pm * 256 + r) * D + u.pn * 256 + c8;
        const f32x4 b0 = *(const f32x4*)(base + o), b1 = *(const f32x4*)(base + o + 4), b2 = *(const f32x4*)(base + o + 128), b3 = *(const f32x4*)(base + o + 132);
        const f32x4 n0 = (f32x4){b0.x + lo[0], b0.y + lo[1], b0.z + lo[2], b0.w + lo[3]}, n1 = (f32x4){b1.x + lo[4], b1.y + lo[5], b1.z + lo[6], b1.w + lo[7]};
        const f32x4 n2 = (f32x4){b2.x + hi[0], b2.y + hi[1], b2.z + hi[2], b2.w + hi[3]}, n3 = (f32x4){b3.x + hi[4], b3.y + hi[5], b3.z + hi[6], b3.w + hi[7]};
        *(f32x4*)(out + o) = n0; *(f32x4*)(out + o + 4) = n1; *(f32x4*)(out + o + 128) = n2; *(f32x4*)(out + o + 132) = n3;
        if (xb) fold_norm(n0, n1, n2, n3, (size_t)u.pm * 256 + r, u.pn * 256 + c8, xb, gain, rowss);
    }
};
struct EpiGU {
    bf16* hid; const float* rowss;
    __device__ __forceinline__ void row8(const Unit& u, int r, int c8, const float (&lo)[8], const float (&hi)[8]) const {
        float h[8];
        const float rs = rowss ? fold_rstd(rowss, (size_t)u.pm * 256 + r) : 1.f;
#pragma unroll
        for (int i = 0; i < 8; ++i) { const float gt = lo[i] * rs; h[i] = fsilu(gt) * (hi[i] * rs); }
        u32x4 w; w.x = pk2(h[0], h[1]); w.y = pk2(h[2], h[3]); w.z = pk2(h[4], h[5]); w.w = pk2(h[6], h[7]);
        *(u32x4*)(hid + ((size_t)u.pm * 256 + r) * FF + u.pn * 128 + c8) = w;
    }
};
struct EpiGU8 {
    unsigned char* hid;
    __device__ __forceinline__ void row8(const Unit& u, int r, int c8, const float (&lo)[8], const float (&hi)[8]) const {
        constexpr float inv = 1.f / (F8_SA * F8_SW);
        float h[8];
#pragma unroll
        for (int i = 0; i < 8; ++i) { const float gt = lo[i] * inv; h[i] = fsilu(gt) * (hi[i] * (inv * F8_SH)); }
        u32x2 w; w.x = pk4_fp8(h[0], h[1], h[2], h[3]); w.y = pk4_fp8(h[4], h[5], h[6], h[7]);
        *(u32x2*)(hid + ((size_t)u.pm * 256 + r) * FF + u.pn * 128 + c8) = w;
    }
};
struct EpiDown {
    float* x; const int* tok; const float* wt; float scale; bf16* xb; const float* gain; float* rowss;
    __device__ __forceinline__ void row8(const Unit& u, int r, int c8, const float (&lo)[8], const float (&hi)[8]) const {
        if (r >= u.nvalid) return;
        const int i = 256 * u.j + r; size_t m; float w;
        if (tok) { m = (size_t)tok[(size_t)u.e * M + i]; w = wt[(size_t)u.e * M + i] * scale; } else { m = (size_t)i; w = scale; }
        float* o = x + m * D + u.pn * 256 + c8;
        f32x4 b0 = *(f32x4*)(o), b1 = *(f32x4*)(o + 4), b2 = *(f32x4*)(o + 128), b3 = *(f32x4*)(o + 132);
        b0.x += w * lo[0]; b0.y += w * lo[1]; b0.z += w * lo[2]; b0.w += w * lo[3]; b1.x += w * lo[4]; b1.y += w * lo[5]; b1.z += w * lo[6]; b1.w += w * lo[7];
        b2.x += w * hi[0]; b2.y += w * hi[1]; b2.z += w * hi[2]; b2.w += w * hi[3]; b3.x += w * hi[4]; b3.y += w * hi[5]; b3.z += w * hi[6]; b3.w += w * hi[7];
        *(f32x4*)(o) = b0; *(f32x4*)(o + 4) = b1; *(f32x4*)(o + 128) = b2; *(f32x4*)(o + 132) = b3;
        if (xb) fold_norm(b0, b1, b2, b3, m, u.pn * 256 + c8, xb, gain, rowss);
    }
};

template <class Sched, class Epi>
__device__ __forceinline__ void gemm_naive(unsigned char* lds, const Sched& S, const Epi& E, int tid) {
    float* As = (float*)lds;
    float* Bs = As + 32 * 132;
    const int tr = tid >> 4, tc = tid & 15;
    const int lr = tid >> 2, lk = (tid & 3) * 8;
    const int K = S.K;
    Unit u;
    for (int it = 0; S.next(it, u); ++it) {
        const bf16* Btile = S.bt(u);
        for (int hf = 0; hf < 2; ++hf) {
            float lo[4][8], hi[4][8];
#pragma unroll
            for (int i = 0; i < 4; ++i)
#pragma unroll
                for (int j = 0; j < 8; ++j) { lo[i][j] = 0.f; hi[i][j] = 0.f; }
            const bf16* arow = S.A + S.arow(u, hf * 128 + lr) * K + lk;
            const bf16* brow0 = Btile + (size_t)lr * K + lk; const bf16* brow1 = Btile + (size_t)(lr + 128) * K + lk;
            for (int k0 = 0; k0 < K; k0 += 32) {
                const u32x4 av = *(const u32x4*)(arow + k0), b0 = *(const u32x4*)(brow0 + k0), b1 = *(const u32x4*)(brow1 + k0);
                __syncthreads();
                As[(lk + 0) * 132 + lr] = bflo(av.x); As[(lk + 1) * 132 + lr] = bfhi(av.x); As[(lk + 2) * 132 + lr] = bflo(av.y); As[(lk + 3) * 132 + lr] = bfhi(av.y);
                As[(lk + 4) * 132 + lr] = bflo(av.z); As[(lk + 5) * 132 + lr] = bfhi(av.z); As[(lk + 6) * 132 + lr] = bflo(av.w); As[(lk + 7) * 132 + lr] = bfhi(av.w);
                Bs[(lk + 0) * 260 + lr] = bflo(b0.x); Bs[(lk + 1) * 260 + lr] = bfhi(b0.x); Bs[(lk + 2) * 260 + lr] = bflo(b0.y); Bs[(lk + 3) * 260 + lr] = bfhi(b0.y);
                Bs[(lk + 4) * 260 + lr] = bflo(b0.z); Bs[(lk + 5) * 260 + lr] = bfhi(b0.z); Bs[(lk + 6) * 260 + lr] = bflo(b0.w); Bs[(lk + 7) * 260 + lr] = bfhi(b0.w);
                Bs[(lk + 0) * 260 + lr + 128] = bflo(b1.x); Bs[(lk + 1) * 260 + lr + 128] = bfhi(b1.x); Bs[(lk + 2) * 260 + lr + 128] = bflo(b1.y); Bs[(lk + 3) * 260 + lr + 128] = bfhi(b1.y);
                Bs[(lk + 4) * 260 + lr + 128] = bflo(b1.z); Bs[(lk + 5) * 260 + lr + 128] = bfhi(b1.z); Bs[(lk + 6) * 260 + lr + 128] = bflo(b1.w); Bs[(lk + 7) * 260 + lr + 128] = bfhi(b1.w);
                __syncthreads();
#pragma unroll 4
                for (int k = 0; k < 32; ++k) {
                    const f32x4 av4 = *(const f32x4*)(As + k * 132 + 4 * tr);
                    const f32x4 l0 = *(const f32x4*)(Bs + k * 260 + 8 * tc), l1 = *(const f32x4*)(Bs + k * 260 + 8 * tc + 4);
                    const f32x4 h0 = *(const f32x4*)(Bs + k * 260 + 128 + 8 * tc), h1 = *(const f32x4*)(Bs + k * 260 + 128 + 8 * tc + 4);
                    const float aa[4] = {av4.x, av4.y, av4.z, av4.w};
                    const float bl[8] = {l0.x, l0.y, l0.z, l0.w, l1.x, l1.y, l1.z, l1.w}, bh[8] = {h0.x, h0.y, h0.z, h0.w, h1.x, h1.y, h1.z, h1.w};
#pragma unroll
                    for (int i = 0; i < 4; ++i)
#pragma unroll
                        for (int j = 0; j < 8; ++j) { lo[i][j] += aa[i] * bl[j]; hi[i][j] += aa[i] * bh[j]; }
                }
            }
#pragma unroll
            for (int i = 0; i < 4; ++i) E.row8(u, hf * 128 + 4 * tr + i, 8 * tc, lo[i], hi[i]);
        }
    }
    __syncthreads();
}

namespace pg8 {
constexpr int BK = 64, HALF = 128, HTB = HALF * BK * 2;
__device__ __forceinline__ int lds_byte(int r, int c) { const int st = (r >> 4) * 2 + (c >> 5), rr = r & 15, cc = c & 31, ob = rr * 64 + cc * 2; return st * 1024 + (ob ^ (((ob >> 9) & 1) << 5)); }
__device__ __forceinline__ void stage_rc(int b, int& R, int& C) { const int st = b / 1024, sb = b % 1024, swz = sb ^ (((sb >> 9) & 1) << 5); R = (st >> 1) * 16 + swz / 64; C = (st & 1) * 32 + (swz % 64) / 2; }
__device__ __forceinline__ int perm32(int rho) { const int n = rho >> 4, i = rho & 15; return 8 * (i >> 2) + 4 * n + (i & 3); }
}
template <bool FP8, class Sched, class Epi>
__device__ __forceinline__ void gemm_fast(LAS unsigned char* lds, const Sched& S, const Epi& E, int wid) {
    using namespace pg8;
    const int lane = lane_id(), tid = wid * 64 + lane, wr = wid >> 2, wc = wid & 3, fr = lane & 15, fq = lane >> 4;
    const int K = S.K, nt = K / BK;
    unsigned voffB[2];
#pragma unroll
    for (int i = 0; i < 2; ++i) { int R, C; stage_rc(tid * 16 + i * 8192, R, C); const int Rb = (R & ~31) + perm32(R & 31); voffB[i] = (unsigned)(Rb * K + C) * 2u; }
    volatile LAS unsigned* nvs = (volatile LAS unsigned*)(lds + NVOFF_OFF) + tid * 4;
#define PG8_AOFFS(u, o0, o1) do { int _t = tid; asm volatile("" : "+v"(_t)); int _R[2], _C[2]; stage_rc(_t * 16, _R[0], _C[0]); stage_rc(_t * 16 + 8192, _R[1], _C[1]); S.a_offs(u, _R, _C, o0, o1); } while (0)
    const size_t kstep = (size_t)(BK * 2);
    const size_t hstep = (size_t)HALF * K * 2;
    const unsigned ldsw = (unsigned)wid * 1024u;
    const int aoff = lds_byte(wr * 64 + fr, fq * 8), boff = lds_byte(wc * 32 + fr, fq * 8);
    const int c8f = 32 * (fq >> 1) + 16 * (fq & 1);
    const int aoff0 = FP8 ? lds_byte(wr * 64 + fr, c8f) : 0, boff0 = FP8 ? lds_byte(wc * 32 + fr, c8f) : 0;
    int boffH = (FP8 ? boff0 : boff) + 4 * HTB; asm volatile("" : "+v"(boffH));
#define PG8_SA(b, h) (((b) * 2 + (h)) * HTB)
#define PG8_SB(b, h) ((4 + (b) * 2 + (h)) * HTB)
#define PG8_STAGE(bufoff, gbase, voff) do { _Pragma("unroll") for (int _i = 0; _i < 2; ++_i) \
        __builtin_amdgcn_global_load_lds((const unsigned*)((const char*)(gbase) + (voff)[_i]), (LAS unsigned*)(lds + (bufoff) + ldsw + _i * 8192), 16, 0, 0); } while (0)
#define PG8_STAGE_A1(bufoff, gbase) do { if constexpr (Sched::LOADS) PG8_STAGE(bufoff, gbase, cv1); else PG8_STAGE(bufoff, (gbase) + hstep, cv0); } while (0)
#define PG8_LDA(dst, b, h) do { _Pragma("unroll") for (int m = 0; m < 4; ++m) _Pragma("unroll") for (int k = 0; k < 2; ++k) dst[m][k] = *(const LAS bf16x8*)(lds + PG8_SA(b, h) + aoff + m * 2048 + k * 1024); } while (0)
#define PG8_LDB(dst, b, h) do { _Pragma("unroll") for (int n = 0; n < 2; ++n) _Pragma("unroll") for (int k = 0; k < 2; ++k) dst[n][k] = *(const LAS bf16x8*)(lds + boffH + (PG8_SB(b, h) - 4 * HTB) + n * 2048 + k * 1024); } while (0)
#define PG8_MMA(ai, bj, At, Bt) do { __builtin_amdgcn_s_setprio(1); _Pragma("unroll") for (int m = 0; m < 4; ++m) _Pragma("unroll") for (int n = 0; n < 2; ++n) _Pragma("unroll") for (int k = 0; k < 2; ++k) \
        acc[ai][bj][m][n] = __builtin_amdgcn_mfma_f32_16x16x32_bf16(Bt[n][k], At[m][k], acc[ai][bj][m][n], 0, 0, 0); __builtin_amdgcn_s_setprio(0); } while (0)
#define PG8_RD8(dst, o0) do { const v4i _l = *(const LAS v4i*)(lds + (o0)), _h = *(const LAS v4i*)(lds + (o0) + 16); dst = __builtin_shufflevector(_l, _h, 0, 1, 2, 3, 4, 5, 6, 7); } while (0)
#define PG8_LDA8(dst, b, h) do { _Pragma("unroll") for (int m = 0; m < 4; ++m) PG8_RD8(dst[m], PG8_SA(b, h) + aoff0 + m * 2048); } while (0)
#define PG8_LDB8(dst, b, h) do { _Pragma("unroll") for (int n = 0; n < 2; ++n) PG8_RD8(dst[n], boffH + (PG8_SB(b, h) - 4 * HTB) + n * 2048); } while (0)
#define PG8_MMA8(ai, bj, At, Bt) do { __builtin_amdgcn_s_setprio(1); _Pragma("unroll") for (int m = 0; m < 4; ++m) _Pragma("unroll") for (int n = 0; n < 2; ++n) \
        asm volatile("v_mfma_scale_f32_16x16x128_f8f6f4 %0, %1, %2, %0, %3, %3 op_sel_hi:[0,0,0]" : "+v"(acc[ai][bj][m][n]) : "v"(Bt[n]), "v"(At[m]), "v"(f8scale)); __builtin_amdgcn_s_setprio(0); } while (0)
#define PG8_WAIT_V(n) asm volatile("s_waitcnt vmcnt(" #n ")" ::: "memory")
#define PG8_WAIT_L(n) asm volatile("s_waitcnt lgkmcnt(" #n ")" ::: "memory")
#define PG8_BAR __builtin_amdgcn_s_barrier()
#define PG8_SCHED __builtin_amdgcn_sched_barrier(0)
#define XLDA(b, h) do { if constexpr (FP8) PG8_LDA8(At8, b, h); else PG8_LDA(At, b, h); } while (0)
#define XLDB0(b, h) do { if constexpr (FP8) PG8_LDB8(B08, b, h); else PG8_LDB(B0, b, h); } while (0)
#define XLDB1(b, h) do { if constexpr (FP8) PG8_LDB8(B18, b, h); else PG8_LDB(B1, b, h); } while (0)
#define XMMA(ai, bj, w) do { if constexpr (FP8) { if (w) PG8_MMA8(ai, bj, At8, B18); else PG8_MMA8(ai, bj, At8, B08); } else { if (w) PG8_MMA(ai, bj, At, B1); else PG8_MMA(ai, bj, At, B0); } } while (0)
    Unit cur, nxt; int ui = 0;
    if (!S.next(0, cur)) return;
    f32x4 acc[2][2][4][2];
#pragma unroll
    for (int a = 0; a < 2; ++a)
#pragma unroll
        for (int b = 0; b < 2; ++b)
#pragma unroll
            for (int m = 0; m < 4; ++m)
#pragma unroll
                for (int n = 0; n < 2; ++n) acc[a][b][m][n] = (f32x4){0.f, 0.f, 0.f, 0.f};
    bf16x8 At[4][2], B0[2][2], B1[2][2];
    v8i At8[4], B08[2], B18[2];
    const int f8scale = 0x7f7f7f7f;
    unsigned cv0[2], cv1[2];
    const char* cA = S.a_base(cur); const char* cB = (const char*)S.bt(cur);
    PG8_AOFFS(cur, cv0, cv1);
    if (Sched::LOADS && S.loads()) PG8_WAIT_V(0);
    PG8_STAGE(PG8_SB(0, 0), cB, voffB); PG8_STAGE(PG8_SB(0, 1), cB + hstep, voffB); PG8_STAGE(PG8_SA(0, 0), cA, cv0); PG8_STAGE_A1(PG8_SA(0, 1), cA);
    if (wr == 1) PG8_BAR;
    PG8_WAIT_V(2); PG8_BAR;
    PG8_STAGE(PG8_SB(1, 0), cB + kstep, voffB); PG8_STAGE(PG8_SA(1, 0), cA + kstep, cv0); PG8_STAGE(PG8_SB(1, 1), cB + hstep + kstep, voffB);
    PG8_WAIT_V(6); PG8_BAR;
    for (;;) {
        const bool has_next = S.next(ui + 1, nxt);
        const char* nA = cA; const char* nB = cB;
        if (has_next) { nA = S.a_base(nxt); nB = (const char*)S.bt(nxt);
            if (Sched::LOADS) { unsigned n0[2], n1[2]; PG8_AOFFS(nxt, n0, n1); if (S.loads()) PG8_WAIT_V(0); nvs[0] = n0[0]; nvs[1] = n0[1]; nvs[2] = n1[0]; nvs[3] = n1[1]; } }
        for (int t = 0; t < nt; t += 2) {
            const bool last = (t == nt - 2);
            const char* a1 = cA + (size_t)(t + 1) * kstep;
            const char* a2 = last ? nA : cA + (size_t)(t + 2) * kstep; const char* b2 = last ? nB : cB + (size_t)(t + 2) * kstep;
            const char* a3 = a2 + kstep; const char* b3 = b2 + kstep;
            XLDB0(0, 0); XLDB1(0, 1); PG8_SCHED; XLDA(0, 0); PG8_STAGE_A1(PG8_SA(1, 1), a1);
            if (Sched::LOADS) { if (last && has_next) { cv0[0] = nvs[0]; cv0[1] = nvs[1]; cv1[0] = nvs[2]; cv1[1] = nvs[3]; } }
            PG8_WAIT_V(8); PG8_WAIT_L(0); PG8_BAR; XMMA(0, 0, 0); XMMA(0, 1, 1); PG8_BAR; PG8_SCHED;
            XLDA(0, 1); PG8_STAGE(PG8_SB(0, 0), b2, voffB); PG8_STAGE(PG8_SB(0, 1), b2 + hstep, voffB); PG8_STAGE(PG8_SA(0, 0), a2, cv0);
            PG8_WAIT_V(8); PG8_WAIT_L(0); PG8_BAR; XMMA(1, 0, 0); XMMA(1, 1, 1); PG8_BAR; PG8_SCHED;
            XLDB0(1, 0); XLDB1(1, 1); PG8_SCHED; XLDA(1, 0); PG8_STAGE_A1(PG8_SA(0, 1), a2);
            PG8_WAIT_V(8); PG8_WAIT_L(0); PG8_BAR; XMMA(0, 0, 0); XMMA(0, 1, 1); PG8_BAR; PG8_SCHED;
            XLDA(1, 1); PG8_STAGE(PG8_SB(1, 0), b3, voffB); PG8_STAGE(PG8_SB(1, 1), b3 + hstep, voffB); PG8_STAGE(PG8_SA(1, 0), a3, cv0);
            PG8_WAIT_V(8); PG8_WAIT_L(0); PG8_BAR; XMMA(1, 0, 0); XMMA(1, 1, 1); PG8_BAR; PG8_SCHED;
        }
        if (wr == 0) PG8_BAR;
        {
            int frl = fr, c8 = wc * 32 + 8 * fq;
            asm volatile("" : "+v"(frl), "+v"(c8));
#pragma unroll
            for (int ai = 0; ai < 2; ++ai)
#pragma unroll
                for (int m = 0; m < 4; ++m) {
                    const float lo[8] = {acc[ai][0][m][0][0], acc[ai][0][m][0][1], acc[ai][0][m][0][2], acc[ai][0][m][0][3], acc[ai][0][m][1][0], acc[ai][0][m][1][1], acc[ai][0][m][1][2], acc[ai][0][m][1][3]};
                    const float hi[8] = {acc[ai][1][m][0][0], acc[ai][1][m][0][1], acc[ai][1][m][0][2], acc[ai][1][m][0][3], acc[ai][1][m][1][0], acc[ai][1][m][1][1], acc[ai][1][m][1][2], acc[ai][1][m][1][3]};
                    E.row8(cur, ai * HALF + wr * 64 + m * 16 + frl, c8, lo, hi);
                }
        }
        if (!has_next) break;
#pragma unroll
        for (int a = 0; a < 2; ++a)
#pragma unroll
            for (int b = 0; b < 2; ++b)
#pragma unroll
                for (int m = 0; m < 4; ++m)
#pragma unroll
                    for (int n = 0; n < 2; ++n) acc[a][b][m][n] = (f32x4){0.f, 0.f, 0.f, 0.f};
        cur = nxt; cA = nA; cB = nB; ++ui;
        if (wr == 1) PG8_BAR;
    }
    PG8_WAIT_V(0);
    PG8_BAR;
#undef XLDA
#undef XLDB0
#undef XLDB1
#undef XMMA
#undef PG8_RD8
#undef PG8_LDA8
#undef PG8_LDB8
#undef PG8_MMA8
#undef PG8_STAGE_A1
#undef PG8_AOFFS
#undef PG8_SA
#undef PG8_SB
#undef PG8_STAGE
#undef PG8_LDA
#undef PG8_LDB
#undef PG8_MMA
#undef PG8_WAIT_V
#undef PG8_WAIT_L
#undef PG8_BAR
#undef PG8_SCHED
}

__device__ __forceinline__ void routed_setup(unsigned char* lds, const int* cnt_g, int ne, bool dense, int tid, int*& tstart, int*& cnt) {
    tstart = (int*)(lds + MISC_OFF + 64); cnt = tstart + 16;
    __syncthreads();
    if (tid == 0) { int acc = 0; for (int e = 0; e < ne; ++e) { const int n = dense ? M : __hip_atomic_load(cnt_g + e, __ATOMIC_RELAXED, __HIP_MEMORY_SCOPE_AGENT); cnt[e] = n; tstart[e] = acc; acc += (n + 255) >> 8; } tstart[ne] = acc; }
    __syncthreads();
}

constexpr int PH_PER_LAYER = 11, NPHASE = 2 * PH_PER_LAYER;
#if FAST_GEMM
#define GEMM_CALL(S, E) gemm_fast<false>((LAS unsigned char*)lds, S, E, wave)
#define GEMM_CALL8(S, E) gemm_fast<true>((LAS unsigned char*)lds, S, E, wave)
#else
#define GEMM_CALL(S, E) gemm_naive(lds, S, E, wave * 64 + lane_id())
#endif
#define IN(k) (lo <= (k) && (k) < hi)
#define SEAM(k) do { if (IN(k) && IN((k) + 1)) xcd_barrier(bar); } while (0)
template <int L>
__device__ __forceinline__ void layer(const Args& a, unsigned char* lds, const XcdBarrier& bar, int wave, int G, int blk) {
#define lane lane_id()
#define tid (wave * 64 + lane_id())
    unsigned char* ws = a.ws;
    const int lo = a.ph_lo, hi = a.ph_hi;
    bf16* hn = (bf16*)(ws + WS_HN); bf16* proj = (bf16*)(ws + WS_PROJ); float* gates = (float*)(ws + WS_GATES);
    int* cntg = (int*)(ws + WS_CTL) + CW_CNT;
    {
        constexpr int l = L; constexpr int P = l * PH_PER_LAYER;
        const float* xin = (l == 0) ? a.in[0] : a.out;
        constexpr bool FUSED = FUSE_NORM && FAST_GEMM;
        float* rowss0 = (float*)(ws + WS_ROWP); float* rowss1 = rowss0 + (size_t)M * 16;
        bf16* x2 = (bf16*)(ws + WS_X2);
        if (IN(P + 0)) {
            if (l == 0) conv_phase(a, lds, blk * NWAVES + wave, G * NWAVES, wave, lane);
            if (l == 0) { const int gw = blk * NWAVES + wave;
                if (gw < 256) { const int lw = gw >> 6, nn = gw & 63, ln = lane; const float* pos = a.in[5] + (size_t)lw * 2048; const float* w = a.in[6] + (size_t)lw * 2048 * 64;
                    float sacc = 0.f;
                    for (int i = 0; i < 32; ++i) sacc += pos[64 * i + ln] * w[(size_t)(64 * i + ln) * 64 + nn];
                    sacc = wave_sum(sacc);
                    if (ln == 0) ((float*)(ws + WS_CTL) + CW_CBIAS)[lw * 64 + nn] = sacc; } }
            if (!(FUSED && l == 1)) norm_phase<false>(a, lds, xin, a.in[1] + l * D, hn, blk, G, wave, lane, tid);
        }
        if (!(FUSED && l == 1)) SEAM(P + 0);
        if (IN(P + 1)) {
            DenseSched S{hn, (const bf16*)(ws + WS_WIN) + (size_t)l * NIN * D, D, M / 256, NIN / 256, G, blk};
            EpiIn E{proj, gates, (FUSED && l == 1) ? rowss1 : nullptr};
            GEMM_CALL(S, E);
        }
        SEAM(P + 1);
        if (IN(P + 2)) post_phase(a, lds, l, blk, G, wave, lane, tid);
        SEAM(P + 2);
        if (IN(P + 3)) { scan_phase(a, blk, G, tid);
#if NSA_FAST && NSA_LS
            nsa_ls_phase(a, lds, l, blk, G, wave);
#elif NSA_FAST
            nsa_fast_phase(a, lds, l, blk, G, wave);
#else
            nsa_phase(a, lds, blk, G, tid);
#endif
        }
        SEAM(P + 3);
        if (IN(P + 4)) {
#if RET_FAST
            retout_fast_phase(a, lds, l, blk, G, wave);
#else
            retout_phase(a, l, blk, G, tid);
#endif
        }
        SEAM(P + 4);
        if (IN(P + 5)) {
            DenseSched S{hn, (const bf16*)(ws + WS_WOUT) + (size_t)l * D * D, D, M / 256, D / 256, G, blk};
            EpiRes E{xin, a.out, (FUSED && l == 0) ? x2 : nullptr, a.in[9] + l * D, rowss0};
            GEMM_CALL(S, E);
        }
        SEAM(P + 5);
        if (IN(P + 6)) {
            if (l == 0) { if (!FUSED) norm_phase<false, DENSE_FP8 && FAST_GEMM>(a, lds, a.out, a.in[9] + l * D, hn, blk, G, wave, lane, tid); }
            else norm_phase<true, MOE_FP8 && FAST_GEMM>(a, lds, a.out, a.in[9] + l * D, hn, blk, G, wave, lane, tid);
        }
        if (!(FUSED && l == 0)) SEAM(P + 6);
#pragma unroll
        for (int s = 0; s < 2; ++s) {
            const bool dense = (l == 0);
            if (dense && s == 1) break;
            const int ne = dense ? 1 : NE;
            const int* tok = dense ? nullptr : (const int*)(ws + WS_RTOK) + (size_t)s * NE * M;
            const float* wt = dense ? nullptr : (const float*)(ws + WS_RWT) + (size_t)s * NE * M;
            if (IN(P + 7 + 2 * s)) {
                int *tstart, *cnt; routed_setup(lds, cntg + s * 8, ne, dense, tid, tstart, cnt);
                if (!(FAST_GEMM && (dense ? DENSE_FP8 : MOE_FP8))) {
                    RoutedSched<true> S{(FUSED && dense) ? x2 : hn, (const bf16*)(ws + (dense ? WS_WGU : WS_MGU)), (size_t)2 * FF * D, D, 2 * FF / 256, G, blk, ne, tok, tstart, cnt};
                    EpiGU E{proj, (FUSED && dense) ? rowss0 : nullptr};
                    GEMM_CALL(S, E);
                } else {
#if (MOE_FP8 || DENSE_FP8) && FAST_GEMM
                    RoutedSched<true> S{hn, (const bf16*)(ws + (dense ? WS_WGU : WS_MGU)), (size_t)2 * FF * D / 2, D / 2, 2 * FF / 256, G, blk, ne, tok, tstart, cnt};
                    EpiGU8 E{(unsigned char*)proj};
                    GEMM_CALL8(S, E);
#endif
                }
            }
            SEAM(P + 7 + 2 * s);
            if (IN(P + 8 + 2 * s)) {
                int *tstart, *cnt; routed_setup(lds, cntg + s * 8, ne, dense, tid, tstart, cnt);
                if (!(FAST_GEMM && (dense ? DENSE_FP8 : MOE_FP8))) {
                    RoutedSched<false> S{proj, (const bf16*)(ws + (dense ? WS_WDN : WS_MDN)), (size_t)D * FF, FF, D / 256, G, blk, ne, tok, tstart, cnt};
                    EpiDown E{a.out, tok, wt, 1.f, (FUSED && dense) ? hn : nullptr, a.in[1] + D, rowss1};
                    GEMM_CALL(S, E);
                } else {
#if (MOE_FP8 || DENSE_FP8) && FAST_GEMM
                    RoutedSched<false> S{proj, (const bf16*)(ws + (dense ? WS_WDN : WS_MDN)), (size_t)D * FF / 2, FF / 2, D / 256, G, blk, ne, tok, tstart, cnt};
                    EpiDown E{a.out, tok, wt, 1.f / (F8_SH * F8_SW), nullptr, nullptr, nullptr};
                    GEMM_CALL8(S, E);
#endif
                }
            }
            if (!(l == 1 && s == 1)) SEAM(P + 8 + 2 * s);
        }
    }
}
#undef lane
#undef tid
#undef IN
#undef SEAM
__global__ void __launch_bounds__(NTHR, 2) fwd(Args a) {
    extern __shared__ __attribute__((aligned(16))) unsigned char lds[];
    const int wave = __builtin_amdgcn_readfirstlane(threadIdx.x >> 6);
    const int G = gridDim.x, blk = blockIdx.x;
    unsigned char* ws = a.ws;
    volatile LAS unsigned* misc = (volatile LAS unsigned*)((LAS unsigned char*)lds + MISC_OFF);
    if (wave == 0) misc[lane_id()] = 0u;
    __syncthreads();
    XcdBarrier bar; bar.bar = (unsigned*)(ws + WS_CTL) + CW_BAR; bar.x = 0; bar.st = nullptr;
    const bool multi = (a.ph_hi - a.ph_lo) > 1;
    bar.wave = wave;
    if (multi) bar = xcd_barrier_post((unsigned*)(ws + WS_CTL) + CW_BAR, misc + 8, wave);
    layer<0>(a, lds, bar, wave, G, blk);
    layer<1>(a, lds, bar, wave, G, blk);
}

extern "C" void kernel_launch(void* const* d_in, const int* in_sizes, int n_in, void* d_out, int out_size, void* d_ws, size_t ws_size, hipStream_t stream) {
    static int grid = 0;
    if (grid == 0) {
        if (n_in != 18 || out_size != M * D || ws_size < WS_END) { fprintf(stderr, "kernel_launch: unexpected problem (n_in %d out %d ws %zu)\n", n_in, out_size, ws_size); grid = -1; return; }
        int dev = 0, cus = 0;
        if (hipGetDevice(&dev) != hipSuccess || hipDeviceGetAttribute(&cus, hipDeviceAttributeMultiprocessorCount, dev) != hipSuccess) { grid = -1; return; }
        if (hipFuncSetAttribute((const void*)fwd, hipFuncAttributeMaxDynamicSharedMemorySize, LDS_BYTES) != hipSuccess) { grid = -1; return; }
        int per_cu = 0;
        if (hipOccupancyMaxActiveBlocksPerMultiprocessor(&per_cu, (const void*)fwd, NTHR, LDS_BYTES) != hipSuccess || per_cu < 1) fprintf(stderr, "kernel_launch: occupancy query says %d\n", per_cu);
        (void)hipGetLastError();
        grid = 256;
        if (cus < 256) { fprintf(stderr, "kernel_launch: needs 256 CUs, device has %d\n", cus); grid = -1; return; }
    }
    if (grid < 0) return;
    (void)hipMemsetAsync((char*)d_ws + WS_CTL, 0, CTL_BYTES, stream);
    Args a{};
    for (int i = 0; i < 18; ++i) a.in[i] = (const float*)d_in[i];
    a.out = (float*)d_out; a.ws = (unsigned char*)d_ws;
#if ONE_LAUNCH
    a.ph_lo = 0; a.ph_hi = NPHASE;
    hipLaunchKernelGGL(fwd, dim3(grid), dim3(NTHR), LDS_BYTES, stream, a);
#else
    for (int p = 0; p < NPHASE; ++p) {
        if (p == 9 || p == 10) continue;
        a.ph_lo = p; a.ph_hi = p + 1;
        hipLaunchKernelGGL(fwd, dim3(grid), dim3(NTHR), LDS_BYTES, stream, a);
    }
#endif
}
```

```cpp
#include <hip/hip_runtime.h>
#include <cstdio>
#include <cstdint>

#ifndef FAST_GEMM
#define FAST_GEMM 1
#endif
#ifndef NSA_FAST
#define NSA_FAST 1
#endif
#ifndef MOE_FP8
#define MOE_FP8 1
#endif
#ifndef DENSE_FP8
#define DENSE_FP8 0
#endif
#ifndef FUSE_NORM
#define FUSE_NORM 0
#endif
#ifndef NSA_LS
#define NSA_LS 0
#endif
#ifndef RET_FAST
#define RET_FAST 1
#endif
#ifndef ONE_LAUNCH
#define ONE_LAUNCH 1
#endif

#define LAS __attribute__((address_space(3)))
typedef unsigned short bf16;
typedef float f32x4 __attribute__((ext_vector_type(4)));
typedef unsigned u32x4 __attribute__((ext_vector_type(4)));
typedef unsigned u32x2 __attribute__((ext_vector_type(2)));
typedef short bf16x8 __attribute__((ext_vector_type(8)));
typedef float f32x16 __attribute__((ext_vector_type(16)));
typedef int v8i __attribute__((ext_vector_type(8)));
typedef int v4i __attribute__((ext_vector_type(4)));

constexpr int NB = 4, T = 8192, D = 1024, M = NB * T;
constexpr int PC = 2816;
constexpr int NIN = 3072;
constexpr int INC = 2840;
constexpr int FF = 2816, NE = 8;
constexpr int C_Q = 0, C_KC = 512, C_VC = 640, C_KS = 768, C_VS = 896, C_KW = 1024, C_VW = 1152, C_RQ = 1280, C_RK = 1536, C_RV = 1792, C_RG = 2304;
constexpr int NCB = 512;
constexpr float EPS = 1e-6f;
constexpr float LOG2E = 1.4426950408889634f;
constexpr int NTHR = 512, NWAVES = 8;
constexpr int HROWS = M + NE * 256;

constexpr size_t MiB = 1u << 20;
constexpr size_t WS_CTL = 0, CTL_BYTES = 1 * MiB;
constexpr size_t WS_WIN = 2 * MiB;
constexpr size_t WS_WOUT = 14 * MiB;
constexpr size_t WS_WGU = 18 * MiB;
constexpr size_t WS_WDN = 29 * MiB;
constexpr size_t WS_MGU = 35 * MiB;
constexpr size_t WS_MDN = (MOE_FP8 && FAST_GEMM ? 79 : 123) * MiB;
constexpr size_t WS_X2 = 102 * MiB;
static_assert(!FUSE_NORM || (MOE_FP8 && FAST_GEMM && !DENSE_FP8), "FUSE_NORM uses workspace freed by MOE_FP8 and the bf16 dense FFN");
static_assert(!FUSE_NORM || (WS_X2 >= WS_MDN + (size_t)8 * FF * D && WS_X2 + (size_t)M * D * 2 <= 168 * MiB), "X2 region");
constexpr size_t WS_HN = 168 * MiB;
constexpr size_t WS_PROJ = 232 * MiB;
constexpr size_t WS_GATES = 420 * MiB;
constexpr size_t WS_KCMP = 423 * MiB;
constexpr size_t WS_VCMP = WS_KCMP + 512 * 1024;
constexpr size_t WS_RETS = 424 * MiB;
constexpr size_t WS_RTOK = 440 * MiB;
constexpr size_t WS_RWT = 442 * MiB;
constexpr size_t WS_KS = 444 * MiB;
constexpr size_t WS_KW = 452 * MiB;
constexpr size_t WS_VST = 460 * MiB;
constexpr size_t WS_VWT = 468 * MiB;
constexpr size_t WS_VCT = 476 * MiB;
constexpr size_t WS_WCT = 477 * MiB;
constexpr size_t WS_RST = 478 * MiB;
constexpr size_t WS_KCF = 486 * MiB;
constexpr size_t WS_ROWP = 487 * MiB;
constexpr size_t WS_END = 491 * MiB;
static_assert(WS_PROJ + (size_t)HROWS * FF * 2 <= WS_GATES, "hidden overlay fits");
constexpr int CW_BAR = 4096;
constexpr int CW_CNT = 16384;
constexpr int CW_ROWSS = 32768;
constexpr int CW_CBIAS = 196608;

constexpr int LDS_BYTES = 147456;
constexpr int MISC_OFF = 131072;
constexpr int SELM_OFF = 131072 + 1024;
constexpr int NVOFF_OFF = 131072 + 2048;

__device__ __forceinline__ unsigned f2bf(float f) { unsigned u = __builtin_bit_cast(unsigned, f); return (u + 0x7fffu + ((u >> 16) & 1u)) >> 16; }
typedef float f32x2_t __attribute__((ext_vector_type(2)));
typedef __bf16 bf16x2_t __attribute__((ext_vector_type(2)));
__device__ __forceinline__ unsigned pk2(float lo, float hi) { const f32x2_t v = {lo, hi}; const bf16x2_t b = __builtin_convertvector(v, bf16x2_t); return __builtin_bit_cast(unsigned, b); }
__device__ __forceinline__ float bflo(unsigned u) { return __builtin_bit_cast(float, u << 16); }
__device__ __forceinline__ float bfhi(unsigned u) { return __builtin_bit_cast(float, u & 0xffff0000u); }
__device__ __forceinline__ float bf2f(bf16 h) { return __builtin_bit_cast(float, (unsigned)h << 16); }
__device__ __forceinline__ float wave_sum(float v) {
#pragma unroll
    for (int o = 1; o < 64; o <<= 1) v += __shfl_xor(v, o);
    return v;
}
__device__ __forceinline__ unsigned pk4_fp8(float a, float b, float c, float d) {
    a = __builtin_amdgcn_fmed3f(a, -448.f, 448.f); b = __builtin_amdgcn_fmed3f(b, -448.f, 448.f); c = __builtin_amdgcn_fmed3f(c, -448.f, 448.f); d = __builtin_amdgcn_fmed3f(d, -448.f, 448.f);
    int w = 0; w = __builtin_amdgcn_cvt_pk_fp8_f32(a, b, w, false); w = __builtin_amdgcn_cvt_pk_fp8_f32(c, d, w, true); return (unsigned)w;
}
constexpr float F8_SA = 16.f, F8_SW = 256.f, F8_SH = 8.f;
#define LDS_WAIT() asm volatile("s_waitcnt lgkmcnt(0)" ::: "memory")
__device__ __forceinline__ float fsigmoid(float x) { return __builtin_amdgcn_rcpf(1.f + __builtin_amdgcn_exp2f(x * -1.4426950408889634f)); }
__device__ __forceinline__ float fsilu(float x) { return x * fsigmoid(x); }
__device__ __forceinline__ int lane_id() { int l; asm volatile("v_mbcnt_lo_u32_b32 %0, -1, 0\n\tv_mbcnt_hi_u32_b32 %0, -1, %0" : "=v"(l)); return l; }

#define XB_TMO      128
#define XB_XCNT(j)  (256  + 64 * (j))
#define XB_XSUB(j)  (1280 + 64 * (j))
#define XB_XGEN(j)  (2304 + 64 * (j))
#define XB_TOP      3328
#define XB_TOPGEN   3392
#define XCD_BAR_WORDS 3456
#define XB_SPIN_CAP (1u << 18)
__device__ __forceinline__ unsigned xb_ld(unsigned* p)              { return __hip_atomic_load(p, __ATOMIC_RELAXED, __HIP_MEMORY_SCOPE_AGENT); }
__device__ __forceinline__ unsigned xb_add(unsigned* p, unsigned v) { return __hip_atomic_fetch_add(p, v, __ATOMIC_RELAXED, __HIP_MEMORY_SCOPE_AGENT); }
__device__ __forceinline__ unsigned xb_xcc_id() { return (unsigned)__builtin_amdgcn_s_getreg((3 << 11) | 20) & 0xFu; }
#define XB_SPIN(cond, bar) do { unsigned _sp = 0; while (cond) { __builtin_amdgcn_s_sleep(1); \
    if ((++_sp & 255u) == 0u) { if (xb_ld(&(bar)[XB_TMO])) break; if (_sp > XB_SPIN_CAP) { atomicAdd(&(bar)[XB_TMO], 1u); break; } } } } while (0)
struct XcdBarrier { unsigned* bar; unsigned x; volatile LAS unsigned* st; int wave; };
__device__ __forceinline__ XcdBarrier xcd_barrier_post(unsigned* bar, volatile LAS unsigned* st, int wave) {
    XcdBarrier b; b.bar = bar; b.x = xb_xcc_id(); b.st = st; b.wave = wave;
    if (wave == 0 && lane_id() == 0) (void)xb_add(&bar[XB_XCNT(b.x)], 1u);
    return b;
}
__device__ __forceinline__ void xcd_barrier_complete(unsigned* bar, unsigned x, unsigned& nloc, unsigned& nx) {
    const unsigned G = gridDim.x * gridDim.y * gridDim.z;
    unsigned sum, cnt, mine, sp = 0u;
    for (;;) {
        sum = 0u; cnt = 0u; mine = 0u;
#pragma unroll
        for (unsigned j = 0; j < 16; ++j) { const unsigned c = xb_ld(&bar[XB_XCNT(j)]); sum += c; cnt += (c > 0u) ? 1u : 0u; mine = (j == x) ? c : mine; }
        if (sum == G) break;
        __builtin_amdgcn_s_sleep(1);
        if ((++sp & 255u) == 0u) { if (xb_ld(&bar[XB_TMO])) break; if (sp > XB_SPIN_CAP) { atomicAdd(&bar[XB_TMO], 1u); break; } }
    }
    nloc = mine > 0u ? mine : 1u; nx = cnt > 0u ? cnt : 1u;
}
__device__ __forceinline__ void xcd_barrier(const XcdBarrier& b) {
    asm volatile("s_waitcnt vmcnt(0)" ::: "memory");
    __syncthreads();
    if (b.wave == 0 && lane_id() == 0) {
        unsigned* bar = b.bar;
        __builtin_amdgcn_s_waitcnt(0);
        unsigned nloc = b.st[0], nx = b.st[1];
        if (nloc == 0u) { xcd_barrier_complete(bar, b.x, nloc, nx); b.st[0] = nloc; b.st[1] = nx; }
        const unsigned old = xb_add(&bar[XB_XSUB(b.x)], 1u);
        const unsigned gen = old / nloc;
        if (old + 1u == (gen + 1u) * nloc) {
            __builtin_amdgcn_fence(__ATOMIC_RELEASE, "agent");
            asm volatile("s_waitcnt vmcnt(0)" ::: "memory");
            const unsigned og = xb_add(&bar[XB_TOP], 1u);
            const unsigned tg = og / nx;
            if (og + 1u == (tg + 1u) * nx) xb_add(&bar[XB_TOPGEN], 1u);
            else XB_SPIN(xb_ld(&bar[XB_TOPGEN]) == tg, bar);
            __builtin_amdgcn_fence(__ATOMIC_ACQUIRE, "agent");
            xb_add(&bar[XB_XGEN(b.x)], 1u);
            asm volatile("s_waitcnt vmcnt(0)" ::: "memory");
        } else {
            XB_SPIN(xb_ld(&bar[XB_XGEN(b.x)]) == gen, bar);
            __builtin_amdgcn_fence(__ATOMIC_ACQUIRE, "agent");
            asm volatile("s_waitcnt vmcnt(0)" ::: "memory");
        }
    }
    __syncthreads();
}

struct Args {
    const float* in[18];
    float* out;
    unsigned char* ws;
    int ph_lo, ph_hi;
};

__device__ __forceinline__ void tr_item(const float* __restrict__ src, int ld, int k0, int c0, int nvalid, bf16* dst, int Kd, float* scr, int lane) {
#pragma unroll 8
    for (int i = 0; i < 32; ++i) { const int kk = 2 * i + (lane >> 5), n = lane & 31; scr[kk * 33 + n] = (n < nvalid) ? src[(size_t)(k0 + kk) * ld + c0 + n] : 0.f; }
    LDS_WAIT();
    const int c = lane & 7;
#pragma unroll
    for (int j = 0; j < 4; ++j) { const int n = (lane >> 3) + 8 * j; const float* s = scr + (8 * c) * 33 + n;
        u32x4 o; o.x = pk2(s[0 * 33], s[1 * 33]); o.y = pk2(s[2 * 33], s[3 * 33]); o.z = pk2(s[4 * 33], s[5 * 33]); o.w = pk2(s[6 * 33], s[7 * 33]);
        *(u32x4*)(dst + (size_t)n * Kd + k0 + 8 * c) = o; }
    LDS_WAIT();
}
__device__ __forceinline__ void tr_item8(const float* __restrict__ src, int ld, int k0, int c0, unsigned char* dst, int Kd, float* scr, int lane) {
#pragma unroll 8
    for (int i = 0; i < 32; ++i) { const int kk = 2 * i + (lane >> 5), n = lane & 31; scr[kk * 33 + n] = src[(size_t)(k0 + kk) * ld + c0 + n] * F8_SW; }
    LDS_WAIT();
    const int c = lane & 7;
#pragma unroll
    for (int j = 0; j < 4; ++j) { const int n = (lane >> 3) + 8 * j; const float* sp = scr + (8 * c) * 33 + n;
        u32x2 o; o.x = pk4_fp8(sp[0 * 33], sp[1 * 33], sp[2 * 33], sp[3 * 33]); o.y = pk4_fp8(sp[4 * 33], sp[5 * 33], sp[6 * 33], sp[7 * 33]);
        *(u32x2*)(dst + (size_t)n * Kd + k0 + 8 * c) = o; }
    LDS_WAIT();
}
__device__ __forceinline__ void conv_phase(const Args& a, unsigned char* lds, int gw, int NGW, int wave, int lane) {
    float* scr = (float*)lds + wave * (64 * 33);
    unsigned char* ws = a.ws;
    constexpr int I_IN = (NIN / 32) * (D / 64);
    constexpr int I_OUT = (D / 32) * (D / 64);
    constexpr int I_GU = (2 * FF / 32) * (D / 64);
    constexpr int I_DN = (D / 32) * (FF / 64);
    constexpr int I_CMP = 2 * 32;
    constexpr int NITEMS = 2 * I_IN + 2 * I_OUT + I_GU + I_DN + NE * (I_GU + I_DN) + 4 * I_CMP;
    for (int it0 = gw; it0 < NITEMS; it0 += NGW) {
        int it = it0;
        if (it < 2 * I_IN) { const int l = it / I_IN, r = it % I_IN, nb = r % (NIN / 32), kb = r / (NIN / 32), n0 = 32 * nb;
            int c0, nv; if (n0 < 1280) { c0 = n0; nv = 32; } else if (n0 < 2816) { c0 = n0 + 24; nv = 32; } else if (n0 == 2816) { c0 = 1280; nv = 24; } else { c0 = 0; nv = 0; }
            tr_item(a.in[2] + (size_t)l * D * INC, INC, 64 * kb, c0, nv, (bf16*)(ws + WS_WIN) + ((size_t)l * NIN + n0) * D, D, scr, lane); continue; }
        it -= 2 * I_IN;
        if (it < 2 * I_OUT) { const int l = it / I_OUT, r = it % I_OUT, nb = r % (D / 32), kb = r / (D / 32), n0 = 32 * nb;
            tr_item(a.in[8] + (size_t)l * D * D, D, 64 * kb, n0, 32, (bf16*)(ws + WS_WOUT) + ((size_t)l * D + n0) * D, D, scr, lane); continue; }
        it -= 2 * I_OUT;
        if (it < I_GU) { const int nb = it % (2 * FF / 32), kb = it / (2 * FF / 32), n0 = 32 * nb, p = n0 >> 8, c = n0 & 255;
#if DENSE_FP8
            tr_item8(c < 128 ? a.in[10] : a.in[11], FF, 64 * kb, 128 * p + (c & 127), (unsigned char*)(ws + WS_WGU) + (size_t)n0 * D, D, scr, lane); continue; }
#else
            tr_item(c < 128 ? a.in[10] : a.in[11], FF, 64 * kb, 128 * p + (c & 127), 32, (bf16*)(ws + WS_WGU) + (size_t)n0 * D, D, scr, lane); continue; }
#endif
        it -= I_GU;
        if (it < I_DN) { const int nb = it % (D / 32), kb = it / (D / 32), n0 = 32 * nb;
#if DENSE_FP8
            tr_item8(a.in[12], D, 64 * kb, n0, (unsigned char*)(ws + WS_WDN) + (size_t)n0 * FF, FF, scr, lane); continue; }
#else
            tr_item(a.in[12], D, 64 * kb, n0, 32, (bf16*)(ws + WS_WDN) + (size_t)n0 * FF, FF, scr, lane); continue; }
#endif
        it -= I_DN;
        if (it < NE * I_GU) { const int e = it / I_GU, r = it % I_GU, nb = r % (2 * FF / 32), kb = r / (2 * FF / 32), n0 = 32 * nb, p = n0 >> 8, c = n0 & 255;
#if MOE_FP8
            tr_item8((c < 128 ? a.in[15] : a.in[16]) + (size_t)e * D * FF, FF, 64 * kb, 128 * p + (c & 127), (unsigned char*)(ws + WS_MGU) + ((size_t)e * 2 * FF + n0) * D, D, scr, lane); continue; }
#else
            tr_item((c < 128 ? a.in[15] : a.in[16]) + (size_t)e * D * FF, FF, 64 * kb, 128 * p + (c & 127), 32, (bf16*)(ws + WS_MGU) + ((size_t)e * 2 * FF + n0) * D, D, scr, lane); continue; }
#endif
        it -= NE * I_GU;
        if (it >= NE * I_DN) { it -= NE * I_DN; const int lw = it / I_CMP, r = it % I_CMP, nb = r & 1, kb = r >> 1;
            tr_item(a.in[6] + (size_t)lw * 2048 * 64, 64, 64 * kb, 32 * nb, 32, (bf16*)(ws + WS_WCT) + ((size_t)lw * 64 + 32 * nb) * 2048, 2048, scr, lane); continue; }
        { const int e = it / I_DN, r = it % I_DN, nb = r % (D / 32), kb = r / (D / 32), n0 = 32 * nb;
#if MOE_FP8
            tr_item8(a.in[17] + (size_t)e * FF * D, D, 64 * kb, n0, (unsigned char*)(ws + WS_MDN) + ((size_t)e * D + n0) * FF, FF, scr, lane); }
#else
            tr_item(a.in[17] + (size_t)e * FF * D, D, 64 * kb, n0, 32, (bf16*)(ws + WS_MDN) + ((size_t)e * D + n0) * FF, FF, scr, lane); }
#endif
    }
}

template <bool ROUTE, bool OUT8 = false>
__device__ __forceinline__ void norm_phase(const Args& a, unsigned char* lds, const float* x, const float* g, bf16* out, int blk, int G, int wave, int lane, int tid) {
    const int RPB = M / G;
    int* r_e = (int*)lds;
    float* r_w = (float*)(lds + 8192);
    const float* router = a.in[13]; const float* rb = a.in[14];
    f32x4 gv[4];
#pragma unroll
    for (int j = 0; j < 4; ++j) gv[j] = ((const f32x4*)g)[64 * j + lane];
    f32x4 vn[4];
    { const f32x4* xr0 = (const f32x4*)(x + (size_t)(blk * RPB + wave) * D) + lane;
#pragma unroll
        for (int j = 0; j < 4; ++j) vn[j] = xr0[64 * j]; }
    for (int rl = wave; rl < RPB; rl += NWAVES) {
        const int m = blk * RPB + rl;
        f32x4 v[4]; float ss = 0.f;
#pragma unroll
        for (int j = 0; j < 4; ++j) v[j] = vn[j];
        if (rl + NWAVES < RPB) { const f32x4* xr1 = (const f32x4*)(x + (size_t)(m + NWAVES) * D) + lane;
#pragma unroll
            for (int j = 0; j < 4; ++j) vn[j] = xr1[64 * j]; }
#pragma unroll
        for (int j = 0; j < 4; ++j) ss += (v[j].x * v[j].x + v[j].y * v[j].y) + (v[j].z * v[j].z + v[j].w * v[j].w);
        const float rstd = 1.0f / sqrtf(wave_sum(ss) * (1.f / D) + EPS);
        if (OUT8) {
            unsigned* o4 = (unsigned*)((unsigned char*)out + (size_t)m * D) + lane;
#pragma unroll
            for (int j = 0; j < 4; ++j) { v[j] = v[j] * rstd * gv[j]; o4[64 * j] = pk4_fp8(v[j].x * F8_SA, v[j].y * F8_SA, v[j].z * F8_SA, v[j].w * F8_SA); }
        } else {
        u32x2* o8 = (u32x2*)(out + (size_t)m * D) + lane;
#pragma unroll
        for (int j = 0; j < 4; ++j) { v[j] = v[j] * rstd * gv[j]; u32x2 w; w.x = pk2(v[j].x, v[j].y); w.y = pk2(v[j].z, v[j].w); o8[64 * j] = w; }
        }
        if (ROUTE) {
            float lg[8];
#pragma unroll
            for (int e = 0; e < 8; ++e) lg[e] = 0.f;
#pragma unroll
            for (int j = 0; j < 4; ++j) {
#pragma unroll
                for (int i = 0; i < 4; ++i) { const int k = 4 * (64 * j + lane) + i; const f32x4 r0 = *(const f32x4*)(router + (size_t)k * 8), r1 = *(const f32x4*)(router + (size_t)k * 8 + 4); const float xv = v[j][i];
                    lg[0] += xv * r0.x; lg[1] += xv * r0.y; lg[2] += xv * r0.z; lg[3] += xv * r0.w; lg[4] += xv * r1.x; lg[5] += xv * r1.y; lg[6] += xv * r1.z; lg[7] += xv * r1.w; }
            }
#pragma unroll
            for (int e = 0; e < 8; ++e) lg[e] = wave_sum(lg[e]) + rb[e];
            int i0 = 0; float v0 = lg[0];
#pragma unroll
            for (int e = 1; e < 8; ++e) if (lg[e] > v0) { v0 = lg[e]; i0 = e; }
            int i1 = -1; float v1 = -3.0e38f;
#pragma unroll
            for (int e = 0; e < 8; ++e) if (e != i0 && lg[e] > v1) { v1 = lg[e]; i1 = e; }
            const float w1 = 1.f / (1.f + __expf(v0 - v1)), w0 = 1.f - w1;
            if (lane == 0) { r_e[2 * rl] = i0; r_e[2 * rl + 1] = i1; r_w[2 * rl] = w0; r_w[2 * rl + 1] = w1; }
        }
    }
    if (ROUTE) {
        __syncthreads();
        if (tid < 16) {
            const int s = tid >> 3, e = tid & 7; int n = 0;
            for (int rl = 0; rl < RPB; ++rl) n += (r_e[2 * rl + s] == e) ? 1 : 0;
            int* cnt = (int*)(a.ws + WS_CTL) + CW_CNT;
            int base = n ? atomicAdd(&cnt[s * 8 + e], n) : 0;
            int* tok = (int*)(a.ws + WS_RTOK) + (size_t)(s * 8 + e) * M; float* wt = (float*)(a.ws + WS_RWT) + (size_t)(s * 8 + e) * M;
            for (int rl = 0; rl < RPB; ++rl) if (r_e[2 * rl + s] == e) { tok[base] = blk * RPB + rl; wt[base] = r_w[2 * rl + s]; ++base; }
        }
        __syncthreads();
    }
}

__device__ __forceinline__ void post_phase(const Args& a, unsigned char* lds, int l, int blk, int G, int wave, int lane, int tid) {
    bf16* proj = (bf16*)(a.ws + WS_PROJ);
    const int gw = blk * NWAVES + wave, NGW = G * NWAVES;
    {
        const float* qg = a.in[3] + l * 64; const float* kg = a.in[4] + l * 192;
        const int sub = lane & 7;
        for (int v0 = gw * 8; v0 < M * 12; v0 += NGW * 8) {
            const int vec = v0 + (lane >> 3), m = vec / 12, j = vec % 12;
            int col; const float* gp; float sc = 1.f;
            if (j < 8) { col = C_Q + 64 * j; gp = qg; sc = 0.125f * LOG2E; } else if (j < 10) { col = C_KS + 64 * (j - 8); gp = kg + 64; } else { col = C_KW + 64 * (j - 10); gp = kg + 128; }
            u32x4* p = (u32x4*)(proj + (size_t)m * PC + col + 8 * sub);
            const u32x4 u = *p;
            float f[8] = {bflo(u.x), bfhi(u.x), bflo(u.y), bfhi(u.y), bflo(u.z), bfhi(u.z), bflo(u.w), bfhi(u.w)};
            float ss = 0.f;
#pragma unroll
            for (int i = 0; i < 8; ++i) ss += f[i] * f[i];
            ss += __shfl_xor(ss, 1); ss += __shfl_xor(ss, 2); ss += __shfl_xor(ss, 4);
            const float rs = sc / sqrtf(ss * (1.f / 64.f) + EPS);
            const f32x4 g0 = *(const f32x4*)(gp + 8 * sub), g1 = *(const f32x4*)(gp + 8 * sub + 4);
            u32x4 o; o.x = pk2(f[0] * rs * g0.x, f[1] * rs * g0.y); o.y = pk2(f[2] * rs * g0.z, f[3] * rs * g0.w); o.z = pk2(f[4] * rs * g1.x, f[5] * rs * g1.y); o.w = pk2(f[6] * rs * g1.z, f[7] * rs * g1.w);
            *p = o;
            if (j >= 8) { const int gg = (j - 8) & 1, bb = m / T, tt = m % T, kk = tt & 31, nn = (kk & 0x13) | ((kk & 4) << 1) | ((kk & 8) >> 1);
                *(u32x4*)((bf16*)(a.ws + (j < 10 ? WS_KS : WS_KW)) + (size_t)(bb * 2 + gg) * T * 64 + ((size_t)((tt >> 5) * 4 + (sub >> 1)) * 64 + (sub & 1) * 32 + nn) * 8) = o; }
        }
    }
    {
        const int dim = tid & 63, tq = tid >> 6;
        for (int u = blk; u < 2 * NB * 2 * 128; u += G) {
            const int which = u >> 10, b = (u >> 8) & 3, g = (u >> 7) & 1, ch = u & 127;
            const bf16* src = proj + ((size_t)b * T + ch * 64 + 8 * tq) * PC + (which ? C_VW : C_VS) + 64 * g + dim;
            unsigned short v[8];
#pragma unroll
            for (int i = 0; i < 8; ++i) v[i] = src[(size_t)i * PC];
            u32x4 o; o.x = v[0] | ((unsigned)v[1] << 16); o.y = v[2] | ((unsigned)v[3] << 16); o.z = v[4] | ((unsigned)v[5] << 16); o.w = v[6] | ((unsigned)v[7] << 16);
            { const int t8 = ch * 64 + 8 * tq, tile = t8 >> 5, ko = t8 & 31;
                *(u32x4*)((bf16*)(a.ws + (which ? WS_VWT : WS_VST)) + (size_t)(b * 2 + g) * 64 * T + ((size_t)((tile * 2 + (ko >> 4)) * 2 + (dim >> 5)) * 64 + ((ko >> 3) & 1) * 32 + (dim & 31)) * 8) = o; }
        }
    }
    {
        const float* kg0 = a.in[4] + l * 192;
        const float* cbias = (const float*)(a.ws + WS_CTL) + CW_CBIAS + l * 128;
        float* red = (float*)lds;
        const int n = lane & 31, h = lane >> 5;
        for (int u = blk; u < 2 * NB * 2 * 16; u += G) {
            const int which = u >> 7, b = (u >> 5) & 3, g = (u >> 4) & 1, rt = u & 15;
            const bf16* arow = proj + ((size_t)b * T + 16 * (32 * rt + n) + 4 * wave) * PC + (which ? C_VC : C_KC) + g * 64 + 8 * h;
            const bf16* wt = (const bf16*)(a.ws + WS_WCT) + ((size_t)(l * 2 + which) * 64 + n) * 2048 + 256 * wave + 8 * h;
            f32x16 acc0, acc1;
#pragma unroll
            for (int i = 0; i < 16; ++i) { acc0[i] = 0.f; acc1[i] = 0.f; }
#pragma unroll
            for (int ks = 0; ks < 16; ++ks) {
                const bf16x8 af = *(const bf16x8*)(arow + (size_t)(ks >> 2) * PC + 16 * (ks & 3));
                const bf16x8 b0 = *(const bf16x8*)(wt + 16 * ks), b1 = *(const bf16x8*)(wt + 32 * 2048 + 16 * ks);
                acc0 = __builtin_amdgcn_mfma_f32_32x32x16_bf16(af, b0, acc0, 0, 0, 0); acc1 = __builtin_amdgcn_mfma_f32_32x32x16_bf16(af, b1, acc1, 0, 0, 0);
            }
            __syncthreads();
#pragma unroll
            for (int i = 0; i < 16; ++i) { const int row = 8 * (i >> 2) + 4 * h + (i & 3); red[(wave * 32 + row) * 64 + n] = acc0[i]; red[(wave * 32 + row) * 64 + 32 + n] = acc1[i]; }
            __syncthreads();
            { const int row = tid >> 4, n4 = (tid & 15) * 4, c = 32 * rt + row;
                f32x4 sum = *(const f32x4*)(cbias + which * 64 + n4);
#pragma unroll
                for (int w = 0; w < 8; ++w) sum = sum + *(const f32x4*)(red + (w * 32 + row) * 64 + n4);
                if (which == 0) { float ss = sum.x * sum.x + sum.y * sum.y + sum.z * sum.z + sum.w * sum.w;
                    ss += __shfl_xor(ss, 1); ss += __shfl_xor(ss, 2); ss += __shfl_xor(ss, 4); ss += __shfl_xor(ss, 8);
                    const float rs = 1.f / sqrtf(ss * (1.f / 64.f) + EPS); const f32x4 gg = *(const f32x4*)(kg0 + n4); sum = sum * rs * gg; }
                if (c >= 511) sum = (f32x4){0.f, 0.f, 0.f, 0.f};
                u32x2 o; o.x = pk2(sum.x, sum.y); o.y = pk2(sum.z, sum.w);
                *(u32x2*)((bf16*)(a.ws + (which ? WS_VCMP : WS_KCMP)) + ((size_t)(b * 2 + g) * NCB + c) * 64 + n4) = o;
                const int ko = c & 31;
                if (which) {
                    bf16* dT = (bf16*)(a.ws + WS_VCT) + (size_t)(b * 2 + g) * 64 * NCB + ((size_t)(((c >> 5) * 2 + (ko >> 4)) * 2 + (n4 >> 5)) * 64 + ((ko >> 3) & 1) * 32 + (n4 & 31)) * 8 + (ko & 7);
                    dT[0] = (bf16)(o.x & 0xffffu); dT[8] = (bf16)(o.x >> 16); dT[16] = (bf16)(o.y & 0xffffu); dT[24] = (bf16)(o.y >> 16);
                } else {
                    const int nn = (ko & 0x13) | ((ko & 4) << 1) | ((ko & 8) >> 1);
                    *(u32x2*)((bf16*)(a.ws + WS_KCF) + (size_t)(b * 2 + g) * NCB * 64 + ((size_t)((c >> 5) * 4 + (n4 >> 4)) * 64 + ((n4 >> 3) & 1) * 32 + nn) * 8 + (n4 & 7)) = o; } }
        }
        __syncthreads();
    }
    {
        float* rets = (float*)(a.ws + WS_RETS);
        float* Ksf = (float*)lds;
        float* Vsf = Ksf + 128 * 32;
        const int d = tid >> 4, e4 = (tid & 15) * 4;
        for (int u = blk; u < NB * 8 * 64; u += G) {
            const int b = u >> 9, h = (u >> 6) & 7, c = u & 63;
            const float lg2 = log2f(1.f - exp2f(-5.f - (float)h));
            const bf16* base = proj + ((size_t)b * T + c * 128) * PC;
            __syncthreads();
            { const int row = tid >> 2, pc = tid & 3; const u32x4 uk = *(const u32x4*)(base + (size_t)row * PC + C_RK + 32 * h + 8 * pc); const float z = exp2f((float)(127 - row) * lg2);
                *(f32x4*)(Ksf + row * 32 + 8 * pc) = (f32x4){bflo(uk.x) * z, bfhi(uk.x) * z, bflo(uk.y) * z, bfhi(uk.y) * z};
                *(f32x4*)(Ksf + row * 32 + 8 * pc + 4) = (f32x4){bflo(uk.z) * z, bfhi(uk.z) * z, bflo(uk.w) * z, bfhi(uk.w) * z}; }
#pragma unroll
            for (int it = 0; it < 2; ++it) { const int idx = tid + NTHR * it, row = idx >> 3, pc = idx & 7; const u32x4 uv = *(const u32x4*)(base + (size_t)row * PC + C_RV + 64 * h + 8 * pc);
                *(f32x4*)(Vsf + row * 64 + 8 * pc) = (f32x4){bflo(uv.x), bfhi(uv.x), bflo(uv.y), bfhi(uv.y)};
                *(f32x4*)(Vsf + row * 64 + 8 * pc + 4) = (f32x4){bflo(uv.z), bfhi(uv.z), bflo(uv.w), bfhi(uv.w)}; }
            __syncthreads();
            f32x4 acc = (f32x4){0.f, 0.f, 0.f, 0.f};
#pragma unroll 8
            for (int j = 0; j < 128; ++j) { const float kz = Ksf[j * 32 + d]; acc = acc + *(const f32x4*)(Vsf + j * 64 + e4) * kz; }
            *(f32x4*)(rets + ((size_t)(b * 8 + h) * 64 + c) * 2048 + d * 64 + e4) = acc;
        }
        __syncthreads();
    }
}

__device__ __forceinline__ void scan_phase(const Args& a, int blk, int G, int tid) {
    float* rets = (float*)(a.ws + WS_RETS);
    if (tid < 256) {
        const int i = blk * 256 + tid;
        if (i < 32 * 2048) {
            const int bh = i >> 11, idx = i & 2047, h = bh & 7;
            const float gc = exp2f(128.f * log2f(1.f - exp2f(-5.f - (float)h)));
            float* p = rets + (size_t)bh * 64 * 2048 + idx;
            bf16* st = (bf16*)(a.ws + WS_RST) + (size_t)bh * 64 * 2048 + (idx & 63) * 32 + (idx >> 6);
            float tv[64];
#pragma unroll
            for (int c = 0; c < 64; ++c) tv[c] = p[(size_t)c * 2048];
            float S = 0.f;
#pragma unroll
            for (int c = 0; c < 64; ++c) { p[(size_t)c * 2048] = S; st[(size_t)c * 2048] = (bf16)f2bf(S); S = S * gc + tv[c]; }
        }
    }
}

__device__ __forceinline__ float dot32(const float (&q)[32], const bf16* kp) {
    const u32x4* p = (const u32x4*)kp; float s = 0.f;
#pragma unroll
    for (int i = 0; i < 4; ++i) { const u32x4 u = p[i];
        s += q[8 * i + 0] * bflo(u.x) + q[8 * i + 1] * bfhi(u.x) + q[8 * i + 2] * bflo(u.y) + q[8 * i + 3] * bfhi(u.y) + q[8 * i + 4] * bflo(u.z) + q[8 * i + 5] * bfhi(u.z) + q[8 * i + 6] * bflo(u.w) + q[8 * i + 7] * bfhi(u.w); }
    return s;
}
__device__ __forceinline__ float dot16(const float (&q)[16], const bf16* kp) {
    const u32x4* p = (const u32x4*)kp; float s = 0.f;
#pragma unroll
    for (int i = 0; i < 2; ++i) { const u32x4 u = p[i];
        s += q[8 * i + 0] * bflo(u.x) + q[8 * i + 1] * bfhi(u.x) + q[8 * i + 2] * bflo(u.y) + q[8 * i + 3] * bfhi(u.y) + q[8 * i + 4] * bflo(u.z) + q[8 * i + 5] * bfhi(u.z) + q[8 * i + 6] * bflo(u.w) + q[8 * i + 7] * bfhi(u.w); }
    return s;
}
__device__ __forceinline__ void axpy16(float (&o)[16], float p, const bf16* vp) {
    const u32x4* q = (const u32x4*)vp;
#pragma unroll
    for (int i = 0; i < 2; ++i) { const u32x4 u = q[i];
        o[8 * i + 0] += p * bflo(u.x); o[8 * i + 1] += p * bfhi(u.x); o[8 * i + 2] += p * bflo(u.y); o[8 * i + 3] += p * bfhi(u.y); o[8 * i + 4] += p * bflo(u.z); o[8 * i + 5] += p * bfhi(u.z); o[8 * i + 6] += p * bflo(u.w); o[8 * i + 7] += p * bfhi(u.w); }
}
__device__ __forceinline__ void nsa_phase(const Args& a, unsigned char* lds, int blk, int G, int tid) {
    const bf16* proj = (const bf16*)(a.ws + WS_PROJ);
    const float* gates = (const float*)(a.ws + WS_GATES);
    bf16* mix = (bf16*)(a.ws + WS_HN);
    float* impH = (float*)lds;
    unsigned* selm = (unsigned*)(lds + SELM_OFF);
    const int tl = tid >> 4, r = (tid >> 2) & 3, qt = tid & 3;
    for (int u = blk; u < NB * 2 * 256; u += G) {
        const int b = u >> 9, g = (u >> 8) & 1, tb = u & 255, cur = tb >> 1;
        const int hq = 4 * g + r, t = 32 * tb + tl; const size_t m = (size_t)b * T + t;
        const float slope = exp2f(-(float)(hq + 1)) * LOG2E;
        float q[16], res[16], o[16];
        { const u32x4* p = (const u32x4*)(proj + m * PC + C_Q + 64 * hq + 16 * qt);
#pragma unroll
            for (int i = 0; i < 2; ++i) { const u32x4 uu = p[i]; q[8 * i] = bflo(uu.x); q[8 * i + 1] = bfhi(uu.x); q[8 * i + 2] = bflo(uu.y); q[8 * i + 3] = bfhi(uu.y); q[8 * i + 4] = bflo(uu.z); q[8 * i + 5] = bfhi(uu.z); q[8 * i + 6] = bflo(uu.w); q[8 * i + 7] = bfhi(uu.w); } }
#pragma unroll
        for (int i = 0; i < 16; ++i) res[i] = 0.f;
        const float g0 = gates[m * 24 + 3 * hq], g1 = gates[m * 24 + 3 * hq + 1], g2 = gates[m * 24 + 3 * hq + 2];
        float* myimp = impH + (tl * 4 + r) * 128;
        for (int s = 32 * qt; s < 32 * qt + 32; ++s) myimp[s] = 0.f;
        if (tid < 128) selm[tid] = 0u;
        __syncthreads();
        const int ncv = t >= 31 ? ((t - 31) >> 4) + 1 : 0;
        const bf16* kc = (const bf16*)(a.ws + WS_KCMP) + (size_t)(b * 2 + g) * NCB * 64 + 16 * qt;
        const bf16* vc = (const bf16*)(a.ws + WS_VCMP) + (size_t)(b * 2 + g) * NCB * 64 + 16 * qt;
        float mx = -1e30f, lsum = 0.f;
        for (int c = 0; c < ncv; ++c) {
            float s = dot16(q, kc + c * 64); s += __shfl_xor(s, 1); s += __shfl_xor(s, 2); s -= slope * (float)(t - 16 * c - 31);
            const float mn = fmaxf(mx, s); lsum = lsum * exp2f(mx - mn) + exp2f(s - mn); mx = mn;
        }
        const float il = 1.f / lsum;
        for (int c = 0; c < ncv; ++c) {
            float s = dot16(q, kc + c * 64); s += __shfl_xor(s, 1); s += __shfl_xor(s, 2); s -= slope * (float)(t - 16 * c - 31);
            const float p = exp2f(s - mx) * il;
            axpy16(res, g0 * p, vc + c * 64);
            if (qt == 0) { const int sb = c >> 2; if ((c & 3) == 3) { myimp[sb] += 0.5f * p; if (sb + 1 < 128) myimp[sb + 1] += 0.5f * p; } else myimp[sb] += p; }
        }
        __syncthreads();
        for (int idx = tid; idx < 32 * 128; idx += NTHR) {
            const int tl2 = idx >> 7, s = idx & 127; float* p = impH + tl2 * 512 + s;
            const float v = (p[0] + p[128]) + (p[256] + p[384]);
            const bool forced = (s == 0) || (s == cur) || (s == cur - 1), valid = s <= cur;
            p[0] = forced ? 1e9f : (valid ? v : -1e9f);
        }
        __syncthreads();
        { const int k16 = tid & 15; const float* val = impH + tl * 512; unsigned bits = 0u;
#pragma unroll 1
            for (int ii = 0; ii < 8; ++ii) { const int i = 8 * k16 + ii; const float vi = val[i]; int rank = 0;
#pragma unroll 4
                for (int j = 0; j < 128; ++j) { const float vj = val[j]; rank += ((vj > vi) || (vj == vi && j < i)) ? 1 : 0; }
                if (rank < 16 && i <= cur) bits |= 1u << ii; }
            atomicOr(&selm[tl * 4 + (k16 >> 2)], bits << (8 * (k16 & 3))); }
        __syncthreads();
        {
            const bf16* kb = proj + (size_t)b * T * PC + C_KS + 64 * g + 16 * qt; const bf16* vb = proj + (size_t)b * T * PC + C_VS + 64 * g + 16 * qt;
            mx = -1e30f; lsum = 0.f;
#pragma unroll
            for (int i = 0; i < 16; ++i) o[i] = 0.f;
            for (int w = 0; w < 4; ++w) { unsigned word = selm[tl * 4 + w];
                while (word) { const int bit = __ffs(word) - 1; word &= word - 1u; const int sblk = 32 * w + bit;
                    const int pend = min(64 * sblk + 63, t);
                    for (int pos = 64 * sblk; pos <= pend; ++pos) {
                        float s = dot16(q, kb + (size_t)pos * PC); s += __shfl_xor(s, 1); s += __shfl_xor(s, 2); s -= slope * (float)(t - pos);
                        const float mn = fmaxf(mx, s), cr = exp2f(mx - mn), p = exp2f(s - mn); lsum = lsum * cr + p; mx = mn;
#pragma unroll
                        for (int i = 0; i < 16; ++i) o[i] *= cr;
                        axpy16(o, p, vb + (size_t)pos * PC);
                    } } }
            const float sc = g1 / lsum;
#pragma unroll
            for (int i = 0; i < 16; ++i) res[i] += sc * o[i];
        }
        {
            const bf16* kb = proj + (size_t)b * T * PC + C_KW + 64 * g + 16 * qt; const bf16* vb = proj + (size_t)b * T * PC + C_VW + 64 * g + 16 * qt;
            mx = -1e30f; lsum = 0.f;
#pragma unroll
            for (int i = 0; i < 16; ++i) o[i] = 0.f;
            for (int pos = max(0, t - 511); pos <= t; ++pos) {
                float s = dot16(q, kb + (size_t)pos * PC); s += __shfl_xor(s, 1); s += __shfl_xor(s, 2); s -= slope * (float)(t - pos);
                const float mn = fmaxf(mx, s), cr = exp2f(mx - mn), p = exp2f(s - mn); lsum = lsum * cr + p; mx = mn;
#pragma unroll
                for (int i = 0; i < 16; ++i) o[i] *= cr;
                axpy16(o, p, vb + (size_t)pos * PC);
            }
            const float sc = g2 / lsum;
#pragma unroll
            for (int i = 0; i < 16; ++i) res[i] += sc * o[i];
        }
        { u32x4* op = (u32x4*)(mix + m * D + 64 * hq + 16 * qt);
#pragma unroll
            for (int i = 0; i < 2; ++i) { u32x4 w; w.x = pk2(res[8 * i], res[8 * i + 1]); w.y = pk2(res[8 * i + 2], res[8 * i + 3]); w.z = pk2(res[8 * i + 4], res[8 * i + 5]); w.w = pk2(res[8 * i + 6], res[8 * i + 7]); op[i] = w; } }
        __syncthreads();
    }
}
#define MFMA32(a, b, c) __builtin_amdgcn_mfma_f32_32x32x16_bf16(a, b, c, 0, 0, 0)
constexpr float NSA_NEG = -1e30f;
__device__ __forceinline__ float ex2(float x) { return __builtin_amdgcn_exp2f(x); }
typedef __amdgpu_buffer_rsrc_t brsrc_t;
__device__ __forceinline__ brsrc_t nsa_rsrc(const bf16* base, int nbytes) { return __builtin_amdgcn_make_buffer_rsrc((void*)base, (short)0, nbytes, 0x00020000); }
__device__ __forceinline__ void nsa_ldk(bf16x8 (&kf)[4], brsrc_t rs, int tile, unsigned voff) {
#pragma unroll
    for (int ks = 0; ks < 4; ++ks) kf[ks] = __builtin_bit_cast(bf16x8, __builtin_amdgcn_raw_buffer_load_b128(rs, voff + 1024u * ks, tile * 4096, 0));
}
__device__ __forceinline__ void nsa_ldv(bf16x8 (&vf)[4], brsrc_t rs, int tile, unsigned voff) {
#pragma unroll
    for (int q = 0; q < 4; ++q) vf[q] = __builtin_bit_cast(bf16x8, __builtin_amdgcn_raw_buffer_load_b128(rs, voff + 1024u * q, tile * 4096, 0));
}
__device__ __forceinline__ void nsa_qk(const bf16x8 (&kf)[4], const bf16x8 (&qf)[4], const bf16x8& kaug, unsigned slpk, float c, f32x16& u) {
    f32x16 acc;
#pragma unroll
    for (int i = 0; i < 16; ++i) acc[i] = 0.f;
    const unsigned hp = pk2(c, c); const float hif = bflo(hp);
    u32x4 w; w.x = slpk; w.y = pk2(hif, c - hif); w.z = 0u; w.w = 0u;
    acc = MFMA32(kaug, __builtin_bit_cast(bf16x8, w), acc);
#pragma unroll
    for (int ks = 0; ks < 4; ++ks) acc = MFMA32(kf[ks], qf[ks], acc);
    u = acc;
}
__device__ __forceinline__ void nsa_qk2(const bf16x8 (&kA)[4], const bf16x8 (&kB)[4], const bf16x8 (&qf)[4], const bf16x8& kaug, unsigned slpk, float cA, float cB, f32x16& uA, f32x16& uB) {
    f32x16 a0, a1;
#pragma unroll
    for (int i = 0; i < 16; ++i) { a0[i] = 0.f; a1[i] = 0.f; }
    u32x4 wA, wB;
    { const unsigned hp = pk2(cA, cA); const float hif = bflo(hp); wA.x = slpk; wA.y = pk2(hif, cA - hif); wA.z = 0u; wA.w = 0u; }
    { const unsigned hp = pk2(cB, cB); const float hif = bflo(hp); wB.x = slpk; wB.y = pk2(hif, cB - hif); wB.z = 0u; wB.w = 0u; }
    a0 = MFMA32(kaug, __builtin_bit_cast(bf16x8, wA), a0); a1 = MFMA32(kaug, __builtin_bit_cast(bf16x8, wB), a1);
#pragma unroll
    for (int ks = 0; ks < 4; ++ks) { a0 = MFMA32(kA[ks], qf[ks], a0); a1 = MFMA32(kB[ks], qf[ks], a1); }
    uA = a0; uB = a1;
}
__device__ __forceinline__ void nsa_mask(f32x16& u, int kminp, int kmaxp) {
#pragma unroll
    for (int i = 0; i < 16; ++i) { const int c = 16 * (i >> 3) + (i & 7); u[i] = (c >= kminp && c <= kmaxp) ? u[i] : NSA_NEG; }
}
__device__ __forceinline__ bf16x8 nsa_pack8(const f32x16& p, int j) {
    u32x4 w; w.x = pk2(p[8 * j], p[8 * j + 1]); w.y = pk2(p[8 * j + 2], p[8 * j + 3]); w.z = pk2(p[8 * j + 4], p[8 * j + 5]); w.w = pk2(p[8 * j + 6], p[8 * j + 7]);
    return __builtin_bit_cast(bf16x8, w);
}
__device__ __forceinline__ void nsa_pv(const bf16x8 (&vf)[4], const f32x16& p, f32x16 (&O)[2]) {
#pragma unroll
    for (int j = 0; j < 2; ++j) { const bf16x8 pb = nsa_pack8(p, j);
#pragma unroll
        for (int dt = 0; dt < 2; ++dt) O[dt] = MFMA32(vf[2 * j + dt], pb, O[dt]); }
}
__device__ __forceinline__ void nsa_expv(const f32x16& u, f32x16& p, float& lpart, f32x16 (&O)[2], const bf16x8 (&vf)[4]) {
    float lt = 0.f;
#pragma unroll
    for (int i = 0; i < 8; ++i) { p[i] = ex2(u[i]); lt += p[i]; }
    { const bf16x8 pb = nsa_pack8(p, 0); O[0] = MFMA32(vf[0], pb, O[0]); O[1] = MFMA32(vf[1], pb, O[1]); }
    __builtin_amdgcn_sched_barrier(0);
#pragma unroll
    for (int i = 8; i < 16; ++i) { p[i] = ex2(u[i]); lt += p[i]; }
    { const bf16x8 pb = nsa_pack8(p, 1); O[0] = MFMA32(vf[2], pb, O[0]); O[1] = MFMA32(vf[3], pb, O[1]); }
    lpart += lt;
}
struct SlcIt { unsigned w[4]; int sblk, half; };
__device__ __forceinline__ int slc_next(SlcIt& it, int tmax) {
    if (it.half == 1) { it.half = 0; return 64 * it.sblk; }
    int wi = it.w[3] ? 3 : it.w[2] ? 2 : it.w[1] ? 1 : it.w[0] ? 0 : -1;
    if (wi < 0) return -1;
    const unsigned word = wi == 3 ? it.w[3] : wi == 2 ? it.w[2] : wi == 1 ? it.w[1] : it.w[0];
    const int bit = 31 - __builtin_clz(word); const unsigned nw = word & ~(1u << bit);
    if (wi == 3) it.w[3] = nw; else if (wi == 2) it.w[2] = nw; else if (wi == 1) it.w[1] = nw; else it.w[0] = nw;
    it.sblk = 32 * wi + bit;
    if (64 * it.sblk + 32 <= tmax) { it.half = 1; return 64 * it.sblk + 32; }
    it.half = 0; return 64 * it.sblk;
}
__device__ __forceinline__ float dpp_xor1(float x) { return __builtin_bit_cast(float, __builtin_amdgcn_update_dpp(0, __builtin_bit_cast(int, x), 0xB1, 0xf, 0xf, true)); }
__device__ __forceinline__ float dpp_xor2(float x) { return __builtin_bit_cast(float, __builtin_amdgcn_update_dpp(0, __builtin_bit_cast(int, x), 0x4E, 0xf, 0xf, true)); }
__device__ __forceinline__ void nsa_res(float* resL, unsigned voff, const f32x16 (&O)[2], float sc, bool first) {
#pragma unroll
    for (int q = 0; q < 8; ++q) { f32x4* p = (f32x4*)((char*)resL + q * 1024 + voff);
        const f32x4 o = (f32x4){O[q >> 2][4 * (q & 3)], O[q >> 2][4 * (q & 3) + 1], O[q >> 2][4 * (q & 3) + 2], O[q >> 2][4 * (q & 3) + 3]} * sc;
        *p = first ? o : (*p + o);
        if (q & 1) asm volatile("" ::: "memory"); }
}
__device__ __forceinline__ bf16x8 nsa_kaug(unsigned kapk, int h) { u32x4 w; w.x = kapk; w.y = h ? 0u : 0x3f803f80u; w.z = 0u; w.w = 0u; return __builtin_bit_cast(bf16x8, w); }
__device__ __forceinline__ void nsa_fast_phase(const Args& a, unsigned char* lds, int l, int blk, int G, int wave) {
    const bf16* proj = (const bf16*)(a.ws + WS_PROJ);
    const float* gates = (const float*)(a.ws + WS_GATES);
    bf16* mix = (bf16*)(a.ws + WS_HN);
    const int lane = lane_id(), n = lane & 31, h = lane >> 5, tq = n >> 2, r = n & 3;
    const int krow = (n & 0x13) | ((n & 4) << 1) | ((n & 8) >> 1);
    const unsigned voff = (unsigned)lane * 16u;
    float* imp = (float*)lds + wave * (8 * 128);
    float* resL = (float*)(lds + 32768) + wave * 2048;
    unsigned* selw = (unsigned*)(lds + SELM_OFF) + wave * 32;
    const unsigned kapk = h ? 0u : pk2((float)krow, (float)krow);
#define kaug nsa_kaug(kapk, h)
    float gmax; { const float* kg = a.in[4] + l * 192; gmax = fmaxf(fmaxf(fabsf(kg[lane]), fabsf(kg[64 + lane])), fabsf(kg[128 + lane]));
#pragma unroll
        for (int o = 1; o < 64; o <<= 1) gmax = fmaxf(gmax, __shfl_xor(gmax, o));
        gmax = __builtin_bit_cast(float, __builtin_amdgcn_readfirstlane(__builtin_bit_cast(int, gmax))); }
    for (int u = blk; u < NB * 2 * 128; u += G) {
        const int b = u >> 8, g = (u >> 7) & 1, tb = ((u & 127) + 32 * (u >> 8)) & 127;
        const int hq = 4 * g + r, t0 = 64 * tb + 8 * wave, t = t0 + tq;
#define m ((size_t)b * T + t)
        const float sl2 = ex2(-(float)(hq + 1)) * LOG2E;
        bf16x8 qf[4];
#pragma unroll
        for (int ks = 0; ks < 4; ++ks) qf[ks] = *(const bf16x8*)(proj + m * PC + C_Q + 64 * hq + 16 * ks + 8 * h);
        float Ccol; { float qq = 0.f;
#pragma unroll
            for (int ks = 0; ks < 4; ++ks) { const u32x4 w = __builtin_bit_cast(u32x4, qf[ks]);
                qq += bflo(w.x) * bflo(w.x) + bfhi(w.x) * bfhi(w.x) + bflo(w.y) * bflo(w.y) + bfhi(w.y) * bfhi(w.y) + bflo(w.z) * bflo(w.z) + bfhi(w.z) * bfhi(w.z) + bflo(w.w) * bflo(w.w) + bfhi(w.w) * bfhi(w.w); }
            qq += __shfl_xor(qq, 32); Ccol = sqrtf(qq) * 8.f * gmax; }
        unsigned slpk1, slpk16; { const unsigned hp = pk2(sl2, sl2); const float hif = bflo(hp); slpk1 = pk2(hif, sl2 - hif); const float s16 = 16.f * sl2; const unsigned hq2 = pk2(s16, s16); const float h2 = bflo(hq2); slpk16 = pk2(h2, s16 - h2); }
        f32x16 O[2];
#pragma unroll
        for (int i = 0; i < 16; ++i) imp[lane + 64 * i] = 0.f;
        if (lane < 32) selw[lane] = 0u;
        bf16x8 kA[4], kB[4], vA[4], vB[4];
        {
            const brsrc_t KC = nsa_rsrc((const bf16*)(a.ws + WS_KCF) + (size_t)(b * 2 + g) * NCB * 64, NCB * 64 * 2);
            const brsrc_t VCT = nsa_rsrc((const bf16*)(a.ws + WS_VCT) + (size_t)(b * 2 + g) * 64 * NCB, NCB * 64 * 2);
            const int ncv = t >= 31 ? ((t - 31) >> 4) + 1 : 0;
            const int tmax = t0 + 7, ncvmax = tmax >= 31 ? ((tmax - 31) >> 4) + 1 : 0, nct = (ncvmax + 31) >> 5;
            const float c0 = sl2 * (float)(31 - t) - Ccol, c1 = sl2 * 512.f;
            float lp = 0.f;
#define CMP_A(KF, TI) do { f32x16 uu; nsa_qk(KF, qf, kaug, slpk16, c0 + (float)(TI) * c1, uu); \
                if ((TI) == nct - 1) nsa_mask(uu, -1000, ncv - 1 - 32 * (TI) - 8 * h); \
                float lt = 0.f; _Pragma("unroll") for (int i = 0; i < 16; ++i) lt += ex2(uu[i]); lp += lt; } while (0)
            if (nct > 0) nsa_ldk(kA, KC, 0, voff);
            for (int ti = 0; ti < nct; ti += 2) {
                if (ti + 1 < nct) nsa_ldk(kB, KC, ti + 1, voff);
                CMP_A(kA, ti);
                if (ti + 1 >= nct) break;
                if (ti + 2 < nct) nsa_ldk(kA, KC, ti + 2, voff);
                CMP_A(kB, ti + 1);
            }
#undef CMP_A
            lp += __shfl_xor(lp, 32);
            const float cB = ncv > 0 ? c0 - __builtin_amdgcn_logf(lp) : -30000.f;
#pragma unroll
            for (int i = 0; i < 16; ++i) { O[0][i] = 0.f; O[1][i] = 0.f; }
            float dummy = 0.f;
#define CMP_B(KF, VF, TI) do { f32x16 uu; nsa_qk(KF, qf, kaug, slpk16, cB + (float)(TI) * c1, uu); \
                if ((TI) == nct - 1) nsa_mask(uu, -1000, ncv - 1 - 32 * (TI) - 8 * h); \
                f32x16 p; nsa_expv(uu, p, dummy, O, VF); \
                float av[4], bv[4]; \
                _Pragma("unroll") for (int q4 = 0; q4 < 4; ++q4) { const int i0 = 4 * q4; av[q4] = (p[i0] + p[i0 + 1]) + (p[i0 + 2] + 0.5f * p[i0 + 3]); bv[q4] = 0.5f * p[i0 + 3]; } \
                _Pragma("unroll") for (int q4 = 0; q4 < 4; ++q4) { av[q4] += dpp_xor1(av[q4]); av[q4] += dpp_xor2(av[q4]); bv[q4] += dpp_xor1(bv[q4]); bv[q4] += dpp_xor2(bv[q4]); } \
                const float am = r == 0 ? av[0] : r == 1 ? av[1] : r == 2 ? av[2] : av[3], bm = r == 0 ? bv[0] : r == 1 ? bv[1] : r == 2 ? bv[2] : bv[3]; \
                const int sb = 8 * (TI) + 4 * (r >> 1) + 2 * h + (r & 1); \
                atomicAdd(&imp[tq * 128 + sb], am); \
                if (sb + 1 < 128) atomicAdd(&imp[tq * 128 + sb + 1], bm); } while (0)
            if (nct > 0) { nsa_ldk(kA, KC, 0, voff); nsa_ldv(vA, VCT, 0, voff); }
            for (int ti = 0; ti < nct; ti += 2) {
                if (ti + 1 < nct) { nsa_ldk(kB, KC, ti + 1, voff); nsa_ldv(vB, VCT, ti + 1, voff); }
                CMP_B(kA, vA, ti);
                if (ti + 1 >= nct) break;
                if (ti + 2 < nct) { nsa_ldk(kA, KC, ti + 2, voff); nsa_ldv(vA, VCT, ti + 2, voff); }
                CMP_B(kB, vB, ti + 1);
            }
#undef CMP_B
            nsa_res(resL, voff, O, gates[m * 24 + 3 * hq], true);
        }
        {
            const int l2 = lane_id(), tk = l2 >> 3, k8 = l2 & 7, cur = tb;
            float v[16];
#pragma unroll
            for (int k4 = 0; k4 < 4; ++k4) { const f32x4 x = *(const f32x4*)(imp + tk * 128 + 16 * k8 + 4 * k4); v[4 * k4] = x.x; v[4 * k4 + 1] = x.y; v[4 * k4 + 2] = x.z; v[4 * k4 + 3] = x.w; }
#pragma unroll
            for (int k = 0; k < 16; ++k) { const int s2 = 16 * k8 + k; const bool forced = (s2 == 0) || (s2 == cur) || (s2 == cur - 1), valid = s2 <= cur; v[k] = forced ? 1e9f : (valid ? v[k] : -1e9f); }
            unsigned bits = 0u;
#pragma unroll 1
            for (int it = 0; it < 16; ++it) {
                float bvv = v[0]; int bi = 0;
#pragma unroll
                for (int k = 1; k < 16; ++k) if (v[k] > bvv) { bvv = v[k]; bi = k; }
                bi += 16 * k8;
#define TK_STEP(CTRL) do { const float ov = __builtin_bit_cast(float, __builtin_amdgcn_update_dpp(0, __builtin_bit_cast(int, bvv), CTRL, 0xf, 0xf, true)); const int oi = __builtin_amdgcn_update_dpp(0, bi, CTRL, 0xf, 0xf, true); \
                    if (ov > bvv || (ov == bvv && oi < bi)) { bvv = ov; bi = oi; } } while (0)
                TK_STEP(0xB1); TK_STEP(0x4E); TK_STEP(0x141);
#undef TK_STEP
#pragma unroll
                for (int k = 0; k < 16; ++k) if (bi == 16 * k8 + k) { v[k] = -3e38f; if (16 * k8 + k <= cur) bits |= 1u << k; }
            }
            atomicOr(&selw[tk * 4 + (k8 >> 1)], bits << (16 * (k8 & 1)));
        }
        {
            const brsrc_t KS = nsa_rsrc((const bf16*)(a.ws + WS_KS) + (size_t)(b * 2 + g) * T * 64, T * 64 * 2);
            const brsrc_t VST = nsa_rsrc((const bf16*)(a.ws + WS_VST) + (size_t)(b * 2 + g) * 64 * T, T * 64 * 2);
            float lp = 0.f;
#pragma unroll
            for (int i = 0; i < 16; ++i) { O[0][i] = 0.f; O[1][i] = 0.f; }
            SlcIt it; it.half = 0; it.sblk = 0;
#pragma unroll
            for (int w = 0; w < 4; ++w) { unsigned uw = selw[(lane & 7) * 4 + w]; uw |= __shfl_xor(uw, 1); uw |= __shfl_xor(uw, 2); uw |= __shfl_xor(uw, 4); it.w[w] = (unsigned)__builtin_amdgcn_readfirstlane((int)uw); }
            const float cS = -sl2 * (float)t - Ccol;
#define SLC_C(PP, SB) (((selw[tq * 4 + ((SB) >> 5)] >> ((SB) & 31)) & 1u) ? cS + sl2 * (float)(PP) : -30000.f)
#define SLC_M(UU, PP) do { if ((PP) + 31 > t0) nsa_mask(UU, -1000, t - (PP) - 8 * h); } while (0)
            int P0 = slc_next(it, t0 + 7), sb0 = it.sblk;
            int P1 = P0 >= 0 ? slc_next(it, t0 + 7) : -1, sb1 = it.sblk;
            if (P0 >= 0) { nsa_ldk(kA, KS, P0 >> 5, voff); nsa_ldv(vA, VST, P0 >> 5, voff); }
            if (P1 >= 0) { nsa_ldk(kB, KS, P1 >> 5, voff); nsa_ldv(vB, VST, P1 >> 5, voff); }
            while (P0 >= 0) {
                const int P2 = P1 >= 0 ? slc_next(it, t0 + 7) : -1, sb2 = it.sblk;
                const int P3 = P2 >= 0 ? slc_next(it, t0 + 7) : -1, sb3 = it.sblk;
                f32x16 uA, uB, p;
                if (P1 >= 0) {
                    nsa_qk2(kA, kB, qf, kaug, slpk1, SLC_C(P0, sb0), SLC_C(P1, sb1), uA, uB);
                    if (P2 >= 0) nsa_ldk(kA, KS, P2 >> 5, voff);
                    if (P3 >= 0) nsa_ldk(kB, KS, P3 >> 5, voff);
                    SLC_M(uA, P0); SLC_M(uB, P1);
                    nsa_expv(uA, p, lp, O, vA);
                    if (P2 >= 0) nsa_ldv(vA, VST, P2 >> 5, voff);
                    nsa_expv(uB, p, lp, O, vB);
                    if (P3 >= 0) nsa_ldv(vB, VST, P3 >> 5, voff);
                } else {
                    nsa_qk(kA, qf, kaug, slpk1, SLC_C(P0, sb0), uA);
                    SLC_M(uA, P0);
                    nsa_expv(uA, p, lp, O, vA);
                }
                P0 = P2; sb0 = sb2; P1 = P3; sb1 = sb3;
            }
#undef SLC_C
#undef SLC_M
#define SLC_T(KF, VF, PP, SB)
#undef SLC_T
            lp += __shfl_xor(lp, 32);
            nsa_res(resL, voff, O, gates[m * 24 + 3 * hq + 1] * __builtin_amdgcn_rcpf(lp), false);
        }
        {
            const brsrc_t KW = nsa_rsrc((const bf16*)(a.ws + WS_KW) + (size_t)(b * 2 + g) * T * 64, T * 64 * 2);
            const brsrc_t VWT = nsa_rsrc((const bf16*)(a.ws + WS_VWT) + (size_t)(b * 2 + g) * 64 * T, T * 64 * 2);
            float lp = 0.f;
#pragma unroll
            for (int i = 0; i < 16; ++i) { O[0][i] = 0.f; O[1][i] = 0.f; }
            const int thi = (t0 + 7) >> 5, tlo = (t0 - 511) > 0 ? ((t0 - 511) >> 5) : 0;
            const float cS = -sl2 * (float)t - Ccol;
#define WIN_M(UU, PP) do { if ((PP) + 31 > t0 || (PP) < t0 + 7 - 511) nsa_mask(UU, t - 511 - (PP) - 8 * h, t - (PP) - 8 * h); } while (0)
            nsa_ldk(kA, KW, thi, voff); nsa_ldv(vA, VWT, thi, voff);
            if (thi - 1 >= tlo) { nsa_ldk(kB, KW, thi - 1, voff); nsa_ldv(vB, VWT, thi - 1, voff); }
#pragma unroll 1
            for (int ti = thi; ti >= tlo; ti -= 2) {
                f32x16 uA, uB, p;
                if (ti - 1 >= tlo) {
                    nsa_qk2(kA, kB, qf, kaug, slpk1, cS + sl2 * (float)(32 * ti), cS + sl2 * (float)(32 * ti - 32), uA, uB);
                    if (ti - 2 >= tlo) nsa_ldk(kA, KW, ti - 2, voff);
                    if (ti - 3 >= tlo) nsa_ldk(kB, KW, ti - 3, voff);
                    WIN_M(uA, 32 * ti); WIN_M(uB, 32 * ti - 32);
                    nsa_expv(uA, p, lp, O, vA);
                    if (ti - 2 >= tlo) nsa_ldv(vA, VWT, ti - 2, voff);
                    nsa_expv(uB, p, lp, O, vB);
                    if (ti - 3 >= tlo) nsa_ldv(vB, VWT, ti - 3, voff);
                } else {
                    nsa_qk(kA, qf, kaug, slpk1, cS + sl2 * (float)(32 * ti), uA);
                    WIN_M(uA, 32 * ti);
                    nsa_expv(uA, p, lp, O, vA);
                }
            }
#undef WIN_M
#define WIN_T(KF, VF, TI)
#undef WIN_T
            lp += __shfl_xor(lp, 32);
            nsa_res(resL, voff, O, gates[m * 24 + 3 * hq + 2] * __builtin_amdgcn_rcpf(lp), false);
        }
        { const int l3 = lane_id(), n3 = l3 & 31, h3 = l3 >> 5; const size_t m3 = (size_t)b * T + t0 + (n3 >> 2); const int hq3 = 4 * g + (n3 & 3);
#pragma unroll
            for (int q = 0; q < 8; ++q) { const f32x4 o = *(const f32x4*)(resL + (q * 64 + l3) * 4); u32x2 w; w.x = pk2(o.x, o.y); w.y = pk2(o.z, o.w);
                *(u32x2*)(mix + m3 * D + 64 * hq3 + 32 * (q >> 2) + 8 * (q & 3) + 4 * h3) = w; } }
    }
}
#undef kaug
#undef m

constexpr int NSA_RING_OFF = 98304, NSA_SLOT = 8192;
#define NSA_VMW(n) asm volatile("s_waitcnt vmcnt(" #n ")" ::: "memory")
__device__ __forceinline__ void nsa_dma(LAS unsigned char* ring, int slot, const bf16* Kb, const bf16* Vb, int tile, int wave, unsigned voff) {
    const char* src = (const char*)(wave < 4 ? Kb : Vb) + (size_t)tile * 4096 + (wave & 3) * 1024 + voff;
    __builtin_amdgcn_global_load_lds((const unsigned*)src, (LAS unsigned*)(ring + slot * NSA_SLOT + wave * 1024), 16, 0, 0);
}
__device__ __forceinline__ void nsa_frag(LAS unsigned char* ring, int slot, unsigned voff, bf16x8 (&kf)[4], bf16x8 (&vf)[4]) {
#pragma unroll
    for (int q = 0; q < 4; ++q) { kf[q] = *(const LAS bf16x8*)(ring + slot * NSA_SLOT + q * 1024 + voff); vf[q] = *(const LAS bf16x8*)(ring + slot * NSA_SLOT + 4096 + q * 1024 + voff); }
}
__device__ __forceinline__ void nsa_ls_phase(const Args& a, unsigned char* lds, int l, int blk, int G, int wave) {
    const bf16* proj = (const bf16*)(a.ws + WS_PROJ);
    const float* gates = (const float*)(a.ws + WS_GATES);
    bf16* mix = (bf16*)(a.ws + WS_HN);
    const int lane = lane_id(), n = lane & 31, h = lane >> 5, tq = n >> 2, r = n & 3;
    const int krow = (n & 0x13) | ((n & 4) << 1) | ((n & 8) >> 1);
    const unsigned voff = (unsigned)lane * 16u;
    float* imp = (float*)lds + wave * (8 * 128);
    float* resL = (float*)(lds + 32768) + wave * 2048;
    unsigned* selw = (unsigned*)(lds + SELM_OFF) + wave * 32;
    volatile unsigned* ubw = (volatile unsigned*)(lds + SELM_OFF + 1024);
    LAS unsigned char* ring = (LAS unsigned char*)lds + NSA_RING_OFF;
    const unsigned kapk = h ? 0u : pk2((float)krow, (float)krow);
#define kaug nsa_kaug(kapk, h)
    float gmax; { const float* kg = a.in[4] + l * 192; gmax = fmaxf(fmaxf(fabsf(kg[lane]), fabsf(kg[64 + lane])), fabsf(kg[128 + lane]));
#pragma unroll
        for (int o = 1; o < 64; o <<= 1) gmax = fmaxf(gmax, __shfl_xor(gmax, o));
        gmax = __builtin_bit_cast(float, __builtin_amdgcn_readfirstlane(__builtin_bit_cast(int, gmax))); }
    for (int u = blk; u < NB * 2 * 128; u += G) {
        const int b = u >> 8, g = (u >> 7) & 1, tb = ((u & 127) + 32 * (u >> 8)) & 127;
        const int hq = 4 * g + r, t0 = 64 * tb + 8 * wave, t = t0 + tq, tmaxB = 64 * tb + 63;
#define m ((size_t)b * T + t)
        const float sl2 = ex2(-(float)(hq + 1)) * LOG2E;
        bf16x8 qf[4];
#pragma unroll
        for (int ks = 0; ks < 4; ++ks) qf[ks] = *(const bf16x8*)(proj + m * PC + C_Q + 64 * hq + 16 * ks + 8 * h);
        float Ccol; { float qq = 0.f;
#pragma unroll
            for (int ks = 0; ks < 4; ++ks) { const u32x4 w = __builtin_bit_cast(u32x4, qf[ks]);
                qq += bflo(w.x) * bflo(w.x) + bfhi(w.x) * bfhi(w.x) + bflo(w.y) * bflo(w.y) + bfhi(w.y) * bfhi(w.y) + bflo(w.z) * bflo(w.z) + bfhi(w.z) * bfhi(w.z) + bflo(w.w) * bflo(w.w) + bfhi(w.w) * bfhi(w.w); }
            qq += __shfl_xor(qq, 32); Ccol = sqrtf(qq) * 8.f * gmax; }
        unsigned slpk1, slpk16; { const unsigned hp = pk2(sl2, sl2); const float hif = bflo(hp); slpk1 = pk2(hif, sl2 - hif); const float s16 = 16.f * sl2; const unsigned hq2 = pk2(s16, s16); const float h2 = bflo(hq2); slpk16 = pk2(h2, s16 - h2); }
        f32x16 O[2];
#pragma unroll
        for (int i = 0; i < 16; ++i) imp[lane + 64 * i] = 0.f;
        if (lane < 32) selw[lane] = 0u;
        if (wave == 0 && lane < 4) ubw[lane] = 0u;
        bf16x8 kc[4], vf[4];
#define NSA_WALK(KB, VB, NEXT, ...) do { \
            NSA_VMW(0); __builtin_amdgcn_s_barrier(); \
            int tA = NEXT, tB = tA >= 0 ? NEXT : -1, sl = 0; \
            if (tA >= 0) nsa_dma(ring, 0, KB, VB, tA, wave, voff); \
            if (tB >= 0) nsa_dma(ring, 1, KB, VB, tB, wave, voff); \
            while (tA >= 0) { \
                const int tC = tB >= 0 ? NEXT : -1; \
                if (tC >= 0) { nsa_dma(ring, (sl + 2) & 3, KB, VB, tC, wave, voff); NSA_VMW(2); } else if (tB >= 0) NSA_VMW(1); else NSA_VMW(0); \
                __builtin_amdgcn_s_barrier(); \
                { const int tile = tA; __VA_ARGS__ } \
                tA = tB; tB = tC; sl = (sl + 1) & 3; } } while (0)
        {
            const bf16* KC = (const bf16*)(a.ws + WS_KCF) + (size_t)(b * 2 + g) * NCB * 64;
            const bf16* VCT = (const bf16*)(a.ws + WS_VCT) + (size_t)(b * 2 + g) * 64 * NCB;
            const int ncv = t >= 31 ? ((t - 31) >> 4) + 1 : 0;
            const int tmax = t0 + 7, ncvmax = tmax >= 31 ? ((tmax - 31) >> 4) + 1 : 0, nct = (ncvmax + 31) >> 5;
            const int nctB = ((((tmaxB - 31) >> 4) + 1) + 31) >> 5;
            const float c0 = sl2 * (float)(31 - t) - Ccol, c1 = sl2 * 512.f;
            float lp = 0.f; int ci = 0;
            NSA_WALK(KC, VCT, (ci < nctB ? ci++ : -1), {
                if (tile < nct) { nsa_frag(ring, sl, voff, kc, vf);
                    f32x16 uu; nsa_qk(kc, qf, kaug, slpk16, c0 + (float)tile * c1, uu);
                    if (tile == nct - 1) nsa_mask(uu, -1000, ncv - 1 - 32 * tile - 8 * h);
                    float lt = 0.f; _Pragma("unroll") for (int i = 0; i < 16; ++i) lt += ex2(uu[i]); lp += lt; } });
            lp += __shfl_xor(lp, 32);
            const float cB = ncv > 0 ? c0 - __builtin_amdgcn_logf(lp) : -30000.f;
#pragma unroll
            for (int i = 0; i < 16; ++i) { O[0][i] = 0.f; O[1][i] = 0.f; }
            float dummy = 0.f; ci = 0;
            NSA_WALK(KC, VCT, (ci < nctB ? ci++ : -1), {
                if (tile < nct) { nsa_frag(ring, sl, voff, kc, vf);
                    f32x16 uu; nsa_qk(kc, qf, kaug, slpk16, cB + (float)tile * c1, uu);
                    if (tile == nct - 1) nsa_mask(uu, -1000, ncv - 1 - 32 * tile - 8 * h);
                    f32x16 p; nsa_expv(uu, p, dummy, O, vf);
                    float av[4], bv[4];
                    _Pragma("unroll") for (int q4 = 0; q4 < 4; ++q4) { const int i0 = 4 * q4; av[q4] = (p[i0] + p[i0 + 1]) + (p[i0 + 2] + 0.5f * p[i0 + 3]); bv[q4] = 0.5f * p[i0 + 3]; }
                    _Pragma("unroll") for (int q4 = 0; q4 < 4; ++q4) { av[q4] += dpp_xor1(av[q4]); av[q4] += dpp_xor2(av[q4]); bv[q4] += dpp_xor1(bv[q4]); bv[q4] += dpp_xor2(bv[q4]); }
                    const float am = r == 0 ? av[0] : r == 1 ? av[1] : r == 2 ? av[2] : av[3], bm = r == 0 ? bv[0] : r == 1 ? bv[1] : r == 2 ? bv[2] : bv[3];
                    const int sb = 8 * tile + 4 * (r >> 1) + 2 * h + (r & 1);
                    atomicAdd(&imp[tq * 128 + sb], am);
                    if (sb + 1 < 128) atomicAdd(&imp[tq * 128 + sb + 1], bm); } });
            nsa_res(resL, voff, O, gates[m * 24 + 3 * hq], true);
        }
        {
            const int l2 = lane_id(), tk = l2 >> 3, k8 = l2 & 7, cur = tb;
            float v[16];
#pragma unroll
            for (int k4 = 0; k4 < 4; ++k4) { const f32x4 x = *(const f32x4*)(imp + tk * 128 + 16 * k8 + 4 * k4); v[4 * k4] = x.x; v[4 * k4 + 1] = x.y; v[4 * k4 + 2] = x.z; v[4 * k4 + 3] = x.w; }
#pragma unroll
            for (int k = 0; k < 16; ++k) { const int s2 = 16 * k8 + k; const bool forced = (s2 == 0) || (s2 == cur) || (s2 == cur - 1), valid = s2 <= cur; v[k] = forced ? 1e9f : (valid ? v[k] : -1e9f); }
            unsigned bits = 0u;
#pragma unroll 1
            for (int it = 0; it < 16; ++it) {
                float bvv = v[0]; int bi = 0;
#pragma unroll
                for (int k = 1; k < 16; ++k) if (v[k] > bvv) { bvv = v[k]; bi = k; }
                bi += 16 * k8;
#define TK_STEP(CTRL) do { const float ov = __builtin_bit_cast(float, __builtin_amdgcn_update_dpp(0, __builtin_bit_cast(int, bvv), CTRL, 0xf, 0xf, true)); const int oi = __builtin_amdgcn_update_dpp(0, bi, CTRL, 0xf, 0xf, true); \
                    if (ov > bvv || (ov == bvv && oi < bi)) { bvv = ov; bi = oi; } } while (0)
                TK_STEP(0xB1); TK_STEP(0x4E); TK_STEP(0x141);
#undef TK_STEP
#pragma unroll
                for (int k = 0; k < 16; ++k) if (bi == 16 * k8 + k) { v[k] = -3e38f; if (16 * k8 + k <= cur) bits |= 1u << k; }
            }
            atomicOr(&selw[tk * 4 + (k8 >> 1)], bits << (16 * (k8 & 1)));
        }
        {
            const bf16* KS = (const bf16*)(a.ws + WS_KS) + (size_t)(b * 2 + g) * T * 64;
            const bf16* VST = (const bf16*)(a.ws + WS_VST) + (size_t)(b * 2 + g) * 64 * T;
            float lp = 0.f;
#pragma unroll
            for (int i = 0; i < 16; ++i) { O[0][i] = 0.f; O[1][i] = 0.f; }
            unsigned myu[4];
#pragma unroll
            for (int w = 0; w < 4; ++w) { unsigned uw = selw[(lane & 7) * 4 + w]; uw |= __shfl_xor(uw, 1); uw |= __shfl_xor(uw, 2); uw |= __shfl_xor(uw, 4); myu[w] = (unsigned)__builtin_amdgcn_readfirstlane((int)uw); }
            if (lane < 4) atomicOr((unsigned*)&ubw[lane], lane == 0 ? myu[0] : lane == 1 ? myu[1] : lane == 2 ? myu[2] : myu[3]);
            __builtin_amdgcn_s_waitcnt(0xc07f);
            __builtin_amdgcn_s_barrier();
            SlcIt it; it.half = 0; it.sblk = 0;
#pragma unroll
            for (int w = 0; w < 4; ++w) it.w[w] = (unsigned)__builtin_amdgcn_readfirstlane((int)ubw[w]);
            const float cS = -sl2 * (float)t - Ccol;
            NSA_WALK(KS, VST, (slc_next(it, tmaxB) >> 5), {
                const int PP = 32 * tile, sbk = tile >> 1;
                const unsigned wsel = (sbk >> 5) == 0 ? myu[0] : (sbk >> 5) == 1 ? myu[1] : (sbk >> 5) == 2 ? myu[2] : myu[3];
                if (((wsel >> (sbk & 31)) & 1u) && PP <= t0 + 7) { nsa_frag(ring, sl, voff, kc, vf);
                    const bool colsel = (selw[tq * 4 + (sbk >> 5)] >> (sbk & 31)) & 1u;
                    f32x16 uu; nsa_qk(kc, qf, kaug, slpk1, colsel ? cS + sl2 * (float)PP : -30000.f, uu);
                    if (PP + 31 > t0) nsa_mask(uu, -1000, t - PP - 8 * h);
                    f32x16 p; nsa_expv(uu, p, lp, O, vf); } });
            lp += __shfl_xor(lp, 32);
            nsa_res(resL, voff, O, gates[m * 24 + 3 * hq + 1] * __builtin_amdgcn_rcpf(lp), false);
        }
        {
            const bf16* KW = (const bf16*)(a.ws + WS_KW) + (size_t)(b * 2 + g) * T * 64;
            const bf16* VWT = (const bf16*)(a.ws + WS_VWT) + (size_t)(b * 2 + g) * 64 * T;
            float lp = 0.f;
#pragma unroll
            for (int i = 0; i < 16; ++i) { O[0][i] = 0.f; O[1][i] = 0.f; }
            const int thiB = tmaxB >> 5, tloB = (64 * tb - 511) > 0 ? ((64 * tb - 511) >> 5) : 0;
            const float cS = -sl2 * (float)t - Ccol;
            int wi = thiB;
            NSA_WALK(KW, VWT, (wi >= tloB ? wi-- : -1), {
                const int PP = 32 * tile;
                if (PP <= t0 + 7 && PP + 31 >= t0 - 511) { nsa_frag(ring, sl, voff, kc, vf);
                    f32x16 uu; nsa_qk(kc, qf, kaug, slpk1, cS + sl2 * (float)PP, uu);
                    if (PP + 31 > t0 || PP < t0 + 7 - 511) nsa_mask(uu, t - 511 - PP - 8 * h, t - PP - 8 * h);
                    f32x16 p; nsa_expv(uu, p, lp, O, vf); } });
            lp += __shfl_xor(lp, 32);
            nsa_res(resL, voff, O, gates[m * 24 + 3 * hq + 2] * __builtin_amdgcn_rcpf(lp), false);
        }
        { const int l3 = lane_id(), n3 = l3 & 31, h3 = l3 >> 5; const size_t m3 = (size_t)b * T + t0 + (n3 >> 2); const int hq3 = 4 * g + (n3 & 3);
#pragma unroll
            for (int q = 0; q < 8; ++q) { const f32x4 o = *(const f32x4*)(resL + (q * 64 + l3) * 4); u32x2 w; w.x = pk2(o.x, o.y); w.y = pk2(o.z, o.w);
                *(u32x2*)(mix + m3 * D + 64 * hq3 + 32 * (q >> 2) + 8 * (q & 3) + 4 * h3) = w; } }
    }
    NSA_VMW(0); __builtin_amdgcn_s_barrier();
}
#undef kaug
#undef m
#undef NSA_WALK

__device__ __forceinline__ void retout_phase(const Args& a, int l, int blk, int G, int tid) {
    const bf16* proj = (const bf16*)(a.ws + WS_PROJ);
    const float* rets = (const float*)(a.ws + WS_RETS);
    bf16* mix = (bf16*)(a.ws + WS_HN);
    const float* rng = a.in[7] + l * 512;
    const int i = tid >> 2, qd = tid & 3;
    for (int u = blk; u < NB * 8 * 64; u += G) {
        const int b = u >> 9, h = (u >> 6) & 7, c = u & 63;
        const float lg2 = log2f(1.f - exp2f(-5.f - (float)h));
        const bf16* base = proj + ((size_t)b * T + c * 128) * PC;
        float q[32], acc[16];
        { const u32x4* p = (const u32x4*)(base + (size_t)i * PC + C_RQ + 32 * h);
#pragma unroll
            for (int k = 0; k < 4; ++k) { const u32x4 uu = p[k]; q[8 * k] = bflo(uu.x); q[8 * k + 1] = bfhi(uu.x); q[8 * k + 2] = bflo(uu.y); q[8 * k + 3] = bfhi(uu.y); q[8 * k + 4] = bflo(uu.z); q[8 * k + 5] = bfhi(uu.z); q[8 * k + 6] = bflo(uu.w); q[8 * k + 7] = bfhi(uu.w); }
#pragma unroll
            for (int k = 0; k < 32; ++k) q[k] *= 0.17677669529663687f; }
#pragma unroll
        for (int k = 0; k < 16; ++k) acc[k] = 0.f;
        for (int j = 0; j <= i; ++j) {
            const float s = dot32(q, base + (size_t)j * PC + C_RK + 32 * h) * exp2f((float)(i - j) * lg2);
            const u32x4* vp = (const u32x4*)(base + (size_t)j * PC + C_RV + 64 * h + 16 * qd);
#pragma unroll
            for (int k = 0; k < 2; ++k) { const u32x4 uu = vp[k]; acc[8 * k] += s * bflo(uu.x); acc[8 * k + 1] += s * bfhi(uu.x); acc[8 * k + 2] += s * bflo(uu.y); acc[8 * k + 3] += s * bfhi(uu.y); acc[8 * k + 4] += s * bflo(uu.z); acc[8 * k + 5] += s * bfhi(uu.z); acc[8 * k + 6] += s * bflo(uu.w); acc[8 * k + 7] += s * bfhi(uu.w); }
        }
        { const float xi = exp2f((float)(i + 1) * lg2); const float* S = rets + ((size_t)(b * 8 + h) * 64 + c) * 2048 + 16 * qd;
#pragma unroll
            for (int d = 0; d < 32; ++d) { const float qx = q[d] * xi; const f32x4* sp = (const f32x4*)(S + d * 64);
#pragma unroll
                for (int k = 0; k < 4; ++k) { const f32x4 sv = sp[k]; acc[4 * k] += qx * sv.x; acc[4 * k + 1] += qx * sv.y; acc[4 * k + 2] += qx * sv.z; acc[4 * k + 3] += qx * sv.w; } } }
        float ss = 0.f;
#pragma unroll
        for (int k = 0; k < 16; ++k) ss += acc[k] * acc[k];
        ss += __shfl_xor(ss, 1); ss += __shfl_xor(ss, 2);
        const float rs = 1.f / sqrtf(ss * (1.f / 64.f) + EPS);
        const size_t m = (size_t)b * T + c * 128 + i;
        const u32x4* gp = (const u32x4*)(proj + m * PC + C_RG + 64 * h + 16 * qd);
        float y[16];
#pragma unroll
        for (int k = 0; k < 2; ++k) { const u32x4 uu = gp[k]; const float gg[8] = {bflo(uu.x), bfhi(uu.x), bflo(uu.y), bfhi(uu.y), bflo(uu.z), bfhi(uu.z), bflo(uu.w), bfhi(uu.w)};
#pragma unroll
            for (int z = 0; z < 8; ++z) { const float gz = gg[z]; y[8 * k + z] = acc[8 * k + z] * rs * rng[64 * h + 16 * qd + 8 * k + z] * (gz / (1.f + __expf(-gz))); } }
        u32x4* op = (u32x4*)(mix + m * D + 512 + 64 * h + 16 * qd);
#pragma unroll
        for (int k = 0; k < 2; ++k) { u32x4 w; w.x = pk2(y[8 * k], y[8 * k + 1]); w.y = pk2(y[8 * k + 2], y[8 * k + 3]); w.z = pk2(y[8 * k + 4], y[8 * k + 5]); w.w = pk2(y[8 * k + 6], y[8 * k + 7]); op[k] = w; }
    }
}

__device__ __forceinline__ void retout_fast_phase(const Args& a, unsigned char* lds, int l, int blk, int G, int wave) {
    const bf16* proj = (const bf16*)(a.ws + WS_PROJ);
    bf16* mix = (bf16*)(a.ws + WS_HN);
    const float* rng = a.in[7] + l * 512;
    const int lane = lane_id(), n = lane & 31, h = lane >> 5, tid = wave * 64 + lane, qt = wave & 3, dt = wave >> 2;
    const int krow = (n & 0x13) | ((n & 4) << 1) | ((n & 8) >> 1);
    bf16* Qs = (bf16*)lds;
    bf16* Ks = Qs + 128 * 32;
    bf16* VTs = Ks + 128 * 32;
    float* ssq = (float*)(lds + 8192 + 8192 + 64 * 136 * 2);
    for (int u = blk; u < NB * 8 * 64; u += G) {
        const int b = u >> 9, hh = (u >> 6) & 7, c = u & 63;
        const float lg2 = log2f(1.f - exp2f(-5.f - (float)hh));
        const size_t m0 = (size_t)b * T + c * 128;
        { const int row = tid >> 2, pc = tid & 3; const bf16* src = proj + (m0 + row) * PC + 32 * hh + 8 * pc;
            const u32x4 uq = *(const u32x4*)(src + C_RQ), uk = *(const u32x4*)(src + C_RK);
            const float sq = 0.17677669529663687f * exp2f((float)(row + 1) * lg2), sk = exp2f(-(float)(row + 1) * lg2);
            u32x4 o; o.x = pk2(bflo(uq.x) * sq, bfhi(uq.x) * sq); o.y = pk2(bflo(uq.y) * sq, bfhi(uq.y) * sq); o.z = pk2(bflo(uq.z) * sq, bfhi(uq.z) * sq); o.w = pk2(bflo(uq.w) * sq, bfhi(uq.w) * sq);
            *(u32x4*)(Qs + row * 32 + 8 * pc) = o;
            o.x = pk2(bflo(uk.x) * sk, bfhi(uk.x) * sk); o.y = pk2(bflo(uk.y) * sk, bfhi(uk.y) * sk); o.z = pk2(bflo(uk.z) * sk, bfhi(uk.z) * sk); o.w = pk2(bflo(uk.w) * sk, bfhi(uk.w) * sk);
            *(u32x4*)(Ks + row * 32 + 8 * pc) = o; }
#pragma unroll
        for (int it = 0; it < 2; ++it) { const int idx = tid + NTHR * it, row = idx >> 3, pc = idx & 7; const u32x4 uv = *(const u32x4*)(proj + (m0 + row) * PC + C_RV + 64 * hh + 8 * pc);
            bf16* d0 = VTs + (8 * pc) * 136 + row;
            d0[0] = (bf16)(uv.x & 0xffffu); d0[136] = (bf16)(uv.x >> 16); d0[2 * 136] = (bf16)(uv.y & 0xffffu); d0[3 * 136] = (bf16)(uv.y >> 16);
            d0[4 * 136] = (bf16)(uv.z & 0xffffu); d0[5 * 136] = (bf16)(uv.z >> 16); d0[6 * 136] = (bf16)(uv.w & 0xffffu); d0[7 * 136] = (bf16)(uv.w >> 16); }
        __syncthreads();
        bf16x8 qf[2];
#pragma unroll
        for (int ks = 0; ks < 2; ++ks) qf[ks] = *(const bf16x8*)(Qs + (32 * qt + n) * 32 + 16 * ks + 8 * h);
        f32x16 O;
#pragma unroll
        for (int i = 0; i < 16; ++i) O[i] = 0.f;
        for (int kt = 0; kt <= qt; ++kt) {
            f32x16 acc;
#pragma unroll
            for (int i = 0; i < 16; ++i) acc[i] = 0.f;
#pragma unroll
            for (int ks = 0; ks < 2; ++ks) { const bf16x8 af = *(const bf16x8*)(Ks + (32 * kt + krow) * 32 + 16 * ks + 8 * h); acc = MFMA32(af, qf[ks], acc); }
            if (kt == qt) {
#pragma unroll
                for (int i = 0; i < 16; ++i) { const int cc = 16 * (i >> 3) + (i & 7) + 8 * h; acc[i] = (cc <= n) ? acc[i] : 0.f; }
            }
#pragma unroll
            for (int j = 0; j < 2; ++j) { const bf16x8 pb = nsa_pack8(acc, j); const bf16x8 vf = *(const bf16x8*)(VTs + (32 * dt + n) * 136 + 32 * kt + 16 * j + 8 * h); O = MFMA32(vf, pb, O); }
        }
        { const bf16* ST = (const bf16*)(a.ws + WS_RST) + (((size_t)(b * 8 + hh) * 64 + c) * 64 + 32 * dt + n) * 32;
#pragma unroll
            for (int ks = 0; ks < 2; ++ks) { const bf16x8 sf = *(const bf16x8*)(ST + 16 * ks + 8 * h); O = MFMA32(sf, qf[ks], O); } }
        float ss = 0.f;
#pragma unroll
        for (int i = 0; i < 16; ++i) ss += O[i] * O[i];
        ss += __shfl_xor(ss, 32);
        if (h == 0) ssq[(dt * 4 + qt) * 32 + n] = ss;
        __syncthreads();
        const float rs = 1.f / sqrtf((ssq[qt * 32 + n] + ssq[(4 + qt) * 32 + n]) * (1.f / 64.f) + EPS);
        const size_t m = m0 + 32 * qt + n;
#pragma unroll
        for (int q4 = 0; q4 < 4; ++q4) { const int e0 = 32 * dt + 8 * q4 + 4 * h;
            const u32x2 ug = *(const u32x2*)(proj + m * PC + C_RG + 64 * hh + e0); const f32x4 gn = *(const f32x4*)(rng + 64 * hh + e0);
            const float z0 = bflo(ug.x), z1 = bfhi(ug.x), z2 = bflo(ug.y), z3 = bfhi(ug.y);
            const float y0 = O[4 * q4] * rs * gn.x * fsilu(z0), y1 = O[4 * q4 + 1] * rs * gn.y * fsilu(z1);
            const float y2 = O[4 * q4 + 2] * rs * gn.z * fsilu(z2), y3 = O[4 * q4 + 3] * rs * gn.w * fsilu(z3);
            u32x2 w; w.x = pk2(y0, y1); w.y = pk2(y2, y3);
            *(u32x2*)(mix + m * D + 512 + 64 * hh + e0) = w; }
        __syncthreads();
    }
}

struct Unit { int pm, pn, e, j, nvalid; };
struct DenseSched {
    const bf16* A; const bf16* Bt; int K, nM, nN, G, c;
    __device__ __forceinline__ bool next(int i, Unit& u) const {
        const int nwg = nM * nN; const int L = i * G + c; if (L >= nwg) return false;
        int wgid = L;
        if ((G & 7) == 0) { const int q = nwg >> 3, r = nwg & 7, xcd = L & 7, off = L >> 3; wgid = (xcd < r ? xcd * (q + 1) : r * (q + 1) + (xcd - r) * q) + off; }
        const int nig = 8 * nN, gid = wgid / nig, fm = gid * 8, gsz = (nM - fm) < 8 ? (nM - fm) : 8;
        u.pm = fm + ((wgid % nig) % gsz); u.pn = (wgid % nig) / gsz; u.e = 0; u.j = u.pm; u.nvalid = 256; return true;
    }
    __device__ __forceinline__ size_t arow(const Unit& u, int r) const { return (size_t)u.pm * 256 + r; }
    __device__ __forceinline__ const bf16* bt(const Unit& u) const { return Bt + (size_t)u.pn * 256 * K; }
    static constexpr bool LOADS = false;
    __device__ __forceinline__ bool loads() const { return false; }
    __device__ __forceinline__ const char* a_base(const Unit& u) const { return (const char*)(A + (size_t)u.pm * 256 * K); }
    __device__ __forceinline__ void a_offs(const Unit& u, const int (&R)[2], const int (&C)[2], unsigned (&v0)[2], unsigned (&v1)[2]) const {
#pragma unroll
        for (int i = 0; i < 2; ++i) { v0[i] = (unsigned)(R[i] * K + C[i]) * 2u; v1[i] = (unsigned)((R[i] + 128) * K + C[i]) * 2u; }
    }
};
template <bool GATHER>
struct RoutedSched {
    const bf16* A; const bf16* Bt; size_t bstride; int K, nN, G, c, ne;
    const int* tok;
    const int* tstart;
    const int* cnt;
    __device__ __forceinline__ bool next(int i, Unit& u) const {
        const int nM = tstart[ne], nwg = nM * nN; const int L = i * G + c; if (L >= nwg) return false;
        int wgid = L;
        if ((G & 7) == 0) { const int q = nwg >> 3, r = nwg & 7, xcd = L & 7, off = L >> 3; wgid = (xcd < r ? xcd * (q + 1) : r * (q + 1) + (xcd - r) * q) + off; }
        const int nig = 8 * nN, gid = wgid / nig, fm = gid * 8, gsz = (nM - fm) < 8 ? (nM - fm) : 8;
        const int rt = fm + ((wgid % nig) % gsz);
        u.pm = rt; u.pn = (wgid % nig) / gsz; int e = 0;
        for (int k = 1; k < ne; ++k) e += (tstart[k] <= rt) ? 1 : 0;
        u.e = e; u.j = rt - tstart[e]; const int left = cnt[e] - 256 * u.j; u.nvalid = left < 256 ? left : 256; return true;
    }
    __device__ __forceinline__ size_t arow(const Unit& u, int r) const {
        if (!GATHER) return (size_t)u.pm * 256 + r;
        const int i = 256 * u.j + (r < u.nvalid ? r : 0);
        return tok ? (size_t)tok[(size_t)u.e * M + i] : (size_t)i;
    }
    __device__ __forceinline__ const bf16* bt(const Unit& u) const { return Bt + (size_t)u.e * bstride + (size_t)u.pn * 256 * K; }
    static constexpr bool LOADS = GATHER;
    __device__ __forceinline__ bool loads() const { return GATHER && tok != nullptr; }
    __device__ __forceinline__ const char* a_base(const Unit& u) const { return GATHER ? (const char*)A : (const char*)(A + (size_t)u.pm * 256 * K); }
    __device__ __forceinline__ void a_offs(const Unit& u, const int (&R)[2], const int (&C)[2], unsigned (&v0)[2], unsigned (&v1)[2]) const {
#pragma unroll
        for (int i = 0; i < 2; ++i) {
            if (GATHER) { v0[i] = (unsigned)(arow(u, R[i]) * K + C[i]) * 2u; v1[i] = (unsigned)(arow(u, R[i] + 128) * K + C[i]) * 2u; }
            else { v0[i] = (unsigned)(R[i] * K + C[i]) * 2u; v1[i] = (unsigned)((R[i] + 128) * K + C[i]) * 2u; }
        }
    }
};
__device__ __forceinline__ void fold_norm(const f32x4& n0, const f32x4& n1, const f32x4& n2, const f32x4& n3, size_t m, int col, bf16* xb, const float* gain, float* rowss) {
    float ss = (n0.x * n0.x + n0.y * n0.y + n0.z * n0.z + n0.w * n0.w) + (n1.x * n1.x + n1.y * n1.y + n1.z * n1.z + n1.w * n1.w)
             + (n2.x * n2.x + n2.y * n2.y + n2.z * n2.z + n2.w * n2.w) + (n3.x * n3.x + n3.y * n3.y + n3.z * n3.z + n3.w * n3.w);
    ss += __shfl_xor(ss, 16); ss += __shfl_xor(ss, 32);
    if (lane_id() < 16) rowss[m * 16 + 4 * (col >> 8) + ((col >> 5) & 3)] = ss;
    const f32x4 g0 = *(const f32x4*)(gain + col), g1 = *(const f32x4*)(gain + col + 4), g2 = *(const f32x4*)(gain + col + 128), g3 = *(const f32x4*)(gain + col + 132);
    u32x4 w; w.x = pk2(n0.x * g0.x, n0.y * g0.y); w.y = pk2(n0.z * g0.z, n0.w * g0.w); w.z = pk2(n1.x * g1.x, n1.y * g1.y); w.w = pk2(n1.z * g1.z, n1.w * g1.w);
    *(u32x4*)(xb + m * D + col) = w;
    w.x = pk2(n2.x * g2.x, n2.y * g2.y); w.y = pk2(n2.z * g2.z, n2.w * g2.w); w.z = pk2(n3.x * g3.x, n3.y * g3.y); w.w = pk2(n3.z * g3.z, n3.w * g3.w);
    *(u32x4*)(xb + m * D + col + 128) = w;
}
__device__ __forceinline__ float fold_rstd(const float* rowss, size_t m) {
    const f32x4* p = (const f32x4*)(rowss + m * 16); const f32x4 a = p[0], b = p[1], c = p[2], d = p[3];
    const float ss = (((a.x + a.y) + (a.z + a.w)) + ((b.x + b.y) + (b.z + b.w))) + (((c.x + c.y) + (c.z + c.w)) + ((d.x + d.y) + (d.z + d.w)));
    return 1.0f / sqrtf(ss * (1.f / D) + EPS);
}
struct EpiIn {
    bf16* proj; float* gates; const float* rowss;
    __device__ __forceinline__ void row8(const Unit& u, int r, int c8, const float (&lo_)[8], const float (&hi_)[8]) const {
        const size_t m = (size_t)u.pm * 256 + r;
        const float rs = rowss ? fold_rstd(rowss, m) : 1.f;
        float lo[8], hi[8];
#pragma unroll
        for (int i = 0; i < 8; ++i) { lo[i] = lo_[i] * rs; hi[i] = hi_[i] * rs; }
        if (u.pn < 11) {
            u32x4 w; w.x = pk2(lo[0], lo[1]); w.y = pk2(lo[2], lo[3]); w.z = pk2(lo[4], lo[5]); w.w = pk2(lo[6], lo[7]);
            *(u32x4*)(proj + m * PC + u.pn * 256 + c8) = w;
            w.x = pk2(hi[0], hi[1]); w.y = pk2(hi[2], hi[3]); w.z = pk2(hi[4], hi[5]); w.w = pk2(hi[6], hi[7]);
            *(u32x4*)(proj + m * PC + u.pn * 256 + 128 + c8) = w;
        } else if (c8 < 24) {
            f32x4 s0, s1;
            s0.x = fsigmoid(lo[0]); s0.y = fsigmoid(lo[1]); s0.z = fsigmoid(lo[2]); s0.w = fsigmoid(lo[3]);
            s1.x = fsigmoid(lo[4]); s1.y = fsigmoid(lo[5]); s1.z = fsigmoid(lo[6]); s1.w = fsigmoid(lo[7]);
            *(f32x4*)(gates + m * 24 + c8) = s0; *(f32x4*)(gates + m * 24 + c8 + 4) = s1;
        }
    }
};
struct EpiRes {
    const float* base; float* out; bf16* xb; const float* gain; float* rowss;
    __device__ __forceinline__ void row8(const Unit& u, int r, int c8, const float (&lo)[8], const float (&hi)[8]) const {
        const size_t o = ((size_t)u.pm * 256 + r) * D + u.pn * 256 + c8;
        const f32x4 b0 = *(const f32x4*)(base + o), b1 = *(const f32x4*)(base + o + 4), b2 = *(const f32x4*)(base + o + 128), b3 = *(const f32x4*)(base + o + 132);
        const f32x4 n0 = (f32x4){b0.x + lo[0], b0.y + lo[1], b0.z + lo[2], b0.w + lo[3]}, n1 = (f32x4){b1.x + lo[4], b1.y + lo[5], b1.z + lo[6], b1.w + lo[7]};
        const f32x4 n2 = (f32x4){b2.x + hi[0], b2.y + hi[1], b2.z + hi[2], b2.w + hi[3]}, n3 = (f32x4){b3.x + hi[4], b3.y + hi[5], b3.z + hi[6], b3.w + hi[7]};
        *(f32x4*)(out + o) = n0; *(f32x4*)(out + o + 4) = n1; *(f32x4*)(out + o + 128) = n2; *(f32x4*)(out + o + 132) = n3;
        if (xb) fold_norm(n0, n1, n2, n3, (size_t)u.pm * 256 + r, u.pn * 256 + c8, xb, gain, rowss);
    }
};
struct EpiGU {
    bf16* hid; const float* rowss;
    __device__ __forceinline__ void row8(const Unit& u, int r, int c8, const float (&lo)[8], const float (&hi)[8]) const {
        float h[8];
        const float rs = rowss ? fold_rstd(rowss, (size_t)u.pm * 256 + r) : 1.f;
#pragma unroll
        for (int i = 0; i < 8; ++i) { const float gt = lo[i] * rs; h[i] = fsilu(gt) * (hi[i] * rs); }
        u32x4 w; w.x = pk2(h[0], h[1]); w.y = pk2(h[2], h[3]); w.z = pk2(h[4], h[5]); w.w = pk2(h[6], h[7]);
        *(u32x4*)(hid + ((size_t)u.pm * 256 + r) * FF + u.pn * 128 + c8) = w;
    }
};
struct EpiGU8 {
    unsigned char* hid;
    __device__ __forceinline__ void row8(const Unit& u, int r, int c8, const float (&lo)[8], const float (&hi)[8]) const {
        constexpr float inv = 1.f / (F8_SA * F8_SW);
        float h[8];
#pragma unroll
        for (int i = 0; i < 8; ++i) { const float gt = lo[i] * inv; h[i] = fsilu(gt) * (hi[i] * (inv * F8_SH)); }
        u32x2 w; w.x = pk4_fp8(h[0], h[1], h[2], h[3]); w.y = pk4_fp8(h[4], h[5], h[6], h[7]);
        *(u32x2*)(hid + ((size_t)u.pm * 256 + r) * FF + u.pn * 128 + c8) = w;
    }
};
struct EpiDown {
    float* x; const int* tok; const float* wt; float scale; bf16* xb; const float* gain; float* rowss;
    __device__ __forceinline__ void row8(const Unit& u, int r, int c8, const float (&lo)[8], const float (&hi)[8]) const {
        if (r >= u.nvalid) return;
        const int i = 256 * u.j + r; size_t m; float w;
        if (tok) { m = (size_t)tok[(size_t)u.e * M + i]; w = wt[(size_t)u.e * M + i] * scale; } else { m = (size_t)i; w = scale; }
        float* o = x + m * D + u.pn * 256 + c8;
        f32x4 b0 = *(f32x4*)(o), b1 = *(f32x4*)(o + 4), b2 = *(f32x4*)(o + 128), b3 = *(f32x4*)(o + 132);
        b0.x += w * lo[0]; b0.y += w * lo[1]; b0.z += w * lo[2]; b0.w += w * lo[3]; b1.x += w * lo[4]; b1.y += w * lo[5]; b1.z += w * lo[6]; b1.w += w * lo[7];
        b2.x += w * hi[0]; b2.y += w * hi[1]; b2.z += w * hi[2]; b2.w += w * hi[3]; b3.x += w * hi[4]; b3.y += w * hi[5]; b3.z += w * hi[6]; b3.w += w * hi[7];
        *(f32x4*)(o) = b0; *(f32x4*)(o + 4) = b1; *(f32x4*)(o + 128) = b2; *(f32x4*)(o + 132) = b3;
        if (xb) fold_norm(b0, b1, b2, b3, m, u.pn * 256 + c8, xb, gain, rowss);
    }
};

template <class Sched, class Epi>
__device__ __forceinline__ void gemm_naive(unsigned char* lds, const Sched& S, const Epi& E, int tid) {
    float* As = (float*)lds;
    float* Bs = As + 32 * 132;
    const int tr = tid >> 4, tc = tid & 15;
    const int lr = tid >> 2, lk = (tid & 3) * 8;
    const int K = S.K;
    Unit u;
    for (int it = 0; S.next(it, u); ++it) {
        const bf16* Btile = S.bt(u);
        for (int hf = 0; hf < 2; ++hf) {
            float lo[4][8], hi[4][8];
#pragma unroll
            for (int i = 0; i < 4; ++i)
#pragma unroll
                for (int j = 0; j < 8; ++j) { lo[i][j] = 0.f; hi[i][j] = 0.f; }
            const bf16* arow = S.A + S.arow(u, hf * 128 + lr) * K + lk;
            const bf16* brow0 = Btile + (size_t)lr * K + lk; const bf16* brow1 = Btile + (size_t)(lr + 128) * K + lk;
            for (int k0 = 0; k0 < K; k0 += 32) {
                const u32x4 av = *(const u32x4*)(arow + k0), b0 = *(const u32x4*)(brow0 + k0), b1 = *(const u32x4*)(brow1 + k0);
                __syncthreads();
                As[(lk + 0) * 132 + lr] = bflo(av.x); As[(lk + 1) * 132 + lr] = bfhi(av.x); As[(lk + 2) * 132 + lr] = bflo(av.y); As[(lk + 3) * 132 + lr] = bfhi(av.y);
                As[(lk + 4) * 132 + lr] = bflo(av.z); As[(lk + 5) * 132 + lr] = bfhi(av.z); As[(lk + 6) * 132 + lr] = bflo(av.w); As[(lk + 7) * 132 + lr] = bfhi(av.w);
                Bs[(lk + 0) * 260 + lr] = bflo(b0.x); Bs[(lk + 1) * 260 + lr] = bfhi(b0.x); Bs[(lk + 2) * 260 + lr] = bflo(b0.y); Bs[(lk + 3) * 260 + lr] = bfhi(b0.y);
                Bs[(lk + 4) * 260 + lr] = bflo(b0.z); Bs[(lk + 5) * 260 + lr] = bfhi(b0.z); Bs[(lk + 6) * 260 + lr] = bflo(b0.w); Bs[(lk + 7) * 260 + lr] = bfhi(b0.w);
                Bs[(lk + 0) * 260 + lr + 128] = bflo(b1.x); Bs[(lk + 1) * 260 + lr + 128] = bfhi(b1.x); Bs[(lk + 2) * 260 + lr + 128] = bflo(b1.y); Bs[(lk + 3) * 260 + lr + 128] = bfhi(b1.y);
                Bs[(lk + 4) * 260 + lr + 128] = bflo(b1.z); Bs[(lk + 5) * 260 + lr + 128] = bfhi(b1.z); Bs[(lk + 6) * 260 + lr + 128] = bflo(b1.w); Bs[(lk + 7) * 260 + lr + 128] = bfhi(b1.w);
                __syncthreads();
#pragma unroll 4
                for (int k = 0; k < 32; ++k) {
                    const f32x4 av4 = *(const f32x4*)(As + k * 132 + 4 * tr);
                    const f32x4 l0 = *(const f32x4*)(Bs + k * 260 + 8 * tc), l1 = *(const f32x4*)(Bs + k * 260 + 8 * tc + 4);
                    const f32x4 h0 = *(const f32x4*)(Bs + k * 260 + 128 + 8 * tc), h1 = *(const f32x4*)(Bs + k * 260 + 128 + 8 * tc + 4);
                    const float aa[4] = {av4.x, av4.y, av4.z, av4.w};
                    const float bl[8] = {l0.x, l0.y, l0.z, l0.w, l1.x, l1.y, l1.z, l1.w}, bh[8] = {h0.x, h0.y, h0.z, h0.w, h1.x, h1.y, h1.z, h1.w};
#pragma unroll
                    for (int i = 0; i < 4; ++i)
#pragma unroll
                        for (int j = 0; j < 8; ++j) { lo[i][j] += aa[i] * bl[j]; hi[i][j] += aa[i] * bh[j]; }
                }
            }
#pragma unroll
            for (int i = 0; i < 4; ++i) E.row8(u, hf * 128 + 4 * tr + i, 8 * tc, lo[i], hi[i]);
        }
    }
    __syncthreads();
}

namespace pg8 {
constexpr int BK = 64, HALF = 128, HTB = HALF * BK * 2;
__device__ __forceinline__ int lds_byte(int r, int c) { const int st = (r >> 4) * 2 + (c >> 5), rr = r & 15, cc = c & 31, ob = rr * 64 + cc * 2; return st * 1024 + (ob ^ (((ob >> 9) & 1) << 5)); }
__device__ __forceinline__ void stage_rc(int b, int& R, int& C) { const int st = b / 1024, sb = b % 1024, swz = sb ^ (((sb >> 9) & 1) << 5); R = (st >> 1) * 16 + swz / 64; C = (st & 1) * 32 + (swz % 64) / 2; }
__device__ __forceinline__ int perm32(int rho) { const int n = rho >> 4, i = rho & 15; return 8 * (i >> 2) + 4 * n + (i & 3); }
}
template <bool FP8, class Sched, class Epi>
__device__ __forceinline__ void gemm_fast(LAS unsigned char* lds, const Sched& S, const Epi& E, int wid) {
    using namespace pg8;
    const int lane = lane_id(), tid = wid * 64 + lane, wr = wid >> 2, wc = wid & 3, fr = lane & 15, fq = lane >> 4;
    const int K = S.K, nt = K / BK;
    unsigned voffB[2];
#pragma unroll
    for (int i = 0; i < 2; ++i) { int R, C; stage_rc(tid * 16 + i * 8192, R, C); const int Rb = (R & ~31) + perm32(R & 31); voffB[i] = (unsigned)(Rb * K + C) * 2u; }
    volatile LAS unsigned* nvs = (volatile LAS unsigned*)(lds + NVOFF_OFF) + tid * 4;
#define PG8_AOFFS(u, o0, o1) do { int _t = tid; asm volatile("" : "+v"(_t)); int _R[2], _C[2]; stage_rc(_t * 16, _R[0], _C[0]); stage_rc(_t * 16 + 8192, _R[1], _C[1]); S.a_offs(u, _R, _C, o0, o1); } while (0)
    const size_t kstep = (size_t)(BK * 2);
    const size_t hstep = (size_t)HALF * K * 2;
    const unsigned ldsw = (unsigned)wid * 1024u;
    const int aoff = lds_byte(wr * 64 + fr, fq * 8), boff = lds_byte(wc * 32 + fr, fq * 8);
    const int c8f = 32 * (fq >> 1) + 16 * (fq & 1);
    const int aoff0 = FP8 ? lds_byte(wr * 64 + fr, c8f) : 0, boff0 = FP8 ? lds_byte(wc * 32 + fr, c8f) : 0;
    int boffH = (FP8 ? boff0 : boff) + 4 * HTB; asm volatile("" : "+v"(boffH));
#define PG8_SA(b, h) (((b) * 2 + (h)) * HTB)
#define PG8_SB(b, h) ((4 + (b) * 2 + (h)) * HTB)
#define PG8_STAGE(bufoff, gbase, voff) do { _Pragma("unroll") for (int _i = 0; _i < 2; ++_i) \
        __builtin_amdgcn_global_load_lds((const unsigned*)((const char*)(gbase) + (voff)[_i]), (LAS unsigned*)(lds + (bufoff) + ldsw + _i * 8192), 16, 0, 0); } while (0)
#define PG8_STAGE_A1(bufoff, gbase) do { if constexpr (Sched::LOADS) PG8_STAGE(bufoff, gbase, cv1); else PG8_STAGE(bufoff, (gbase) + hstep, cv0); } while (0)
#define PG8_LDA(dst, b, h) do { _Pragma("unroll") for (int m = 0; m < 4; ++m) _Pragma("unroll") for (int k = 0; k < 2; ++k) dst[m][k] = *(const LAS bf16x8*)(lds + PG8_SA(b, h) + aoff + m * 2048 + k * 1024); } while (0)
#define PG8_LDB(dst, b, h) do { _Pragma("unroll") for (int n = 0; n < 2; ++n) _Pragma("unroll") for (int k = 0; k < 2; ++k) dst[n][k] = *(const LAS bf16x8*)(lds + boffH + (PG8_SB(b, h) - 4 * HTB) + n * 2048 + k * 1024); } while (0)
#define PG8_MMA(ai, bj, At, Bt) do { __builtin_amdgcn_s_setprio(1); _Pragma("unroll") for (int m = 0; m < 4; ++m) _Pragma("unroll") for (int n = 0; n < 2; ++n) _Pragma("unroll") for (int k = 0; k < 2; ++k) \
        acc[ai][bj][m][n] = __builtin_amdgcn_mfma_f32_16x16x32_bf16(Bt[n][k], At[m][k], acc[ai][bj][m][n], 0, 0, 0); __builtin_amdgcn_s_setprio(0); } while (0)
#define PG8_RD8(dst, o0) do { const v4i _l = *(const LAS v4i*)(lds + (o0)), _h = *(const LAS v4i*)(lds + (o0) + 16); dst = __builtin_shufflevector(_l, _h, 0, 1, 2, 3, 4, 5, 6, 7); } while (0)
#define PG8_LDA8(dst, b, h) do { _Pragma("unroll") for (int m = 0; m < 4; ++m) PG8_RD8(dst[m], PG8_SA(b, h) + aoff0 + m * 2048); } while (0)
#define PG8_LDB8(dst, b, h) do { _Pragma("unroll") for (int n = 0; n < 2; ++n) PG8_RD8(dst[n], boffH + (PG8_SB(b, h) - 4 * HTB) + n * 2048); } while (0)
#define PG8_MMA8(ai, bj, At, Bt) do { __builtin_amdgcn_s_setprio(1); _Pragma("unroll") for (int m = 0; m < 4; ++m) _Pragma("unroll") for (int n = 0; n < 2; ++n) \
        asm volatile("v_mfma_scale_f32_16x16x128_f8f6f4 %0, %1, %2, %0, %3, %3 op_sel_hi:[0,0,0]" : "+v"(acc[ai][bj][m][n]) : "v"(Bt[n]), "v"(At[m]), "v"(f8scale)); __builtin_amdgcn_s_setprio(0); } while (0)
#define PG8_WAIT_V(n) asm volatile("s_waitcnt vmcnt(" #n ")" ::: "memory")
#define PG8_WAIT_L(n) asm volatile("s_waitcnt lgkmcnt(" #n ")" ::: "memory")
#define PG8_BAR __builtin_amdgcn_s_barrier()
#define PG8_SCHED __builtin_amdgcn_sched_barrier(0)
#define XLDA(b, h) do { if constexpr (FP8) PG8_LDA8(At8, b, h); else PG8_LDA(At, b, h); } while (0)
#define XLDB0(b, h) do { if constexpr (FP8) PG8_LDB8(B08, b, h); else PG8_LDB(B0, b, h); } while (0)
#define XLDB1(b, h) do { if constexpr (FP8) PG8_LDB8(B18, b, h); else PG8_LDB(B1, b, h); } while (0)
#define XMMA(ai, bj, w) do { if constexpr (FP8) { if (w) PG8_MMA8(ai, bj, At8, B18); else PG8_MMA8(ai, bj, At8, B08); } else { if (w) PG8_MMA(ai, bj, At, B1); else PG8_MMA(ai, bj, At, B0); } } while (0)
    Unit cur, nxt; int ui = 0;
    if (!S.next(0, cur)) return;
    f32x4 acc[2][2][4][2];
#pragma unroll
    for (int a = 0; a < 2; ++a)
#pragma unroll
        for (int b = 0; b < 2; ++b)
#pragma unroll
            for (int m = 0; m < 4; ++m)
#pragma unroll
                for (int n = 0; n < 2; ++n) acc[a][b][m][n] = (f32x4){0.f, 0.f, 0.f, 0.f};
    bf16x8 At[4][2], B0[2][2], B1[2][2];
    v8i At8[4], B08[2], B18[2];
    const int f8scale = 0x7f7f7f7f;
    unsigned cv0[2], cv1[2];
    const char* cA = S.a_base(cur); const char* cB = (const char*)S.bt(cur);
    PG8_AOFFS(cur, cv0, cv1);
    if (Sched::LOADS && S.loads()) PG8_WAIT_V(0);
    PG8_STAGE(PG8_SB(0, 0), cB, voffB); PG8_STAGE(PG8_SB(0, 1), cB + hstep, voffB); PG8_STAGE(PG8_SA(0, 0), cA, cv0); PG8_STAGE_A1(PG8_SA(0, 1), cA);
    if (wr == 1) PG8_BAR;
    PG8_WAIT_V(2); PG8_BAR;
    PG8_STAGE(PG8_SB(1, 0), cB + kstep, voffB); PG8_STAGE(PG8_SA(1, 0), cA + kstep, cv0); PG8_STAGE(PG8_SB(1, 1), cB + hstep + kstep, voffB);
    PG8_WAIT_V(6); PG8_BAR;
    for (;;) {
        const bool has_next = S.next(ui + 1, nxt);
        const char* nA = cA; const char* nB = cB;
        if (has_next) { nA = S.a_base(nxt); nB = (const char*)S.bt(nxt);
            if (Sched::LOADS) { unsigned n0[2], n1[2]; PG8_AOFFS(nxt, n0, n1); if (S.loads()) PG8_WAIT_V(0); nvs[0] = n0[0]; nvs[1] = n0[1]; nvs[2] = n1[0]; nvs[3] = n1[1]; } }
        for (int t = 0; t < nt; t += 2) {
            const bool last = (t == nt - 2);
            const char* a1 = cA + (size_t)(t + 1) * kstep;
            const char* a2 = last ? nA : cA + (size_t)(t + 2) * kstep; const char* b2 = last ? nB : cB + (size_t)(t + 2) * kstep;
            const char* a3 = a2 + kstep; const char* b3 = b2 + kstep;
            XLDB0(0, 0); XLDB1(0, 1); PG8_SCHED; XLDA(0, 0); PG8_STAGE_A1(PG8_SA(1, 1), a1);
            if (Sched::LOADS) { if (last && has_next) { cv0[0] = nvs[0]; cv0[1] = nvs[1]; cv1[0] = nvs[2]; cv1[1] = nvs[3]; } }
            PG8_WAIT_V(8); PG8_WAIT_L(0); PG8_BAR; XMMA(0, 0, 0); XMMA(0, 1, 1); PG8_BAR; PG8_SCHED;
            XLDA(0, 1); PG8_STAGE(PG8_SB(0, 0), b2, voffB); PG8_STAGE(PG8_SB(0, 1), b2 + hstep, voffB); PG8_STAGE(PG8_SA(0, 0), a2, cv0);
            PG8_WAIT_V(8); PG8_WAIT_L(0); PG8_BAR; XMMA(1, 0, 0); XMMA(1, 1, 1); PG8_BAR; PG8_SCHED;
            XLDB0(1, 0); XLDB1(1, 1); PG8_SCHED; XLDA(1, 0); PG8_STAGE_A1(PG8_SA(0, 1), a2);
            PG8_WAIT_V(8); PG8_WAIT_L(0); PG8_BAR; XMMA(0, 0, 0); XMMA(0, 1, 1); PG8_BAR; PG8_SCHED;
            XLDA(1, 1); PG8_STAGE(PG8_SB(1, 0), b3, voffB); PG8_STAGE(PG8_SB(1, 1), b3 + hstep, voffB); PG8_STAGE(PG8_SA(1, 0), a3, cv0);
            PG8_WAIT_V(8); PG8_WAIT_L(0); PG8_BAR; XMMA(1, 0, 0); XMMA(1, 1, 1); PG8_BAR; PG8_SCHED;
        }
        if (wr == 0) PG8_BAR;
        {
            int frl = fr, c8 = wc * 32 + 8 * fq;
            asm volatile("" : "+v"(frl), "+v"(c8));
#pragma unroll
            for (int ai = 0; ai < 2; ++ai)
#pragma unroll
                for (int m = 0; m < 4; ++m) {
                    const float lo[8] = {acc[ai][0][m][0][0], acc[ai][0][m][0][1], acc[ai][0][m][0][2], acc[ai][0][m][0][3], acc[ai][0][m][1][0], acc[ai][0][m][1][1], acc[ai][0][m][1][2], acc[ai][0][m][1][3]};
                    const float hi[8] = {acc[ai][1][m][0][0], acc[ai][1][m][0][1], acc[ai][1][m][0][2], acc[ai][1][m][0][3], acc[ai][1][m][1][0], acc[ai][1][m][1][1], acc[ai][1][m][1][2], acc[ai][1][m][1][3]};
                    E.row8(cur, ai * HALF + wr * 64 + m * 16 + frl, c8, lo, hi);
                }
        }
        if (!has_next) break;
#pragma unroll
        for (int a = 0; a < 2; ++a)
#pragma unroll
            for (int b = 0; b < 2; ++b)
#pragma unroll
                for (int m = 0; m < 4; ++m)
#pragma unroll
                    for (int n = 0; n < 2; ++n) acc[a][b][m][n] = (f32x4){0.f, 0.f, 0.f, 0.f};
        cur = nxt; cA = nA; cB = nB; ++ui;
        if (wr == 1) PG8_BAR;
    }
    PG8_WAIT_V(0);
    PG8_BAR;
#undef XLDA
#undef XLDB0
#undef XLDB1
#undef XMMA
#undef PG8_RD8
#undef PG8_LDA8
#undef PG8_LDB8
#undef PG8_MMA8
#undef PG8_STAGE_A1
#undef PG8_AOFFS
#undef PG8_SA
#undef PG8_SB
#undef PG8_STAGE
#undef PG8_LDA
#undef PG8_LDB
#undef PG8_MMA
#undef PG8_WAIT_V
#undef PG8_WAIT_L
#undef PG8_BAR
#undef PG8_SCHED
}

__device__ __forceinline__ void routed_setup(unsigned char* lds, const int* cnt_g, int ne, bool dense, int tid, int*& tstart, int*& cnt) {
    tstart = (int*)(lds + MISC_OFF + 64); cnt = tstart + 16;
    __syncthreads();
    if (tid == 0) { int acc = 0; for (int e = 0; e < ne; ++e) { const int n = dense ? M : __hip_atomic_load(cnt_g + e, __ATOMIC_RELAXED, __HIP_MEMORY_SCOPE_AGENT); cnt[e] = n; tstart[e] = acc; acc += (n + 255) >> 8; } tstart[ne] = acc; }
    __syncthreads();
}

constexpr int PH_PER_LAYER = 11, NPHASE = 2 * PH_PER_LAYER;
#if FAST_GEMM
#define GEMM_CALL(S, E) gemm_fast<false>((LAS unsigned char*)lds, S, E, wave)
#define GEMM_CALL8(S, E) gemm_fast<true>((LAS unsigned char*)lds, S, E, wave)
#else
#define GEMM_CALL(S, E) gemm_naive(lds, S, E, wave * 64 + lane_id())
#endif
#define IN(k) (lo <= (k) && (k) < hi)
#define SEAM(k) do { if (IN(k) && IN((k) + 1)) xcd_barrier(bar); } while (0)
template <int L>
__device__ __forceinline__ void layer(const Args& a, unsigned char* lds, const XcdBarrier& bar, int wave, int G, int blk) {
#define lane lane_id()
#define tid (wave * 64 + lane_id())
    unsigned char* ws = a.ws;
    const int lo = a.ph_lo, hi = a.ph_hi;
    bf16* hn = (bf16*)(ws + WS_HN); bf16* proj = (bf16*)(ws + WS_PROJ); float* gates = (float*)(ws + WS_GATES);
    int* cntg = (int*)(ws + WS_CTL) + CW_CNT;
    {
        constexpr int l = L; constexpr int P = l * PH_PER_LAYER;
        const float* xin = (l == 0) ? a.in[0] : a.out;
        constexpr bool FUSED = FUSE_NORM && FAST_GEMM;
        float* rowss0 = (float*)(ws + WS_ROWP); float* rowss1 = rowss0 + (size_t)M * 16;
        bf16* x2 = (bf16*)(ws + WS_X2);
        if (IN(P + 0)) {
            if (l == 0) conv_phase(a, lds, blk * NWAVES + wave, G * NWAVES, wave, lane);
            if (l == 0) { const int gw = blk * NWAVES + wave;
                if (gw < 256) { const int lw = gw >> 6, nn = gw & 63, ln = lane; const float* pos = a.in[5] + (size_t)lw * 2048; const float* w = a.in[6] + (size_t)lw * 2048 * 64;
                    float sacc = 0.f;
                    for (int i = 0; i < 32; ++i) sacc += pos[64 * i + ln] * w[(size_t)(64 * i + ln) * 64 + nn];
                    sacc = wave_sum(sacc);
                    if (ln == 0) ((float*)(ws + WS_CTL) + CW_CBIAS)[lw * 64 + nn] = sacc; } }
            if (!(FUSED && l == 1)) norm_phase<false>(a, lds, xin, a.in[1] + l * D, hn, blk, G, wave, lane, tid);
        }
        if (!(FUSED && l == 1)) SEAM(P + 0);
        if (IN(P + 1)) {
            DenseSched S{hn, (const bf16*)(ws + WS_WIN) + (size_t)l * NIN * D, D, M / 256, NIN / 256, G, blk};
            EpiIn E{proj, gates, (FUSED && l == 1) ? rowss1 : nullptr};
            GEMM_CALL(S, E);
        }
        SEAM(P + 1);
        if (IN(P + 2)) post_phase(a, lds, l, blk, G, wave, lane, tid);
        SEAM(P + 2);
        if (IN(P + 3)) { scan_phase(a, blk, G, tid);
#if NSA_FAST && NSA_LS
            nsa_ls_phase(a, lds, l, blk, G, wave);
#elif NSA_FAST
            nsa_fast_phase(a, lds, l, blk, G, wave);
#else
            nsa_phase(a, lds, blk, G, tid);
#endif
        }
        SEAM(P + 3);
        if (IN(P + 4)) {
#if RET_FAST
            retout_fast_phase(a, lds, l, blk, G, wave);
#else
            retout_phase(a, l, blk, G, tid);
#endif
        }
        SEAM(P + 4);
        if (IN(P + 5)) {
            DenseSched S{hn, (const bf16*)(ws + WS_WOUT) + (size_t)l * D * D, D, M / 256, D / 256, G, blk};
            EpiRes E{xin, a.out, (FUSED && l == 0) ? x2 : nullptr, a.in[9] + l * D, rowss0};
            GEMM_CALL(S, E);
        }
        SEAM(P + 5);
        if (IN(P + 6)) {
            if (l == 0) { if (!FUSED) norm_phase<false, DENSE_FP8 && FAST_GEMM>(a, lds, a.out, a.in[9] + l * D, hn, blk, G, wave, lane, tid); }
            else norm_phase<true, MOE_FP8 && FAST_GEMM>(a, lds, a.out, a.in[9] + l * D, hn, blk, G, wave, lane, tid);
        }
        if (!(FUSED && l == 0)) SEAM(P + 6);
#pragma unroll
        for (int s = 0; s < 2; ++s) {
            const bool dense = (l == 0);
            if (dense && s == 1) break;
            const int ne = dense ? 1 : NE;
            const int* tok = dense ? nullptr : (const int*)(ws + WS_RTOK) + (size_t)s * NE * M;
            const float* wt = dense ? nullptr : (const float*)(ws + WS_RWT) + (size_t)s * NE * M;
            if (IN(P + 7 + 2 * s)) {
                int *tstart, *cnt; routed_setup(lds, cntg + s * 8, ne, dense, tid, tstart, cnt);
                if (!(FAST_GEMM && (dense ? DENSE_FP8 : MOE_FP8))) {
                    RoutedSched<true> S{(FUSED && dense) ? x2 : hn, (const bf16*)(ws + (dense ? WS_WGU : WS_MGU)), (size_t)2 * FF * D, D, 2 * FF / 256, G, blk, ne, tok, tstart, cnt};
                    EpiGU E{proj, (FUSED && dense) ? rowss0 : nullptr};
                    GEMM_CALL(S, E);
                } else {
#if (MOE_FP8 || DENSE_FP8) && FAST_GEMM
                    RoutedSched<true> S{hn, (const bf16*)(ws + (dense ? WS_WGU : WS_MGU)), (size_t)2 * FF * D / 2, D / 2, 2 * FF / 256, G, blk, ne, tok, tstart, cnt};
                    EpiGU8 E{(unsigned char*)proj};
                    GEMM_CALL8(S, E);
#endif
                }
            }
            SEAM(P + 7 + 2 * s);
            if (IN(P + 8 + 2 * s)) {
                int *tstart, *cnt; routed_setup(lds, cntg + s * 8, ne, dense, tid, tstart, cnt);
                if (!(FAST_GEMM && (dense ? DENSE_FP8 : MOE_FP8))) {
                    RoutedSched<false> S{proj, (const bf16*)(ws + (dense ? WS_WDN : WS_MDN)), (size_t)D * FF, FF, D / 256, G, blk, ne, tok, tstart, cnt};
                    EpiDown E{a.out, tok, wt, 1.f, (FUSED && dense) ? hn : nullptr, a.in[1] + D, rowss1};
                    GEMM_CALL(S, E);
                } else {
#if (MOE_FP8 || DENSE_FP8) && FAST_GEMM
                    RoutedSched<false> S{proj, (const bf16*)(ws + (dense ? WS_WDN : WS_MDN)), (size_t)D * FF / 2, FF / 2, D / 256, G, blk, ne, tok, tstart, cnt};
                    EpiDown E{a.out, tok, wt, 1.f / (F8_SH * F8_SW), nullptr, nullptr, nullptr};
                    GEMM_CALL8(S, E);
#endif
                }
            }
            if (!(l == 1 && s == 1)) SEAM(P + 8 + 2 * s);
        }
    }
}
#undef lane
#undef tid
#undef IN
#undef SEAM
__global__ void __launch_bounds__(NTHR, 2) fwd(Args a) {
    extern __shared__ __attribute__((aligned(16))) unsigned char lds[];
    const int wave = __builtin_amdgcn_readfirstlane(threadIdx.x >> 6);
    const int G = gridDim.x, blk = blockIdx.x;
    unsigned char* ws = a.ws;
    volatile LAS unsigned* misc = (volatile LAS unsigned*)((LAS unsigned char*)lds + MISC_OFF);
    if (wave == 0) misc[lane_id()] = 0u;
    __syncthreads();
    XcdBarrier bar; bar.bar = (unsigned*)(ws + WS_CTL) + CW_BAR; bar.x = 0; bar.st = nullptr;
    const bool multi = (a.ph_hi - a.ph_lo) > 1;
    bar.wave = wave;
    if (multi) bar = xcd_barrier_post((unsigned*)(ws + WS_CTL) + CW_BAR, misc + 8, wave);
    layer<0>(a, lds, bar, wave, G, blk);
    layer<1>(a, lds, bar, wave, G, blk);
}

extern "C" void kernel_launch(void* const* d_in, const int* in_sizes, int n_in, void* d_out, int out_size, void* d_ws, size_t ws_size, hipStream_t stream) {
    static int grid = 0;
    if (grid == 0) {
        if (n_in != 18 || out_size != M * D || ws_size < WS_END) { fprintf(stderr, "kernel_launch: unexpected problem (n_in %d out %d ws %zu)\n", n_in, out_size, ws_size); grid = -1; return; }
        int dev = 0, cus = 0;
        if (hipGetDevice(&dev) != hipSuccess || hipDeviceGetAttribute(&cus, hipDeviceAttributeMultiprocessorCount, dev) != hipSuccess) { grid = -1; return; }
        if (hipFuncSetAttribute((const void*)fwd, hipFuncAttributeMaxDynamicSharedMemorySize, LDS_BYTES) != hipSuccess) { grid = -1; return; }
        int per_cu = 0;
        if (hipOccupancyMaxActiveBlocksPerMultiprocessor(&per_cu, (const void*)fwd, NTHR, LDS_BYTES) != hipSuccess || per_cu < 1) fprintf(stderr, "kernel_launch: occupancy query says %d\n", per_cu);
        (void)hipGetLastError();
        grid = 256;
        if (cus < 256) { fprintf(stderr, "kernel_launch: needs 256 CUs, device has %d\n", cus); grid = -1; return; }
    }
    if (grid < 0) return;
    (void)hipMemsetAsync((char*)d_ws + WS_CTL, 0, CTL_BYTES, stream);
    Args a{};
    for (int i = 0; i < 18; ++i) a.in[i] = (const float*)d_in[i];
    a.out = (float*)d_out; a.ws = (unsigned char*)d_ws;
#if ONE_LAUNCH
    a.ph_lo = 0; a.ph_hi = NPHASE;
    hipLaunchKernelGGL(fwd, dim3(grid), dim3(NTHR), LDS_BYTES, stream, a);
#else
    for (int p = 0; p < NPHASE; ++p) {
        if (p == 9 || p == 10) continue;
        a.ph_lo = p; a.ph_hi = p + 1;
        hipLaunchKernelGGL(fwd, dim3(grid), dim3(NTHR), LDS_BYTES, stream, a);
    }
#endif
}
```

```cpp
#include <hip/hip_runtime.h>
#include <cstdio>
#include <cstdint>

#ifndef FAST_GEMM
#define FAST_GEMM 1
#endif
#ifndef NSA_FAST
#define NSA_FAST 1
#endif
#ifndef MOE_FP8
#define MOE_FP8 1
#endif
#ifndef DENSE_FP8
#define DENSE_FP8 0
#endif
#ifndef FUSE_NORM
#define FUSE_NORM 0
#endif
#ifndef NSA_LS
#define NSA_LS 0
#endif
#ifndef RET_FAST
#define RET_FAST 1
#endif
#ifndef ONE_LAUNCH
#define ONE_LAUNCH 1
#endif

#define LAS __attribute__((address_space(3)))
typedef unsigned short bf16;
typedef float f32x4 __attribute__((ext_vector_type(4)));
typedef unsigned u32x4 __attribute__((ext_vector_type(4)));
typedef unsigned u32x2 __attribute__((ext_vector_type(2)));
typedef short bf16x8 __attribute__((ext_vector_type(8)));
typedef float f32x16 __attribute__((ext_vector_type(16)));
typedef int v8i __attribute__((ext_vector_type(8)));
typedef int v4i __attribute__((ext_vector_type(4)));

constexpr int NB = 4, T = 8192, D = 1024, M = NB * T;
constexpr int PC = 2816;
constexpr int NIN = 3072;
constexpr int INC = 2840;
constexpr int FF = 2816, NE = 8;
constexpr int C_Q = 0, C_KC = 512, C_VC = 640, C_KS = 768, C_VS = 896, C_KW = 1024, C_VW = 1152, C_RQ = 1280, C_RK = 1536, C_RV = 1792, C_RG = 2304;
constexpr int NCB = 512;
constexpr float EPS = 1e-6f;
constexpr float LOG2E = 1.4426950408889634f;
constexpr int NTHR = 512, NWAVES = 8;
constexpr int HROWS = M + NE * 256;

constexpr size_t MiB = 1u << 20;
constexpr size_t WS_CTL = 0, CTL_BYTES = 1 * MiB;
constexpr size_t WS_WIN = 2 * MiB;
constexpr size_t WS_WOUT = 14 * MiB;
constexpr size_t WS_WGU = 18 * MiB;
constexpr size_t WS_WDN = 29 * MiB;
constexpr size_t WS_MGU = 35 * MiB;
constexpr size_t WS_MDN = (MOE_FP8 && FAST_GEMM ? 79 : 123) * MiB;
constexpr size_t WS_X2 = 102 * MiB;
static_assert(!FUSE_NORM || (MOE_FP8 && FAST_GEMM && !DENSE_FP8), "FUSE_NORM uses workspace freed by MOE_FP8 and the bf16 dense FFN");
static_assert(!FUSE_NORM || (WS_X2 >= WS_MDN + (size_t)8 * FF * D && WS_X2 + (size_t)M * D * 2 <= 168 * MiB), "X2 region");
constexpr size_t WS_HN = 168 * MiB;
constexpr size_t WS_PROJ = 232 * MiB;
constexpr size_t WS_GATES = 420 * MiB;
constexpr size_t WS_KCMP = 423 * MiB;
constexpr size_t WS_VCMP = WS_KCMP + 512 * 1024;
constexpr size_t WS_RETS = 424 * MiB;
constexpr size_t WS_RTOK = 440 * MiB;
constexpr size_t WS_RWT = 442 * MiB;
constexpr size_t WS_KS = 444 * MiB;
constexpr size_t WS_KW = 452 * MiB;
constexpr size_t WS_VST = 460 * MiB;
constexpr size_t WS_VWT = 468 * MiB;
constexpr size_t WS_VCT = 476 * MiB;
constexpr size_t WS_WCT = 477 * MiB;
constexpr size_t WS_RST = 478 * MiB;
constexpr size_t WS_KCF = 486 * MiB;
constexpr size_t WS_ROWP = 487 * MiB;
constexpr size_t WS_END = 491 * MiB;
static_assert(WS_PROJ + (size_t)HROWS * FF * 2 <= WS_GATES, "hidden overlay fits");
constexpr int CW_BAR = 4096;
constexpr int CW_CNT = 16384;
constexpr int CW_ROWSS = 32768;
constexpr int CW_CBIAS = 196608;

constexpr int LDS_BYTES = 147456;
constexpr int MISC_OFF = 131072;
constexpr int SELM_OFF = 131072 + 1024;
constexpr int NVOFF_OFF = 131072 + 2048;

__device__ __forceinline__ unsigned f2bf(float f) { unsigned u = __builtin_bit_cast(unsigned, f); return (u + 0x7fffu + ((u >> 16) & 1u)) >> 16; }
typedef float f32x2_t __attribute__((ext_vector_type(2)));
typedef __bf16 bf16x2_t __attribute__((ext_vector_type(2)));
__device__ __forceinline__ unsigned pk2(float lo, float hi) { const f32x2_t v = {lo, hi}; const bf16x2_t b = __builtin_convertvector(v, bf16x2_t); return __builtin_bit_cast(unsigned, b); }
__device__ __forceinline__ float bflo(unsigned u) { return __builtin_bit_cast(float, u << 16); }
__device__ __forceinline__ float bfhi(unsigned u) { return __builtin_bit_cast(float, u & 0xffff0000u); }
__device__ __forceinline__ float bf2f(bf16 h) { return __builtin_bit_cast(float, (unsigned)h << 16); }
__device__ __forceinline__ float wave_sum(float v) {
#pragma unroll
    for (int o = 1; o < 64; o <<= 1) v += __shfl_xor(v, o);
    return v;
}
__device__ __forceinline__ unsigned pk4_fp8(float a, float b, float c, float d) {
    a = __builtin_amdgcn_fmed3f(a, -448.f, 448.f); b = __builtin_amdgcn_fmed3f(b, -448.f, 448.f); c = __builtin_amdgcn_fmed3f(c, -448.f, 448.f); d = __builtin_amdgcn_fmed3f(d, -448.f, 448.f);
    int w = 0; w = __builtin_amdgcn_cvt_pk_fp8_f32(a, b, w, false); w = __builtin_amdgcn_cvt_pk_fp8_f32(c, d, w, true); return (unsigned)w;
}
constexpr float F8_SA = 16.f, F8_SW = 256.f, F8_SH = 8.f;
__device__ __forceinline__ float dpp_xor1(float x) { return __builtin_bit_cast(float, __builtin_amdgcn_update_dpp(0, __builtin_bit_cast(int, x), 0xB1, 0xf, 0xf, true)); }
__device__ __forceinline__ float dpp_xor2(float x) { return __builtin_bit_cast(float, __builtin_amdgcn_update_dpp(0, __builtin_bit_cast(int, x), 0x4E, 0xf, 0xf, true)); }
#define LDS_WAIT() asm volatile("s_waitcnt lgkmcnt(0)" ::: "memory")
__device__ __forceinline__ float fsigmoid(float x) { return __builtin_amdgcn_rcpf(1.f + __builtin_amdgcn_exp2f(x * -1.4426950408889634f)); }
__device__ __forceinline__ float fsilu(float x) { return x * fsigmoid(x); }
__device__ __forceinline__ int lane_id() { int l; asm volatile("v_mbcnt_lo_u32_b32 %0, -1, 0\n\tv_mbcnt_hi_u32_b32 %0, -1, %0" : "=v"(l)); return l; }

#define XB_TMO      128
#define XB_XCNT(j)  (256  + 64 * (j))
#define XB_XSUB(j)  (1280 + 64 * (j))
#define XB_XGEN(j)  (2304 + 64 * (j))
#define XB_TOP      3328
#define XB_TOPGEN   3392
#define XCD_BAR_WORDS 3456
#define XB_SPIN_CAP (1u << 18)
__device__ __forceinline__ unsigned xb_ld(unsigned* p)              { return __hip_atomic_load(p, __ATOMIC_RELAXED, __HIP_MEMORY_SCOPE_AGENT); }
__device__ __forceinline__ unsigned xb_add(unsigned* p, unsigned v) { return __hip_atomic_fetch_add(p, v, __ATOMIC_RELAXED, __HIP_MEMORY_SCOPE_AGENT); }
__device__ __forceinline__ unsigned xb_xcc_id() { return (unsigned)__builtin_amdgcn_s_getreg((3 << 11) | 20) & 0xFu; }
#define XB_SPIN(cond, bar) do { unsigned _sp = 0; while (cond) { __builtin_amdgcn_s_sleep(1); \
    if ((++_sp & 255u) == 0u) { if (xb_ld(&(bar)[XB_TMO])) break; if (_sp > XB_SPIN_CAP) { atomicAdd(&(bar)[XB_TMO], 1u); break; } } } } while (0)
struct XcdBarrier { unsigned* bar; unsigned x; volatile LAS unsigned* st; int wave; };
__device__ __forceinline__ XcdBarrier xcd_barrier_post(unsigned* bar, volatile LAS unsigned* st, int wave) {
    XcdBarrier b; b.bar = bar; b.x = xb_xcc_id(); b.st = st; b.wave = wave;
    if (wave == 0 && lane_id() == 0) (void)xb_add(&bar[XB_XCNT(b.x)], 1u);
    return b;
}
__device__ __forceinline__ void xcd_barrier_complete(unsigned* bar, unsigned x, unsigned& nloc, unsigned& nx) {
    const unsigned G = gridDim.x * gridDim.y * gridDim.z;
    unsigned sum, cnt, mine, sp = 0u;
    for (;;) {
        sum = 0u; cnt = 0u; mine = 0u;
#pragma unroll
        for (unsigned j = 0; j < 16; ++j) { const unsigned c = xb_ld(&bar[XB_XCNT(j)]); sum += c; cnt += (c > 0u) ? 1u : 0u; mine = (j == x) ? c : mine; }
        if (sum == G) break;
        __builtin_amdgcn_s_sleep(1);
        if ((++sp & 255u) == 0u) { if (xb_ld(&bar[XB_TMO])) break; if (sp > XB_SPIN_CAP) { atomicAdd(&bar[XB_TMO], 1u); break; } }
    }
    nloc = mine > 0u ? mine : 1u; nx = cnt > 0u ? cnt : 1u;
}
__device__ __forceinline__ void xcd_barrier(const XcdBarrier& b) {
    asm volatile("s_waitcnt vmcnt(0)" ::: "memory");
    __syncthreads();
    if (b.wave == 0 && lane_id() == 0) {
        unsigned* bar = b.bar;
        __builtin_amdgcn_s_waitcnt(0);
        unsigned nloc = b.st[0], nx = b.st[1];
        if (nloc == 0u) { xcd_barrier_complete(bar, b.x, nloc, nx); b.st[0] = nloc; b.st[1] = nx; }
        const unsigned old = xb_add(&bar[XB_XSUB(b.x)], 1u);
        const unsigned gen = old / nloc;
        if (old + 1u == (gen + 1u) * nloc) {
            __builtin_amdgcn_fence(__ATOMIC_RELEASE, "agent");
            asm volatile("s_waitcnt vmcnt(0)" ::: "memory");
            const unsigned og = xb_add(&bar[XB_TOP], 1u);
            const unsigned tg = og / nx;
            if (og + 1u == (tg + 1u) * nx) xb_add(&bar[XB_TOPGEN], 1u);
            else XB_SPIN(xb_ld(&bar[XB_TOPGEN]) == tg, bar);
            __builtin_amdgcn_fence(__ATOMIC_ACQUIRE, "agent");
            xb_add(&bar[XB_XGEN(b.x)], 1u);
            asm volatile("s_waitcnt vmcnt(0)" ::: "memory");
        } else {
            XB_SPIN(xb_ld(&bar[XB_XGEN(b.x)]) == gen, bar);
            __builtin_amdgcn_fence(__ATOMIC_ACQUIRE, "agent");
            asm volatile("s_waitcnt vmcnt(0)" ::: "memory");
        }
    }
    __syncthreads();
}

struct Args {
    const float* in[18];
    float* out;
    unsigned char* ws;
    int ph_lo, ph_hi;
};

__device__ __forceinline__ void tr_item(const float* __restrict__ src, int ld, int k0, int c0, int nvalid, bf16* dst, int Kd, float* scr, int lane) {
    float tv[32];
#pragma unroll
    for (int i = 0; i < 32; ++i) { const int kk = 2 * i + (lane >> 5), n = lane & 31; tv[i] = (n < nvalid) ? src[(size_t)(k0 + kk) * ld + c0 + n] : 0.f; }
#pragma unroll
    for (int i = 0; i < 32; ++i) { const int kk = 2 * i + (lane >> 5), n = lane & 31; scr[kk * 33 + n] = tv[i]; }
    LDS_WAIT();
    const int c = lane & 7;
#pragma unroll
    for (int j = 0; j < 4; ++j) { const int n = (lane >> 3) + 8 * j; const float* s = scr + (8 * c) * 33 + n;
        u32x4 o; o.x = pk2(s[0 * 33], s[1 * 33]); o.y = pk2(s[2 * 33], s[3 * 33]); o.z = pk2(s[4 * 33], s[5 * 33]); o.w = pk2(s[6 * 33], s[7 * 33]);
        *(u32x4*)(dst + (size_t)n * Kd + k0 + 8 * c) = o; }
    LDS_WAIT();
}
__device__ __forceinline__ void tr_item8(const float* __restrict__ src, int ld, int k0, int c0, unsigned char* dst, int Kd, float* scr, int lane) {
    float tv[32];
#pragma unroll
    for (int i = 0; i < 32; ++i) { const int kk = 2 * i + (lane >> 5), n = lane & 31; tv[i] = src[(size_t)(k0 + kk) * ld + c0 + n]; }
#pragma unroll
    for (int i = 0; i < 32; ++i) { const int kk = 2 * i + (lane >> 5), n = lane & 31; scr[kk * 33 + n] = tv[i] * F8_SW; }
    LDS_WAIT();
    const int c = lane & 7;
#pragma unroll
    for (int j = 0; j < 4; ++j) { const int n = (lane >> 3) + 8 * j; const float* sp = scr + (8 * c) * 33 + n;
        u32x2 o; o.x = pk4_fp8(sp[0 * 33], sp[1 * 33], sp[2 * 33], sp[3 * 33]); o.y = pk4_fp8(sp[4 * 33], sp[5 * 33], sp[6 * 33], sp[7 * 33]);
        *(u32x2*)(dst + (size_t)n * Kd + k0 + 8 * c) = o; }
    LDS_WAIT();
}
__device__ __forceinline__ void conv_phase(const Args& a, unsigned char* lds, int gw, int NGW, int wave, int lane) {
    float* scr = (float*)lds + wave * (64 * 33);
    unsigned char* ws = a.ws;
    constexpr int I_IN = (NIN / 32) * (D / 64);
    constexpr int I_OUT = (D / 32) * (D / 64);
    constexpr int I_GU = (2 * FF / 32) * (D / 64);
    constexpr int I_DN = (D / 32) * (FF / 64);
    constexpr int I_CMP = 2 * 32;
    constexpr int NITEMS = 2 * I_IN + 2 * I_OUT + I_GU + I_DN + NE * (I_GU + I_DN) + 4 * I_CMP;
    for (int it0 = gw; it0 < NITEMS; it0 += NGW) {
        int it = it0;
        if (it < 2 * I_IN) { const int l = it / I_IN, r = it % I_IN, nb = r % (NIN / 32), kb = r / (NIN / 32), n0 = 32 * nb;
            int c0, nv; if (n0 < 1280) { c0 = n0; nv = 32; } else if (n0 < 2816) { c0 = n0 + 24; nv = 32; } else if (n0 == 2816) { c0 = 1280; nv = 24; } else { c0 = 0; nv = 0; }
            tr_item(a.in[2] + (size_t)l * D * INC, INC, 64 * kb, c0, nv, (bf16*)(ws + WS_WIN) + ((size_t)l * NIN + n0) * D, D, scr, lane); continue; }
        it -= 2 * I_IN;
        if (it < 2 * I_OUT) { const int l = it / I_OUT, r = it % I_OUT, nb = r % (D / 32), kb = r / (D / 32), n0 = 32 * nb;
            tr_item(a.in[8] + (size_t)l * D * D, D, 64 * kb, n0, 32, (bf16*)(ws + WS_WOUT) + ((size_t)l * D + n0) * D, D, scr, lane); continue; }
        it -= 2 * I_OUT;
        if (it < I_GU) { const int nb = it % (2 * FF / 32), kb = it / (2 * FF / 32), n0 = 32 * nb, p = n0 >> 8, c = n0 & 255;
#if DENSE_FP8
            tr_item8(c < 128 ? a.in[10] : a.in[11], FF, 64 * kb, 128 * p + (c & 127), (unsigned char*)(ws + WS_WGU) + (size_t)n0 * D, D, scr, lane); continue; }
#else
            tr_item(c < 128 ? a.in[10] : a.in[11], FF, 64 * kb, 128 * p + (c & 127), 32, (bf16*)(ws + WS_WGU) + (size_t)n0 * D, D, scr, lane); continue; }
#endif
        it -= I_GU;
        if (it < I_DN) { const int nb = it % (D / 32), kb = it / (D / 32), n0 = 32 * nb;
#if DENSE_FP8
            tr_item8(a.in[12], D, 64 * kb, n0, (unsigned char*)(ws + WS_WDN) + (size_t)n0 * FF, FF, scr, lane); continue; }
#else
            tr_item(a.in[12], D, 64 * kb, n0, 32, (bf16*)(ws + WS_WDN) + (size_t)n0 * FF, FF, scr, lane); continue; }
#endif
        it -= I_DN;
        if (it < NE * I_GU) { const int e = it / I_GU, r = it % I_GU, nb = r % (2 * FF / 32), kb = r / (2 * FF / 32), n0 = 32 * nb, p = n0 >> 8, c = n0 & 255;
#if MOE_FP8
            tr_item8((c < 128 ? a.in[15] : a.in[16]) + (size_t)e * D * FF, FF, 64 * kb, 128 * p + (c & 127), (unsigned char*)(ws + WS_MGU) + ((size_t)e * 2 * FF + n0) * D, D, scr, lane); continue; }
#else
            tr_item((c < 128 ? a.in[15] : a.in[16]) + (size_t)e * D * FF, FF, 64 * kb, 128 * p + (c & 127), 32, (bf16*)(ws + WS_MGU) + ((size_t)e * 2 * FF + n0) * D, D, scr, lane); continue; }
#endif
        it -= NE * I_GU;
        if (it >= NE * I_DN) { it -= NE * I_DN; const int lw = it / I_CMP, r = it % I_CMP, nb = r & 1, kb = r >> 1;
            tr_item(a.in[6] + (size_t)lw * 2048 * 64, 64, 64 * kb, 32 * nb, 32, (bf16*)(ws + WS_WCT) + ((size_t)lw * 64 + 32 * nb) * 2048, 2048, scr, lane); continue; }
        { const int e = it / I_DN, r = it % I_DN, nb = r % (D / 32), kb = r / (D / 32), n0 = 32 * nb;
#if MOE_FP8
            tr_item8(a.in[17] + (size_t)e * FF * D, D, 64 * kb, n0, (unsigned char*)(ws + WS_MDN) + ((size_t)e * D + n0) * FF, FF, scr, lane); }
#else
            tr_item(a.in[17] + (size_t)e * FF * D, D, 64 * kb, n0, 32, (bf16*)(ws + WS_MDN) + ((size_t)e * D + n0) * FF, FF, scr, lane); }
#endif
    }
}

template <bool ROUTE, bool OUT8 = false>
__device__ __forceinline__ void norm_phase(const Args& a, unsigned char* lds, const float* x, const float* g, bf16* out, int blk, int G, int wave, int lane, int tid) {
    const int RPB = M / G;
    int* r_e = (int*)lds;
    float* r_w = (float*)(lds + 8192);
    const float* router = a.in[13]; const float* rb = a.in[14];
    f32x4 gv[4];
#pragma unroll
    for (int j = 0; j < 4; ++j) gv[j] = ((const f32x4*)g)[64 * j + lane];
    float rw[ROUTE ? 16 : 1][8];
    if (ROUTE) {
#pragma unroll
        for (int j = 0; j < 4; ++j)
#pragma unroll
            for (int i = 0; i < 4; ++i) { const int k = 4 * (64 * j + lane) + i; const f32x4 r0 = *(const f32x4*)(router + (size_t)k * 8), r1 = *(const f32x4*)(router + (size_t)k * 8 + 4);
                rw[4 * j + i][0] = r0.x; rw[4 * j + i][1] = r0.y; rw[4 * j + i][2] = r0.z; rw[4 * j + i][3] = r0.w; rw[4 * j + i][4] = r1.x; rw[4 * j + i][5] = r1.y; rw[4 * j + i][6] = r1.z; rw[4 * j + i][7] = r1.w; }
    }
    f32x4 vn[4];
    { const f32x4* xr0 = (const f32x4*)(x + (size_t)(blk * RPB + wave) * D) + lane;
#pragma unroll
        for (int j = 0; j < 4; ++j) vn[j] = xr0[64 * j]; }
    for (int rl = wave; rl < RPB; rl += NWAVES) {
        const int m = blk * RPB + rl;
        f32x4 v[4]; float ss = 0.f;
#pragma unroll
        for (int j = 0; j < 4; ++j) v[j] = vn[j];
        if (rl + NWAVES < RPB) { const f32x4* xr1 = (const f32x4*)(x + (size_t)(m + NWAVES) * D) + lane;
#pragma unroll
            for (int j = 0; j < 4; ++j) vn[j] = xr1[64 * j]; }
#pragma unroll
        for (int j = 0; j < 4; ++j) ss += (v[j].x * v[j].x + v[j].y * v[j].y) + (v[j].z * v[j].z + v[j].w * v[j].w);
        const float rstd = 1.0f / sqrtf(wave_sum(ss) * (1.f / D) + EPS);
        if (OUT8) {
            unsigned* o4 = (unsigned*)((unsigned char*)out + (size_t)m * D) + lane;
#pragma unroll
            for (int j = 0; j < 4; ++j) { v[j] = v[j] * rstd * gv[j]; o4[64 * j] = pk4_fp8(v[j].x * F8_SA, v[j].y * F8_SA, v[j].z * F8_SA, v[j].w * F8_SA); }
        } else {
        u32x2* o8 = (u32x2*)(out + (size_t)m * D) + lane;
#pragma unroll
        for (int j = 0; j < 4; ++j) { v[j] = v[j] * rstd * gv[j]; u32x2 w; w.x = pk2(v[j].x, v[j].y); w.y = pk2(v[j].z, v[j].w); o8[64 * j] = w; }
        }
        if (ROUTE) {
            float lg[8];
#pragma unroll
            for (int e = 0; e < 8; ++e) lg[e] = 0.f;
#pragma unroll
            for (int j = 0; j < 4; ++j)
#pragma unroll
                for (int i = 0; i < 4; ++i) { const float xv = v[j][i];
#pragma unroll
                    for (int e = 0; e < 8; ++e) lg[e] += xv * rw[ROUTE ? 4 * j + i : 0][e]; }
            { const bool b5 = lane & 32, b4 = lane & 16, b3 = lane & 8; float t4[4], t2[2];
#pragma unroll
                for (int q = 0; q < 4; ++q) { const float snd = b5 ? lg[q] : lg[q + 4], mine = b5 ? lg[q + 4] : lg[q]; t4[q] = mine + __shfl_xor(snd, 32); }
#pragma unroll
                for (int q = 0; q < 2; ++q) { const float snd = b4 ? t4[q] : t4[q + 2], mine = b4 ? t4[q + 2] : t4[q]; t2[q] = mine + __shfl_xor(snd, 16); }
                float w1v; { const float snd = b3 ? t2[0] : t2[1], mine = b3 ? t2[1] : t2[0]; w1v = mine + __shfl_xor(snd, 8); }
                w1v += __shfl_xor(w1v, 4); w1v += dpp_xor2(w1v); w1v += dpp_xor1(w1v);
#pragma unroll
                for (int e = 0; e < 8; ++e) lg[e] = __builtin_bit_cast(float, __builtin_amdgcn_readlane(__builtin_bit_cast(int, w1v), 32 * (e >> 2) + 16 * ((e >> 1) & 1) + 8 * (e & 1))) + rb[e]; }
            int i0 = 0; float v0 = lg[0];
#pragma unroll
            for (int e = 1; e < 8; ++e) if (lg[e] > v0) { v0 = lg[e]; i0 = e; }
            int i1 = -1; float v1 = -3.0e38f;
#pragma unroll
            for (int e = 0; e < 8; ++e) if (e != i0 && lg[e] > v1) { v1 = lg[e]; i1 = e; }
            const float w1 = 1.f / (1.f + __expf(v0 - v1)), w0 = 1.f - w1;
            if (lane == 0) { r_e[2 * rl] = i0; r_e[2 * rl + 1] = i1; r_w[2 * rl] = w0; r_w[2 * rl + 1] = w1; }
        }
    }
    if (ROUTE) {
        __syncthreads();
        {
            int* cnt = (int*)(a.ws + WS_CTL) + CW_CNT;
#pragma unroll
            for (int cc = 0; cc < 2; ++cc) {
                const int combo = 2 * wave + cc, s = combo >> 3, e = combo & 7;
                const bool f0 = r_e[2 * lane + s] == e, f1 = r_e[2 * (lane + 64) + s] == e;
                const unsigned long long m0 = __ballot(f0), m1 = __ballot(f1);
                const int n0 = __popcll(m0), n = n0 + __popcll(m1);
                int base = 0; if (lane == 0 && n) base = atomicAdd(&cnt[combo], n);
                base = __builtin_amdgcn_readfirstlane(base);
                int* tok = (int*)(a.ws + WS_RTOK) + (size_t)combo * M; float* wt = (float*)(a.ws + WS_RWT) + (size_t)combo * M;
                const unsigned long long below = (1ull << lane) - 1ull;
                if (f0) { const int p = base + __popcll(m0 & below); tok[p] = blk * RPB + lane; wt[p] = r_w[2 * lane + s]; }
                if (f1) { const int p = base + n0 + __popcll(m1 & below); tok[p] = blk * RPB + lane + 64; wt[p] = r_w[2 * (lane + 64) + s]; }
            }
        }
        __syncthreads();
    }
}

__device__ __forceinline__ void post_phase(const Args& a, unsigned char* lds, int l, int blk, int G, int wave, int lane, int tid) {
    bf16* proj = (bf16*)(a.ws + WS_PROJ);
    const int gw = blk * NWAVES + wave, NGW = G * NWAVES;
    {
        const float* qg = a.in[3] + l * 64; const float* kg = a.in[4] + l * 192;
        const int sub = lane & 7;
        for (int v0 = gw * 8; v0 < M * 12; v0 += NGW * 8) {
            const int vec = v0 + (lane >> 3), m = vec / 12, j = vec % 12;
            int col; const float* gp; float sc = 1.f;
            if (j < 8) { col = C_Q + 64 * j; gp = qg; sc = 0.125f * LOG2E; } else if (j < 10) { col = C_KS + 64 * (j - 8); gp = kg + 64; } else { col = C_KW + 64 * (j - 10); gp = kg + 128; }
            u32x4* p = (u32x4*)(proj + (size_t)m * PC + col + 8 * sub);
            const u32x4 u = *p;
            float f[8] = {bflo(u.x), bfhi(u.x), bflo(u.y), bfhi(u.y), bflo(u.z), bfhi(u.z), bflo(u.w), bfhi(u.w)};
            float ss = 0.f;
#pragma unroll
            for (int i = 0; i < 8; ++i) ss += f[i] * f[i];
            ss += __shfl_xor(ss, 1); ss += __shfl_xor(ss, 2); ss += __shfl_xor(ss, 4);
            const float rs = sc / sqrtf(ss * (1.f / 64.f) + EPS);
            const f32x4 g0 = *(const f32x4*)(gp + 8 * sub), g1 = *(const f32x4*)(gp + 8 * sub + 4);
            u32x4 o; o.x = pk2(f[0] * rs * g0.x, f[1] * rs * g0.y); o.y = pk2(f[2] * rs * g0.z, f[3] * rs * g0.w); o.z = pk2(f[4] * rs * g1.x, f[5] * rs * g1.y); o.w = pk2(f[6] * rs * g1.z, f[7] * rs * g1.w);
            *p = o;
            if (j >= 8) { const int gg = (j - 8) & 1, bb = m / T, tt = m % T, kk = tt & 31, nn = (kk & 0x13) | ((kk & 4) << 1) | ((kk & 8) >> 1);
                *(u32x4*)((bf16*)(a.ws + (j < 10 ? WS_KS : WS_KW)) + (size_t)(bb * 2 + gg) * T * 64 + ((size_t)((tt >> 5) * 4 + (sub >> 1)) * 64 + (sub & 1) * 32 + nn) * 8) = o; }
        }
    }
    {
        const int dim = tid & 63, tq = tid >> 6;
        for (int u = blk; u < 2 * NB * 2 * 128; u += G) {
            const int which = u >> 10, b = (u >> 8) & 3, g = (u >> 7) & 1, ch = u & 127;
            const bf16* src = proj + ((size_t)b * T + ch * 64 + 8 * tq) * PC + (which ? C_VW : C_VS) + 64 * g + dim;
            unsigned short v[8];
#pragma unroll
            for (int i = 0; i < 8; ++i) v[i] = src[(size_t)i * PC];
            u32x4 o; o.x = v[0] | ((unsigned)v[1] << 16); o.y = v[2] | ((unsigned)v[3] << 16); o.z = v[4] | ((unsigned)v[5] << 16); o.w = v[6] | ((unsigned)v[7] << 16);
            { const int t8 = ch * 64 + 8 * tq, tile = t8 >> 5, ko = t8 & 31;
                *(u32x4*)((bf16*)(a.ws + (which ? WS_VWT : WS_VST)) + (size_t)(b * 2 + g) * 64 * T + ((size_t)((tile * 2 + (ko >> 4)) * 2 + (dim >> 5)) * 64 + ((ko >> 3) & 1) * 32 + (dim & 31)) * 8) = o; }
        }
    }
    {
        const float* kg0 = a.in[4] + l * 192;
        const float* cbias = (const float*)(a.ws + WS_CTL) + CW_CBIAS + l * 128;
        float* red = (float*)lds;
        const int n = lane & 31, h = lane >> 5;
        for (int u = blk; u < 2 * NB * 2 * 16; u += G) {
            const int which = u >> 7, b = (u >> 5) & 3, g = (u >> 4) & 1, rt = u & 15;
            const bf16* arow = proj + ((size_t)b * T + 16 * (32 * rt + n) + 4 * wave) * PC + (which ? C_VC : C_KC) + g * 64 + 8 * h;
            const bf16* wt = (const bf16*)(a.ws + WS_WCT) + ((size_t)(l * 2 + which) * 64 + n) * 2048 + 256 * wave + 8 * h;
            f32x16 acc0, acc1;
#pragma unroll
            for (int i = 0; i < 16; ++i) { acc0[i] = 0.f; acc1[i] = 0.f; }
#pragma unroll
            for (int ks = 0; ks < 16; ++ks) {
                const bf16x8 af = *(const bf16x8*)(arow + (size_t)(ks >> 2) * PC + 16 * (ks & 3));
                const bf16x8 b0 = *(const bf16x8*)(wt + 16 * ks), b1 = *(const bf16x8*)(wt + 32 * 2048 + 16 * ks);
                acc0 = __builtin_amdgcn_mfma_f32_32x32x16_bf16(af, b0, acc0, 0, 0, 0); acc1 = __builtin_amdgcn_mfma_f32_32x32x16_bf16(af, b1, acc1, 0, 0, 0);
            }
            __syncthreads();
#pragma unroll
            for (int i = 0; i < 16; ++i) { const int row = 8 * (i >> 2) + 4 * h + (i & 3); red[(wave * 32 + row) * 64 + n] = acc0[i]; red[(wave * 32 + row) * 64 + 32 + n] = acc1[i]; }
            __syncthreads();
            { const int row = tid >> 4, n4 = (tid & 15) * 4, c = 32 * rt + row;
                f32x4 sum = *(const f32x4*)(cbias + which * 64 + n4);
#pragma unroll
                for (int w = 0; w < 8; ++w) sum = sum + *(const f32x4*)(red + (w * 32 + row) * 64 + n4);
                if (which == 0) { float ss = sum.x * sum.x + sum.y * sum.y + sum.z * sum.z + sum.w * sum.w;
                    ss += __shfl_xor(ss, 1); ss += __shfl_xor(ss, 2); ss += __shfl_xor(ss, 4); ss += __shfl_xor(ss, 8);
                    const float rs = 1.f / sqrtf(ss * (1.f / 64.f) + EPS); const f32x4 gg = *(const f32x4*)(kg0 + n4); sum = sum * rs * gg; }
                if (c >= 511) sum = (f32x4){0.f, 0.f, 0.f, 0.f};
                u32x2 o; o.x = pk2(sum.x, sum.y); o.y = pk2(sum.z, sum.w);
                *(u32x2*)((bf16*)(a.ws + (which ? WS_VCMP : WS_KCMP)) + ((size_t)(b * 2 + g) * NCB + c) * 64 + n4) = o;
                const int ko = c & 31;
                if (which) {
                    bf16* dT = (bf16*)(a.ws + WS_VCT) + (size_t)(b * 2 + g) * 64 * NCB + ((size_t)(((c >> 5) * 2 + (ko >> 4)) * 2 + (n4 >> 5)) * 64 + ((ko >> 3) & 1) * 32 + (n4 & 31)) * 8 + (ko & 7);
                    dT[0] = (bf16)(o.x & 0xffffu); dT[8] = (bf16)(o.x >> 16); dT[16] = (bf16)(o.y & 0xffffu); dT[24] = (bf16)(o.y >> 16);
                } else {
                    const int nn = (ko & 0x13) | ((ko & 4) << 1) | ((ko & 8) >> 1);
                    *(u32x2*)((bf16*)(a.ws + WS_KCF) + (size_t)(b * 2 + g) * NCB * 64 + ((size_t)((c >> 5) * 4 + (n4 >> 4)) * 64 + ((n4 >> 3) & 1) * 32 + nn) * 8 + (n4 & 7)) = o; } }
        }
        __syncthreads();
    }
    {
        float* rets = (float*)(a.ws + WS_RETS);
        float* Ksf = (float*)lds;
        float* Vsf = Ksf + 128 * 32;
        const int d = tid >> 4, e4 = (tid & 15) * 4;
        for (int u = blk; u < NB * 8 * 64; u += G) {
            const int b = u >> 9, h = (u >> 6) & 7, c = u & 63;
            const float lg2 = log2f(1.f - exp2f(-5.f - (float)h));
            const bf16* base = proj + ((size_t)b * T + c * 128) * PC;
            __syncthreads();
            { const int row = tid >> 2, pc = tid & 3; const u32x4 uk = *(const u32x4*)(base + (size_t)row * PC + C_RK + 32 * h + 8 * pc); const float z = exp2f((float)(127 - row) * lg2);
                *(f32x4*)(Ksf + row * 32 + 8 * pc) = (f32x4){bflo(uk.x) * z, bfhi(uk.x) * z, bflo(uk.y) * z, bfhi(uk.y) * z};
                *(f32x4*)(Ksf + row * 32 + 8 * pc + 4) = (f32x4){bflo(uk.z) * z, bfhi(uk.z) * z, bflo(uk.w) * z, bfhi(uk.w) * z}; }
#pragma unroll
            for (int it = 0; it < 2; ++it) { const int idx = tid + NTHR * it, row = idx >> 3, pc = idx & 7; const u32x4 uv = *(const u32x4*)(base + (size_t)row * PC + C_RV + 64 * h + 8 * pc);
                *(f32x4*)(Vsf + row * 64 + 8 * pc) = (f32x4){bflo(uv.x), bfhi(uv.x), bflo(uv.y), bfhi(uv.y)};
                *(f32x4*)(Vsf + row * 64 + 8 * pc + 4) = (f32x4){bflo(uv.z), bfhi(uv.z), bflo(uv.w), bfhi(uv.w)}; }
            __syncthreads();
            f32x4 acc = (f32x4){0.f, 0.f, 0.f, 0.f};
#pragma unroll 8
            for (int j = 0; j < 128; ++j) { const float kz = Ksf[j * 32 + d]; acc = acc + *(const f32x4*)(Vsf + j * 64 + e4) * kz; }
            *(f32x4*)(rets + ((size_t)(b * 8 + h) * 64 + c) * 2048 + d * 64 + e4) = acc;
        }
        __syncthreads();
    }
}

__device__ __forceinline__ void scan_phase(const Args& a, int blk, int G, int tid) {
    float* rets = (float*)(a.ws + WS_RETS);
    if (tid < 256) {
        const int i = blk * 256 + tid;
        if (i < 32 * 2048) {
            const int bh = i >> 11, idx = i & 2047, h = bh & 7;
            const float gc = exp2f(128.f * log2f(1.f - exp2f(-5.f - (float)h)));
            float* p = rets + (size_t)bh * 64 * 2048 + idx;
            bf16* st = (bf16*)(a.ws + WS_RST) + (size_t)bh * 64 * 2048 + (idx & 63) * 32 + (idx >> 6);
            float tv[64];
#pragma unroll
            for (int c = 0; c < 64; ++c) tv[c] = p[(size_t)c * 2048];
            float S = 0.f;
#pragma unroll
            for (int c = 0; c < 64; ++c) { p[(size_t)c * 2048] = S; st[(size_t)c * 2048] = (bf16)f2bf(S); S = S * gc + tv[c]; }
        }
    }
}

__device__ __forceinline__ float dot32(const float (&q)[32], const bf16* kp) {
    const u32x4* p = (const u32x4*)kp; float s = 0.f;
#pragma unroll
    for (int i = 0; i < 4; ++i) { const u32x4 u = p[i];
        s += q[8 * i + 0] * bflo(u.x) + q[8 * i + 1] * bfhi(u.x) + q[8 * i + 2] * bflo(u.y) + q[8 * i + 3] * bfhi(u.y) + q[8 * i + 4] * bflo(u.z) + q[8 * i + 5] * bfhi(u.z) + q[8 * i + 6] * bflo(u.w) + q[8 * i + 7] * bfhi(u.w); }
    return s;
}
__device__ __forceinline__ float dot16(const float (&q)[16], const bf16* kp) {
    const u32x4* p = (const u32x4*)kp; float s = 0.f;
#pragma unroll
    for (int i = 0; i < 2; ++i) { const u32x4 u = p[i];
        s += q[8 * i + 0] * bflo(u.x) + q[8 * i + 1] * bfhi(u.x) + q[8 * i + 2] * bflo(u.y) + q[8 * i + 3] * bfhi(u.y) + q[8 * i + 4] * bflo(u.z) + q[8 * i + 5] * bfhi(u.z) + q[8 * i + 6] * bflo(u.w) + q[8 * i + 7] * bfhi(u.w); }
    return s;
}
__device__ __forceinline__ void axpy16(float (&o)[16], float p, const bf16* vp) {
    const u32x4* q = (const u32x4*)vp;
#pragma unroll
    for (int i = 0; i < 2; ++i) { const u32x4 u = q[i];
        o[8 * i + 0] += p * bflo(u.x); o[8 * i + 1] += p * bfhi(u.x); o[8 * i + 2] += p * bflo(u.y); o[8 * i + 3] += p * bfhi(u.y); o[8 * i + 4] += p * bflo(u.z); o[8 * i + 5] += p * bfhi(u.z); o[8 * i + 6] += p * bflo(u.w); o[8 * i + 7] += p * bfhi(u.w); }
}
__device__ __forceinline__ void nsa_phase(const Args& a, unsigned char* lds, int blk, int G, int tid) {
    const bf16* proj = (const bf16*)(a.ws + WS_PROJ);
    const float* gates = (const float*)(a.ws + WS_GATES);
    bf16* mix = (bf16*)(a.ws + WS_HN);
    float* impH = (float*)lds;
    unsigned* selm = (unsigned*)(lds + SELM_OFF);
    const int tl = tid >> 4, r = (tid >> 2) & 3, qt = tid & 3;
    for (int u = blk; u < NB * 2 * 256; u += G) {
        const int b = u >> 9, g = (u >> 8) & 1, tb = u & 255, cur = tb >> 1;
        const int hq = 4 * g + r, t = 32 * tb + tl; const size_t m = (size_t)b * T + t;
        const float slope = exp2f(-(float)(hq + 1)) * LOG2E;
        float q[16], res[16], o[16];
        { const u32x4* p = (const u32x4*)(proj + m * PC + C_Q + 64 * hq + 16 * qt);
#pragma unroll
            for (int i = 0; i < 2; ++i) { const u32x4 uu = p[i]; q[8 * i] = bflo(uu.x); q[8 * i + 1] = bfhi(uu.x); q[8 * i + 2] = bflo(uu.y); q[8 * i + 3] = bfhi(uu.y); q[8 * i + 4] = bflo(uu.z); q[8 * i + 5] = bfhi(uu.z); q[8 * i + 6] = bflo(uu.w); q[8 * i + 7] = bfhi(uu.w); } }
#pragma unroll
        for (int i = 0; i < 16; ++i) res[i] = 0.f;
        const float g0 = gates[m * 24 + 3 * hq], g1 = gates[m * 24 + 3 * hq + 1], g2 = gates[m * 24 + 3 * hq + 2];
        float* myimp = impH + (tl * 4 + r) * 128;
        for (int s = 32 * qt; s < 32 * qt + 32; ++s) myimp[s] = 0.f;
        if (tid < 128) selm[tid] = 0u;
        __syncthreads();
        const int ncv = t >= 31 ? ((t - 31) >> 4) + 1 : 0;
        const bf16* kc = (const bf16*)(a.ws + WS_KCMP) + (size_t)(b * 2 + g) * NCB * 64 + 16 * qt;
        const bf16* vc = (const bf16*)(a.ws + WS_VCMP) + (size_t)(b * 2 + g) * NCB * 64 + 16 * qt;
        float mx = -1e30f, lsum = 0.f;
        for (int c = 0; c < ncv; ++c) {
            float s = dot16(q, kc + c * 64); s += __shfl_xor(s, 1); s += __shfl_xor(s, 2); s -= slope * (float)(t - 16 * c - 31);
            const float mn = fmaxf(mx, s); lsum = lsum * exp2f(mx - mn) + exp2f(s - mn); mx = mn;
        }
        const float il = 1.f / lsum;
        for (int c = 0; c < ncv; ++c) {
            float s = dot16(q, kc + c * 64); s += __shfl_xor(s, 1); s += __shfl_xor(s, 2); s -= slope * (float)(t - 16 * c - 31);
            const float p = exp2f(s - mx) * il;
            axpy16(res, g0 * p, vc + c * 64);
            if (qt == 0) { const int sb = c >> 2; if ((c & 3) == 3) { myimp[sb] += 0.5f * p; if (sb + 1 < 128) myimp[sb + 1] += 0.5f * p; } else myimp[sb] += p; }
        }
        __syncthreads();
        for (int idx = tid; idx < 32 * 128; idx += NTHR) {
            const int tl2 = idx >> 7, s = idx & 127; float* p = impH + tl2 * 512 + s;
            const float v = (p[0] + p[128]) + (p[256] + p[384]);
            const bool forced = (s == 0) || (s == cur) || (s == cur - 1), valid = s <= cur;
            p[0] = forced ? 1e9f : (valid ? v : -1e9f);
        }
        __syncthreads();
        { const int k16 = tid & 15; const float* val = impH + tl * 512; unsigned bits = 0u;
#pragma unroll 1
            for (int ii = 0; ii < 8; ++ii) { const int i = 8 * k16 + ii; const float vi = val[i]; int rank = 0;
#pragma unroll 4
                for (int j = 0; j < 128; ++j) { const float vj = val[j]; rank += ((vj > vi) || (vj == vi && j < i)) ? 1 : 0; }
                if (rank < 16 && i <= cur) bits |= 1u << ii; }
            atomicOr(&selm[tl * 4 + (k16 >> 2)], bits << (8 * (k16 & 3))); }
        __syncthreads();
        {
            const bf16* kb = proj + (size_t)b * T * PC + C_KS + 64 * g + 16 * qt; const bf16* vb = proj + (size_t)b * T * PC + C_VS + 64 * g + 16 * qt;
            mx = -1e30f; lsum = 0.f;
#pragma unroll
            for (int i = 0; i < 16; ++i) o[i] = 0.f;
            for (int w = 0; w < 4; ++w) { unsigned word = selm[tl * 4 + w];
                while (word) { const int bit = __ffs(word) - 1; word &= word - 1u; const int sblk = 32 * w + bit;
                    const int pend = min(64 * sblk + 63, t);
                    for (int pos = 64 * sblk; pos <= pend; ++pos) {
                        float s = dot16(q, kb + (size_t)pos * PC); s += __shfl_xor(s, 1); s += __shfl_xor(s, 2); s -= slope * (float)(t - pos);
                        const float mn = fmaxf(mx, s), cr = exp2f(mx - mn), p = exp2f(s - mn); lsum = lsum * cr + p; mx = mn;
#pragma unroll
                        for (int i = 0; i < 16; ++i) o[i] *= cr;
                        axpy16(o, p, vb + (size_t)pos * PC);
                    } } }
            const float sc = g1 / lsum;
#pragma unroll
            for (int i = 0; i < 16; ++i) res[i] += sc * o[i];
        }
        {
            const bf16* kb = proj + (size_t)b * T * PC + C_KW + 64 * g + 16 * qt; const bf16* vb = proj + (size_t)b * T * PC + C_VW + 64 * g + 16 * qt;
            mx = -1e30f; lsum = 0.f;
#pragma unroll
            for (int i = 0; i < 16; ++i) o[i] = 0.f;
            for (int pos = max(0, t - 511); pos <= t; ++pos) {
                float s = dot16(q, kb + (size_t)pos * PC); s += __shfl_xor(s, 1); s += __shfl_xor(s, 2); s -= slope * (float)(t - pos);
                const float mn = fmaxf(mx, s), cr = exp2f(mx - mn), p = exp2f(s - mn); lsum = lsum * cr + p; mx = mn;
#pragma unroll
                for (int i = 0; i < 16; ++i) o[i] *= cr;
                axpy16(o, p, vb + (size_t)pos * PC);
            }
            const float sc = g2 / lsum;
#pragma unroll
            for (int i = 0; i < 16; ++i) res[i] += sc * o[i];
        }
        { u32x4* op = (u32x4*)(mix + m * D + 64 * hq + 16 * qt);
#pragma unroll
            for (int i = 0; i < 2; ++i) { u32x4 w; w.x = pk2(res[8 * i], res[8 * i + 1]); w.y = pk2(res[8 * i + 2], res[8 * i + 3]); w.z = pk2(res[8 * i + 4], res[8 * i + 5]); w.w = pk2(res[8 * i + 6], res[8 * i + 7]); op[i] = w; } }
        __syncthreads();
    }
}
#define MFMA32(a, b, c) __builtin_amdgcn_mfma_f32_32x32x16_bf16(a, b, c, 0, 0, 0)
constexpr float NSA_NEG = -1e30f;
__device__ __forceinline__ float ex2(float x) { return __builtin_amdgcn_exp2f(x); }
typedef __amdgpu_buffer_rsrc_t brsrc_t;
__device__ __forceinline__ brsrc_t nsa_rsrc(const bf16* base, int nbytes) { return __builtin_amdgcn_make_buffer_rsrc((void*)base, (short)0, nbytes, 0x00020000); }
__device__ __forceinline__ void nsa_ldk(bf16x8 (&kf)[4], brsrc_t rs, int tile, unsigned voff) {
#pragma unroll
    for (int ks = 0; ks < 4; ++ks) kf[ks] = __builtin_bit_cast(bf16x8, __builtin_amdgcn_raw_buffer_load_b128(rs, voff + 1024u * ks, tile * 4096, 0));
}
__device__ __forceinline__ void nsa_ldv(bf16x8 (&vf)[4], brsrc_t rs, int tile, unsigned voff) {
#pragma unroll
    for (int q = 0; q < 4; ++q) vf[q] = __builtin_bit_cast(bf16x8, __builtin_amdgcn_raw_buffer_load_b128(rs, voff + 1024u * q, tile * 4096, 0));
}
__device__ __forceinline__ void nsa_qk(const bf16x8 (&kf)[4], const bf16x8 (&qf)[4], const bf16x8& kaug, unsigned slpk, float c, f32x16& u) {
    f32x16 acc;
#pragma unroll
    for (int i = 0; i < 16; ++i) acc[i] = 0.f;
    const unsigned hp = pk2(c, c); const float hif = bflo(hp);
    u32x4 w; w.x = slpk; w.y = pk2(hif, c - hif); w.z = 0u; w.w = 0u;
    acc = MFMA32(kaug, __builtin_bit_cast(bf16x8, w), acc);
#pragma unroll
    for (int ks = 0; ks < 4; ++ks) acc = MFMA32(kf[ks], qf[ks], acc);
    u = acc;
}
__device__ __forceinline__ void nsa_qk2(const bf16x8 (&kA)[4], const bf16x8 (&kB)[4], const bf16x8 (&qf)[4], const bf16x8& kaug, unsigned slpk, float cA, float cB, f32x16& uA, f32x16& uB) {
    f32x16 a0, a1;
#pragma unroll
    for (int i = 0; i < 16; ++i) { a0[i] = 0.f; a1[i] = 0.f; }
    u32x4 wA, wB;
    { const unsigned hp = pk2(cA, cA); const float hif = bflo(hp); wA.x = slpk; wA.y = pk2(hif, cA - hif); wA.z = 0u; wA.w = 0u; }
    { const unsigned hp = pk2(cB, cB); const float hif = bflo(hp); wB.x = slpk; wB.y = pk2(hif, cB - hif); wB.z = 0u; wB.w = 0u; }
    a0 = MFMA32(kaug, __builtin_bit_cast(bf16x8, wA), a0); a1 = MFMA32(kaug, __builtin_bit_cast(bf16x8, wB), a1);
#pragma unroll
    for (int ks = 0; ks < 4; ++ks) { a0 = MFMA32(kA[ks], qf[ks], a0); a1 = MFMA32(kB[ks], qf[ks], a1); }
    uA = a0; uB = a1;
}
__device__ __forceinline__ void nsa_mask(f32x16& u, int kminp, int kmaxp) {
#pragma unroll
    for (int i = 0; i < 16; ++i) { const int c = 16 * (i >> 3) + (i & 7); u[i] = (c >= kminp && c <= kmaxp) ? u[i] : NSA_NEG; }
}
__device__ __forceinline__ bf16x8 nsa_pack8(const f32x16& p, int j) {
    u32x4 w; w.x = pk2(p[8 * j], p[8 * j + 1]); w.y = pk2(p[8 * j + 2], p[8 * j + 3]); w.z = pk2(p[8 * j + 4], p[8 * j + 5]); w.w = pk2(p[8 * j + 6], p[8 * j + 7]);
    return __builtin_bit_cast(bf16x8, w);
}
__device__ __forceinline__ void nsa_pv(const bf16x8 (&vf)[4], const f32x16& p, f32x16 (&O)[2]) {
#pragma unroll
    for (int j = 0; j < 2; ++j) { const bf16x8 pb = nsa_pack8(p, j);
#pragma unroll
        for (int dt = 0; dt < 2; ++dt) O[dt] = MFMA32(vf[2 * j + dt], pb, O[dt]); }
}
__device__ __forceinline__ void nsa_expv(const f32x16& u, f32x16& p, float& lpart, f32x16 (&O)[2], const bf16x8 (&vf)[4]) {
    float lt = 0.f;
#pragma unroll
    for (int i = 0; i < 8; ++i) { p[i] = ex2(u[i]); lt += p[i]; }
    { const bf16x8 pb = nsa_pack8(p, 0); O[0] = MFMA32(vf[0], pb, O[0]); O[1] = MFMA32(vf[1], pb, O[1]); }
    __builtin_amdgcn_sched_barrier(0);
#pragma unroll
    for (int i = 8; i < 16; ++i) { p[i] = ex2(u[i]); lt += p[i]; }
    { const bf16x8 pb = nsa_pack8(p, 1); O[0] = MFMA32(vf[2], pb, O[0]); O[1] = MFMA32(vf[3], pb, O[1]); }
    lpart += lt;
}
struct SlcIt { unsigned w[4]; int sblk, half; };
__device__ __forceinline__ int slc_next(SlcIt& it, int tmax) {
    if (it.half == 1) { it.half = 0; return 64 * it.sblk; }
    int wi = it.w[3] ? 3 : it.w[2] ? 2 : it.w[1] ? 1 : it.w[0] ? 0 : -1;
    if (wi < 0) return -1;
    const unsigned word = wi == 3 ? it.w[3] : wi == 2 ? it.w[2] : wi == 1 ? it.w[1] : it.w[0];
    const int bit = 31 - __builtin_clz(word); const unsigned nw = word & ~(1u << bit);
    if (wi == 3) it.w[3] = nw; else if (wi == 2) it.w[2] = nw; else if (wi == 1) it.w[1] = nw; else it.w[0] = nw;
    it.sblk = 32 * wi + bit;
    if (64 * it.sblk + 32 <= tmax) { it.half = 1; return 64 * it.sblk + 32; }
    it.half = 0; return 64 * it.sblk;
}
__device__ __forceinline__ void nsa_res(float* resL, unsigned voff, const f32x16 (&O)[2], float sc, bool first) {
#pragma unroll
    for (int q = 0; q < 8; ++q) { f32x4* p = (f32x4*)((char*)resL + q * 1024 + voff);
        const f32x4 o = (f32x4){O[q >> 2][4 * (q & 3)], O[q >> 2][4 * (q & 3) + 1], O[q >> 2][4 * (q & 3) + 2], O[q >> 2][4 * (q & 3) + 3]} * sc;
        *p = first ? o : (*p + o);
        if (q & 1) asm volatile("" ::: "memory"); }
}
__device__ __forceinline__ bf16x8 nsa_kaug(unsigned kapk, int h) { u32x4 w; w.x = kapk; w.y = h ? 0u : 0x3f803f80u; w.z = 0u; w.w = 0u; return __builtin_bit_cast(bf16x8, w); }
__device__ __forceinline__ void nsa_fast_phase(const Args& a, unsigned char* lds, int l, int blk, int G, int wave) {
    const bf16* proj = (const bf16*)(a.ws + WS_PROJ);
    const float* gates = (const float*)(a.ws + WS_GATES);
    bf16* mix = (bf16*)(a.ws + WS_HN);
    const int lane = lane_id(), n = lane & 31, h = lane >> 5, tq = n >> 2, r = n & 3;
    const int krow = (n & 0x13) | ((n & 4) << 1) | ((n & 8) >> 1);
    const unsigned voff = (unsigned)lane * 16u;
    float* imp = (float*)lds + wave * (8 * 128);
    float* resL = (float*)(lds + 32768) + wave * 2048;
    unsigned* selw = (unsigned*)(lds + SELM_OFF) + wave * 32;
    const unsigned kapk = h ? 0u : pk2((float)krow, (float)krow);
#define kaug nsa_kaug(kapk, h)
    float gmax; { const float* kg = a.in[4] + l * 192; gmax = fmaxf(fmaxf(fabsf(kg[lane]), fabsf(kg[64 + lane])), fabsf(kg[128 + lane]));
#pragma unroll
        for (int o = 1; o < 64; o <<= 1) gmax = fmaxf(gmax, __shfl_xor(gmax, o));
        gmax = __builtin_bit_cast(float, __builtin_amdgcn_readfirstlane(__builtin_bit_cast(int, gmax))); }
    for (int u = blk; u < NB * 2 * 128; u += G) {
        int b, g, tb;
        if (G == 256) { const int k = u >> 8, j = blk >> 3;
            b = (blk & 7) >> 1; g = (blk & 1) ^ (k & 1); tb = (k & 1) ? (k == 1 ? 63 - j : 127 - j) : (k == 0 ? j : 64 + j); }
        else { b = u >> 8; g = (u >> 7) & 1; tb = ((u & 127) + 32 * (u >> 8)) & 127; }
        const int hq = 4 * g + r, t0 = 64 * tb + 8 * wave, t = t0 + tq;
#define m ((size_t)b * T + t)
        const float sl2 = ex2(-(float)(hq + 1)) * LOG2E;
        bf16x8 qf[4];
#pragma unroll
        for (int ks = 0; ks < 4; ++ks) qf[ks] = *(const bf16x8*)(proj + m * PC + C_Q + 64 * hq + 16 * ks + 8 * h);
        float Ccol; { float qq = 0.f;
#pragma unroll
            for (int ks = 0; ks < 4; ++ks) { const u32x4 w = __builtin_bit_cast(u32x4, qf[ks]);
                qq += bflo(w.x) * bflo(w.x) + bfhi(w.x) * bfhi(w.x) + bflo(w.y) * bflo(w.y) + bfhi(w.y) * bfhi(w.y) + bflo(w.z) * bflo(w.z) + bfhi(w.z) * bfhi(w.z) + bflo(w.w) * bflo(w.w) + bfhi(w.w) * bfhi(w.w); }
            qq += __shfl_xor(qq, 32); Ccol = sqrtf(qq) * 8.f * gmax; }
        unsigned slpk1, slpk16; { const unsigned hp = pk2(sl2, sl2); const float hif = bflo(hp); slpk1 = pk2(hif, sl2 - hif); const float s16 = 16.f * sl2; const unsigned hq2 = pk2(s16, s16); const float h2 = bflo(hq2); slpk16 = pk2(h2, s16 - h2); }
        f32x16 O[2];
#pragma unroll
        for (int i = 0; i < 16; ++i) imp[lane + 64 * i] = 0.f;
        if (lane < 32) selw[lane] = 0u;
        bf16x8 kA[4], kB[4], vA[4], vB[4];
        {
            const brsrc_t KC = nsa_rsrc((const bf16*)(a.ws + WS_KCF) + (size_t)(b * 2 + g) * NCB * 64, NCB * 64 * 2);
            const brsrc_t VCT = nsa_rsrc((const bf16*)(a.ws + WS_VCT) + (size_t)(b * 2 + g) * 64 * NCB, NCB * 64 * 2);
            const int ncv = t >= 31 ? ((t - 31) >> 4) + 1 : 0;
            const int tmax = t0 + 7, ncvmax = tmax >= 31 ? ((tmax - 31) >> 4) + 1 : 0, nct = (ncvmax + 31) >> 5;
            const float c0 = sl2 * (float)(31 - t) - Ccol, c1 = sl2 * 512.f;
            float lp = 0.f;
#define CMP_A(KF, TI) do { f32x16 uu; nsa_qk(KF, qf, kaug, slpk16, c0 + (float)(TI) * c1, uu); \
                if ((TI) == nct - 1) nsa_mask(uu, -1000, ncv - 1 - 32 * (TI) - 8 * h); \
                float lt = 0.f; _Pragma("unroll") for (int i = 0; i < 16; ++i) lt += ex2(uu[i]); lp += lt; } while (0)
            if (nct > 0) nsa_ldk(kA, KC, 0, voff);
            for (int ti = 0; ti < nct; ti += 2) {
                if (ti + 1 < nct) nsa_ldk(kB, KC, ti + 1, voff);
                CMP_A(kA, ti);
                if (ti + 1 >= nct) break;
                if (ti + 2 < nct) nsa_ldk(kA, KC, ti + 2, voff);
                CMP_A(kB, ti + 1);
            }
#undef CMP_A
            lp += __shfl_xor(lp, 32);
            const float cB = ncv > 0 ? c0 - __builtin_amdgcn_logf(lp) : -30000.f;
#pragma unroll
            for (int i = 0; i < 16; ++i) { O[0][i] = 0.f; O[1][i] = 0.f; }
            float dummy = 0.f;
#define CMP_B(KF, VF, TI) do { f32x16 uu; nsa_qk(KF, qf, kaug, slpk16, cB + (float)(TI) * c1, uu); \
                if ((TI) == nct - 1) nsa_mask(uu, -1000, ncv - 1 - 32 * (TI) - 8 * h); \
                f32x16 p; nsa_expv(uu, p, dummy, O, VF); \
                float av[4], bv[4]; \
                _Pragma("unroll") for (int q4 = 0; q4 < 4; ++q4) { const int i0 = 4 * q4; av[q4] = (p[i0] + p[i0 + 1]) + (p[i0 + 2] + 0.5f * p[i0 + 3]); bv[q4] = 0.5f * p[i0 + 3]; } \
                _Pragma("unroll") for (int q4 = 0; q4 < 4; ++q4) { av[q4] += dpp_xor1(av[q4]); av[q4] += dpp_xor2(av[q4]); bv[q4] += dpp_xor1(bv[q4]); bv[q4] += dpp_xor2(bv[q4]); } \
                const float am = r == 0 ? av[0] : r == 1 ? av[1] : r == 2 ? av[2] : av[3], bm = r == 0 ? bv[0] : r == 1 ? bv[1] : r == 2 ? bv[2] : bv[3]; \
                const int sb = 8 * (TI) + 4 * (r >> 1) + 2 * h + (r & 1); \
                atomicAdd(&imp[tq * 128 + sb], am); \
                if (sb + 1 < 128) atomicAdd(&imp[tq * 128 + sb + 1], bm); } while (0)
            if (nct > 0) { nsa_ldk(kA, KC, 0, voff); nsa_ldv(vA, VCT, 0, voff); }
            for (int ti = 0; ti < nct; ti += 2) {
                if (ti + 1 < nct) { nsa_ldk(kB, KC, ti + 1, voff); nsa_ldv(vB, VCT, ti + 1, voff); }
                CMP_B(kA, vA, ti);
                if (ti + 1 >= nct) break;
                if (ti + 2 < nct) { nsa_ldk(kA, KC, ti + 2, voff); nsa_ldv(vA, VCT, ti + 2, voff); }
                CMP_B(kB, vB, ti + 1);
            }
#undef CMP_B
            nsa_res(resL, voff, O, gates[m * 24 + 3 * hq], true);
        }
        {
            const int l2 = lane_id(), tk = l2 >> 3, k8 = l2 & 7, cur = tb;
            unsigned key[16];
#pragma unroll
            for (int k4 = 0; k4 < 4; ++k4) { const u32x4 x = *(const u32x4*)(imp + tk * 128 + 16 * k8 + 4 * k4); key[4 * k4] = x.x; key[4 * k4 + 1] = x.y; key[4 * k4 + 2] = x.z; key[4 * k4 + 3] = x.w; }
#pragma unroll
            for (int k = 0; k < 16; ++k) { const int s2 = 16 * k8 + k; const bool forced = (s2 == 0) || (s2 == cur) || (s2 == cur - 1), valid = s2 <= cur;
                const unsigned kv = ((key[k] & 0xFFFFFF80u) + 0x80u) | (unsigned)(127 - s2); key[k] = forced ? (0xFFFFFF00u | (unsigned)(127 - s2)) : (valid ? kv : 0u); }
#pragma unroll
            for (int kk = 2; kk <= 16; kk <<= 1)
#pragma unroll
                for (int jj = kk >> 1; jj > 0; jj >>= 1)
#pragma unroll
                    for (int i = 0; i < 16; ++i) { const int p = i ^ jj; if (p > i) { const unsigned a0 = key[i], a1 = key[p]; const unsigned hi = a0 > a1 ? a0 : a1, lo = a0 > a1 ? a1 : a0;
                        if ((i & kk) == 0) { key[i] = hi; key[p] = lo; } else { key[i] = lo; key[p] = hi; } } }
            unsigned bits = 0u;
#pragma unroll 1
            for (int it = 0; it < 16; ++it) {
                unsigned mk = key[0];
                { const unsigned o = (unsigned)__builtin_amdgcn_update_dpp(0, (int)mk, 0xB1, 0xf, 0xf, true); mk = o > mk ? o : mk; }
                { const unsigned o = (unsigned)__builtin_amdgcn_update_dpp(0, (int)mk, 0x4E, 0xf, 0xf, true); mk = o > mk ? o : mk; }
                { const unsigned o = (unsigned)__builtin_amdgcn_update_dpp(0, (int)mk, 0x141, 0xf, 0xf, true); mk = o > mk ? o : mk; }
                const bool own = (key[0] == mk) && (mk != 0u);
                bits |= own ? (1u << ((127u - (mk & 127u)) & 15u)) : 0u;
#pragma unroll
                for (int i = 0; i < 15; ++i) key[i] = own ? key[i + 1] : key[i];
                key[15] = own ? 0u : key[15];
            }
            atomicOr(&selw[tk * 4 + (k8 >> 1)], bits << (16 * (k8 & 1)));
        }
        {
            const brsrc_t KS = nsa_rsrc((const bf16*)(a.ws + WS_KS) + (size_t)(b * 2 + g) * T * 64, T * 64 * 2);
            const brsrc_t VST = nsa_rsrc((const bf16*)(a.ws + WS_VST) + (size_t)(b * 2 + g) * 64 * T, T * 64 * 2);
            float lp = 0.f;
#pragma unroll
            for (int i = 0; i < 16; ++i) { O[0][i] = 0.f; O[1][i] = 0.f; }
            SlcIt it; it.half = 0; it.sblk = 0;
#pragma unroll
            for (int w = 0; w < 4; ++w) { unsigned uw = selw[(lane & 7) * 4 + w]; uw |= __shfl_xor(uw, 1); uw |= __shfl_xor(uw, 2); uw |= __shfl_xor(uw, 4); it.w[w] = (unsigned)__builtin_amdgcn_readfirstlane((int)uw); }
            const float cS = -sl2 * (float)t - Ccol;
#define SLC_C(PP, SB) (((selw[tq * 4 + ((SB) >> 5)] >> ((SB) & 31)) & 1u) ? cS + sl2 * (float)(PP) : -30000.f)
#define SLC_M(UU, PP) do { if ((PP) + 31 > t0) nsa_mask(UU, -1000, t - (PP) - 8 * h); } while (0)
            int P0 = slc_next(it, t0 + 7), sb0 = it.sblk;
            int P1 = P0 >= 0 ? slc_next(it, t0 + 7) : -1, sb1 = it.sblk;
            if (P0 >= 0) { nsa_ldk(kA, KS, P0 >> 5, voff); nsa_ldv(vA, VST, P0 >> 5, voff); }
            if (P1 >= 0) { nsa_ldk(kB, KS, P1 >> 5, voff); nsa_ldv(vB, VST, P1 >> 5, voff); }
            while (P0 >= 0) {
                const int P2 = P1 >= 0 ? slc_next(it, t0 + 7) : -1, sb2 = it.sblk;
                const int P3 = P2 >= 0 ? slc_next(it, t0 + 7) : -1, sb3 = it.sblk;
                f32x16 uA, uB, p;
                if (P1 >= 0) {
                    nsa_qk2(kA, kB, qf, kaug, slpk1, SLC_C(P0, sb0), SLC_C(P1, sb1), uA, uB);
                    if (P2 >= 0) nsa_ldk(kA, KS, P2 >> 5, voff);
                    if (P3 >= 0) nsa_ldk(kB, KS, P3 >> 5, voff);
                    SLC_M(uA, P0); SLC_M(uB, P1);
                    nsa_expv(uA, p, lp, O, vA);
                    if (P2 >= 0) nsa_ldv(vA, VST, P2 >> 5, voff);
                    nsa_expv(uB, p, lp, O, vB);
                    if (P3 >= 0) nsa_ldv(vB, VST, P3 >> 5, voff);
                } else {
                    nsa_qk(kA, qf, kaug, slpk1, SLC_C(P0, sb0), uA);
                    SLC_M(uA, P0);
                    nsa_expv(uA, p, lp, O, vA);
                }
                P0 = P2; sb0 = sb2; P1 = P3; sb1 = sb3;
            }
#undef SLC_C
#undef SLC_M
#define SLC_T(KF, VF, PP, SB)
#undef SLC_T
            lp += __shfl_xor(lp, 32);
            nsa_res(resL, voff, O, gates[m * 24 + 3 * hq + 1] * __builtin_amdgcn_rcpf(lp), false);
        }
        {
            const brsrc_t KW = nsa_rsrc((const bf16*)(a.ws + WS_KW) + (size_t)(b * 2 + g) * T * 64, T * 64 * 2);
            const brsrc_t VWT = nsa_rsrc((const bf16*)(a.ws + WS_VWT) + (size_t)(b * 2 + g) * 64 * T, T * 64 * 2);
            float lp = 0.f;
#pragma unroll
            for (int i = 0; i < 16; ++i) { O[0][i] = 0.f; O[1][i] = 0.f; }
            const int thi = (t0 + 7) >> 5, tlo = (t0 - 511) > 0 ? ((t0 - 511) >> 5) : 0;
            const float cS = -sl2 * (float)t - Ccol;
#define WIN_M(UU, PP) do { if ((PP) + 31 > t0 || (PP) < t0 + 7 - 511) nsa_mask(UU, t - 511 - (PP) - 8 * h, t - (PP) - 8 * h); } while (0)
            nsa_ldk(kA, KW, thi, voff); nsa_ldv(vA, VWT, thi, voff);
            if (thi - 1 >= tlo) { nsa_ldk(kB, KW, thi - 1, voff); nsa_ldv(vB, VWT, thi - 1, voff); }
#pragma unroll 1
            for (int ti = thi; ti >= tlo; ti -= 2) {
                f32x16 uA, uB, p;
                if (ti - 1 >= tlo) {
                    nsa_qk2(kA, kB, qf, kaug, slpk1, cS + sl2 * (float)(32 * ti), cS + sl2 * (float)(32 * ti - 32), uA, uB);
                    if (ti - 2 >= tlo) nsa_ldk(kA, KW, ti - 2, voff);
                    if (ti - 3 >= tlo) nsa_ldk(kB, KW, ti - 3, voff);
                    WIN_M(uA, 32 * ti); WIN_M(uB, 32 * ti - 32);
                    nsa_expv(uA, p, lp, O, vA);
                    if (ti - 2 >= tlo) nsa_ldv(vA, VWT, ti - 2, voff);
                    nsa_expv(uB, p, lp, O, vB);
                    if (ti - 3 >= tlo) nsa_ldv(vB, VWT, ti - 3, voff);
                } else {
                    nsa_qk(kA, qf, kaug, slpk1, cS + sl2 * (float)(32 * ti), uA);
                    WIN_M(uA, 32 * ti);
                    nsa_expv(uA, p, lp, O, vA);
                }
            }
#undef WIN_M
#define WIN_T(KF, VF, TI)
#undef WIN_T
            lp += __shfl_xor(lp, 32);
            nsa_res(resL, voff, O, gates[m * 24 + 3 * hq + 2] * __builtin_amdgcn_rcpf(lp), false);
        }
        { const int l3 = lane_id(), n3 = l3 & 31, h3 = l3 >> 5; const size_t m3 = (size_t)b * T + t0 + (n3 >> 2); const int hq3 = 4 * g + (n3 & 3);
#pragma unroll
            for (int q = 0; q < 8; ++q) { const f32x4 o = *(const f32x4*)(resL + (q * 64 + l3) * 4); u32x2 w; w.x = pk2(o.x, o.y); w.y = pk2(o.z, o.w);
                *(u32x2*)(mix + m3 * D + 64 * hq3 + 32 * (q >> 2) + 8 * (q & 3) + 4 * h3) = w; } }
    }
}
#undef kaug
#undef m

constexpr int NSA_RING_OFF = 98304, NSA_SLOT = 8192;
#define NSA_VMW(n) asm volatile("s_waitcnt vmcnt(" #n ")" ::: "memory")
__device__ __forceinline__ void nsa_dma(LAS unsigned char* ring, int slot, const bf16* Kb, const bf16* Vb, int tile, int wave, unsigned voff) {
    const char* src = (const char*)(wave < 4 ? Kb : Vb) + (size_t)tile * 4096 + (wave & 3) * 1024 + voff;
    __builtin_amdgcn_global_load_lds((const unsigned*)src, (LAS unsigned*)(ring + slot * NSA_SLOT + wave * 1024), 16, 0, 0);
}
__device__ __forceinline__ void nsa_frag(LAS unsigned char* ring, int slot, unsigned voff, bf16x8 (&kf)[4], bf16x8 (&vf)[4]) {
#pragma unroll
    for (int q = 0; q < 4; ++q) { kf[q] = *(const LAS bf16x8*)(ring + slot * NSA_SLOT + q * 1024 + voff); vf[q] = *(const LAS bf16x8*)(ring + slot * NSA_SLOT + 4096 + q * 1024 + voff); }
}
__device__ __forceinline__ void nsa_ls_phase(const Args& a, unsigned char* lds, int l, int blk, int G, int wave) {
    const bf16* proj = (const bf16*)(a.ws + WS_PROJ);
    const float* gates = (const float*)(a.ws + WS_GATES);
    bf16* mix = (bf16*)(a.ws + WS_HN);
    const int lane = lane_id(), n = lane & 31, h = lane >> 5, tq = n >> 2, r = n & 3;
    const int krow = (n & 0x13) | ((n & 4) << 1) | ((n & 8) >> 1);
    const unsigned voff = (unsigned)lane * 16u;
    float* imp = (float*)lds + wave * (8 * 128);
    float* resL = (float*)(lds + 32768) + wave * 2048;
    unsigned* selw = (unsigned*)(lds + SELM_OFF) + wave * 32;
    volatile unsigned* ubw = (volatile unsigned*)(lds + SELM_OFF + 1024);
    LAS unsigned char* ring = (LAS unsigned char*)lds + NSA_RING_OFF;
    const unsigned kapk = h ? 0u : pk2((float)krow, (float)krow);
#define kaug nsa_kaug(kapk, h)
    float gmax; { const float* kg = a.in[4] + l * 192; gmax = fmaxf(fmaxf(fabsf(kg[lane]), fabsf(kg[64 + lane])), fabsf(kg[128 + lane]));
#pragma unroll
        for (int o = 1; o < 64; o <<= 1) gmax = fmaxf(gmax, __shfl_xor(gmax, o));
        gmax = __builtin_bit_cast(float, __builtin_amdgcn_readfirstlane(__builtin_bit_cast(int, gmax))); }
    for (int u = blk; u < NB * 2 * 128; u += G) {
        const int b = u >> 8, g = (u >> 7) & 1, tb = ((u & 127) + 32 * (u >> 8)) & 127;
        const int hq = 4 * g + r, t0 = 64 * tb + 8 * wave, t = t0 + tq, tmaxB = 64 * tb + 63;
#define m ((size_t)b * T + t)
        const float sl2 = ex2(-(float)(hq + 1)) * LOG2E;
        bf16x8 qf[4];
#pragma unroll
        for (int ks = 0; ks < 4; ++ks) qf[ks] = *(const bf16x8*)(proj + m * PC + C_Q + 64 * hq + 16 * ks + 8 * h);
        float Ccol; { float qq = 0.f;
#pragma unroll
            for (int ks = 0; ks < 4; ++ks) { const u32x4 w = __builtin_bit_cast(u32x4, qf[ks]);
                qq += bflo(w.x) * bflo(w.x) + bfhi(w.x) * bfhi(w.x) + bflo(w.y) * bflo(w.y) + bfhi(w.y) * bfhi(w.y) + bflo(w.z) * bflo(w.z) + bfhi(w.z) * bfhi(w.z) + bflo(w.w) * bflo(w.w) + bfhi(w.w) * bfhi(w.w); }
            qq += __shfl_xor(qq, 32); Ccol = sqrtf(qq) * 8.f * gmax; }
        unsigned slpk1, slpk16; { const unsigned hp = pk2(sl2, sl2); const float hif = bflo(hp); slpk1 = pk2(hif, sl2 - hif); const float s16 = 16.f * sl2; const unsigned hq2 = pk2(s16, s16); const float h2 = bflo(hq2); slpk16 = pk2(h2, s16 - h2); }
        f32x16 O[2];
#pragma unroll
        for (int i = 0; i < 16; ++i) imp[lane + 64 * i] = 0.f;
        if (lane < 32) selw[lane] = 0u;
        if (wave == 0 && lane < 4) ubw[lane] = 0u;
        bf16x8 kc[4], vf[4];
#define NSA_WALK(KB, VB, NEXT, ...) do { \
            NSA_VMW(0); __builtin_amdgcn_s_barrier(); \
            int tA = NEXT, tB = tA >= 0 ? NEXT : -1, sl = 0; \
            if (tA >= 0) nsa_dma(ring, 0, KB, VB, tA, wave, voff); \
            if (tB >= 0) nsa_dma(ring, 1, KB, VB, tB, wave, voff); \
            while (tA >= 0) { \
                const int tC = tB >= 0 ? NEXT : -1; \
                if (tC >= 0) { nsa_dma(ring, (sl + 2) & 3, KB, VB, tC, wave, voff); NSA_VMW(2); } else if (tB >= 0) NSA_VMW(1); else NSA_VMW(0); \
                __builtin_amdgcn_s_barrier(); \
                { const int tile = tA; __VA_ARGS__ } \
                tA = tB; tB = tC; sl = (sl + 1) & 3; } } while (0)
        {
            const bf16* KC = (const bf16*)(a.ws + WS_KCF) + (size_t)(b * 2 + g) * NCB * 64;
            const bf16* VCT = (const bf16*)(a.ws + WS_VCT) + (size_t)(b * 2 + g) * 64 * NCB;
            const int ncv = t >= 31 ? ((t - 31) >> 4) + 1 : 0;
            const int tmax = t0 + 7, ncvmax = tmax >= 31 ? ((tmax - 31) >> 4) + 1 : 0, nct = (ncvmax + 31) >> 5;
            const int nctB = ((((tmaxB - 31) >> 4) + 1) + 31) >> 5;
            const float c0 = sl2 * (float)(31 - t) - Ccol, c1 = sl2 * 512.f;
            float lp = 0.f; int ci = 0;
            NSA_WALK(KC, VCT, (ci < nctB ? ci++ : -1), {
                if (tile < nct) { nsa_frag(ring, sl, voff, kc, vf);
                    f32x16 uu; nsa_qk(kc, qf, kaug, slpk16, c0 + (float)tile * c1, uu);
                    if (tile == nct - 1) nsa_mask(uu, -1000, ncv - 1 - 32 * tile - 8 * h);
                    float lt = 0.f; _Pragma("unroll") for (int i = 0; i < 16; ++i) lt += ex2(uu[i]); lp += lt; } });
            lp += __shfl_xor(lp, 32);
            const float cB = ncv > 0 ? c0 - __builtin_amdgcn_logf(lp) : -30000.f;
#pragma unroll
            for (int i = 0; i < 16; ++i) { O[0][i] = 0.f; O[1][i] = 0.f; }
            float dummy = 0.f; ci = 0;
            NSA_WALK(KC, VCT, (ci < nctB ? ci++ : -1), {
                if (tile < nct) { nsa_frag(ring, sl, voff, kc, vf);
                    f32x16 uu; nsa_qk(kc, qf, kaug, slpk16, cB + (float)tile * c1, uu);
                    if (tile == nct - 1) nsa_mask(uu, -1000, ncv - 1 - 32 * tile - 8 * h);
                    f32x16 p; nsa_expv(uu, p, dummy, O, vf);
                    float av[4], bv[4];
                    _Pragma("unroll") for (int q4 = 0; q4 < 4; ++q4) { const int i0 = 4 * q4; av[q4] = (p[i0] + p[i0 + 1]) + (p[i0 + 2] + 0.5f * p[i0 + 3]); bv[q4] = 0.5f * p[i0 + 3]; }
                    _Pragma("unroll") for (int q4 = 0; q4 < 4; ++q4) { av[q4] += dpp_xor1(av[q4]); av[q4] += dpp_xor2(av[q4]); bv[q4] += dpp_xor1(bv[q4]); bv[q4] += dpp_xor2(bv[q4]); }
                    const float am = r == 0 ? av[0] : r == 1 ? av[1] : r == 2 ? av[2] : av[3], bm = r == 0 ? bv[0] : r == 1 ? bv[1] : r == 2 ? bv[2] : bv[3];
                    const int sb = 8 * tile + 4 * (r >> 1) + 2 * h + (r & 1);
                    atomicAdd(&imp[tq * 128 + sb], am);
                    if (sb + 1 < 128) atomicAdd(&imp[tq * 128 + sb + 1], bm); } });
            nsa_res(resL, voff, O, gates[m * 24 + 3 * hq], true);
        }
        {
            const int l2 = lane_id(), tk = l2 >> 3, k8 = l2 & 7, cur = tb;
            float v[16];
#pragma unroll
            for (int k4 = 0; k4 < 4; ++k4) { const f32x4 x = *(const f32x4*)(imp + tk * 128 + 16 * k8 + 4 * k4); v[4 * k4] = x.x; v[4 * k4 + 1] = x.y; v[4 * k4 + 2] = x.z; v[4 * k4 + 3] = x.w; }
#pragma unroll
            for (int k = 0; k < 16; ++k) { const int s2 = 16 * k8 + k; const bool forced = (s2 == 0) || (s2 == cur) || (s2 == cur - 1), valid = s2 <= cur; v[k] = forced ? 1e9f : (valid ? v[k] : -1e9f); }
            unsigned bits = 0u;
#pragma unroll 1
            for (int it = 0; it < 16; ++it) {
                float bvv = v[0]; int bi = 0;
#pragma unroll
                for (int k = 1; k < 16; ++k) if (v[k] > bvv) { bvv = v[k]; bi = k; }
                bi += 16 * k8;
#define TK_STEP(CTRL) do { const float ov = __builtin_bit_cast(float, __builtin_amdgcn_update_dpp(0, __builtin_bit_cast(int, bvv), CTRL, 0xf, 0xf, true)); const int oi = __builtin_amdgcn_update_dpp(0, bi, CTRL, 0xf, 0xf, true); \
                    if (ov > bvv || (ov == bvv && oi < bi)) { bvv = ov; bi = oi; } } while (0)
                TK_STEP(0xB1); TK_STEP(0x4E); TK_STEP(0x141);
#undef TK_STEP
#pragma unroll
                for (int k = 0; k < 16; ++k) if (bi == 16 * k8 + k) { v[k] = -3e38f; if (16 * k8 + k <= cur) bits |= 1u << k; }
            }
            atomicOr(&selw[tk * 4 + (k8 >> 1)], bits << (16 * (k8 & 1)));
        }
        {
            const bf16* KS = (const bf16*)(a.ws + WS_KS) + (size_t)(b * 2 + g) * T * 64;
            const bf16* VST = (const bf16*)(a.ws + WS_VST) + (size_t)(b * 2 + g) * 64 * T;
            float lp = 0.f;
#pragma unroll
            for (int i = 0; i < 16; ++i) { O[0][i] = 0.f; O[1][i] = 0.f; }
            unsigned myu[4];
#pragma unroll
            for (int w = 0; w < 4; ++w) { unsigned uw = selw[(lane & 7) * 4 + w]; uw |= __shfl_xor(uw, 1); uw |= __shfl_xor(uw, 2); uw |= __shfl_xor(uw, 4); myu[w] = (unsigned)__builtin_amdgcn_readfirstlane((int)uw); }
            if (lane < 4) atomicOr((unsigned*)&ubw[lane], lane == 0 ? myu[0] : lane == 1 ? myu[1] : lane == 2 ? myu[2] : myu[3]);
            __builtin_amdgcn_s_waitcnt(0xc07f);
            __builtin_amdgcn_s_barrier();
            SlcIt it; it.half = 0; it.sblk = 0;
#pragma unroll
            for (int w = 0; w < 4; ++w) it.w[w] = (unsigned)__builtin_amdgcn_readfirstlane((int)ubw[w]);
            const float cS = -sl2 * (float)t - Ccol;
            NSA_WALK(KS, VST, (slc_next(it, tmaxB) >> 5), {
                const int PP = 32 * tile, sbk = tile >> 1;
                const unsigned wsel = (sbk >> 5) == 0 ? myu[0] : (sbk >> 5) == 1 ? myu[1] : (sbk >> 5) == 2 ? myu[2] : myu[3];
                if (((wsel >> (sbk & 31)) & 1u) && PP <= t0 + 7) { nsa_frag(ring, sl, voff, kc, vf);
                    const bool colsel = (selw[tq * 4 + (sbk >> 5)] >> (sbk & 31)) & 1u;
                    f32x16 uu; nsa_qk(kc, qf, kaug, slpk1, colsel ? cS + sl2 * (float)PP : -30000.f, uu);
                    if (PP + 31 > t0) nsa_mask(uu, -1000, t - PP - 8 * h);
                    f32x16 p; nsa_expv(uu, p, lp, O, vf); } });
            lp += __shfl_xor(lp, 32);
            nsa_res(resL, voff, O, gates[m * 24 + 3 * hq + 1] * __builtin_amdgcn_rcpf(lp), false);
        }
        {
            const bf16* KW = (const bf16*)(a.ws + WS_KW) + (size_t)(b * 2 + g) * T * 64;
            const bf16* VWT = (const bf16*)(a.ws + WS_VWT) + (size_t)(b * 2 + g) * 64 * T;
            float lp = 0.f;
#pragma unroll
            for (int i = 0; i < 16; ++i) { O[0][i] = 0.f; O[1][i] = 0.f; }
            const int thiB = tmaxB >> 5, tloB = (64 * tb - 511) > 0 ? ((64 * tb - 511) >> 5) : 0;
            const float cS = -sl2 * (float)t - Ccol;
            int wi = thiB;
            NSA_WALK(KW, VWT, (wi >= tloB ? wi-- : -1), {
                const int PP = 32 * tile;
                if (PP <= t0 + 7 && PP + 31 >= t0 - 511) { nsa_frag(ring, sl, voff, kc, vf);
                    f32x16 uu; nsa_qk(kc, qf, kaug, slpk1, cS + sl2 * (float)PP, uu);
                    if (PP + 31 > t0 || PP < t0 + 7 - 511) nsa_mask(uu, t - 511 - PP - 8 * h, t - PP - 8 * h);
                    f32x16 p; nsa_expv(uu, p, lp, O, vf); } });
            lp += __shfl_xor(lp, 32);
            nsa_res(resL, voff, O, gates[m * 24 + 3 * hq + 2] * __builtin_amdgcn_rcpf(lp), false);
        }
        { const int l3 = lane_id(), n3 = l3 & 31, h3 = l3 >> 5; const size_t m3 = (size_t)b * T + t0 + (n3 >> 2); const int hq3 = 4 * g + (n3 & 3);
#pragma unroll
            for (int q = 0; q < 8; ++q) { const f32x4 o = *(const f32x4*)(resL + (q * 64 + l3) * 4); u32x2 w; w.x = pk2(o.x, o.y); w.y = pk2(o.z, o.w);
                *(u32x2*)(mix + m3 * D + 64 * hq3 + 32 * (q >> 2) + 8 * (q & 3) + 4 * h3) = w; } }
    }
    NSA_VMW(0); __builtin_amdgcn_s_barrier();
}
#undef kaug
#undef m
#undef NSA_WALK

__device__ __forceinline__ void retout_phase(const Args& a, int l, int blk, int G, int tid) {
    const bf16* proj = (const bf16*)(a.ws + WS_PROJ);
    const float* rets = (const float*)(a.ws + WS_RETS);
    bf16* mix = (bf16*)(a.ws + WS_HN);
    const float* rng = a.in[7] + l * 512;
    const int i = tid >> 2, qd = tid & 3;
    for (int u = blk; u < NB * 8 * 64; u += G) {
        const int b = u >> 9, h = (u >> 6) & 7, c = u & 63;
        const float lg2 = log2f(1.f - exp2f(-5.f - (float)h));
        const bf16* base = proj + ((size_t)b * T + c * 128) * PC;
        float q[32], acc[16];
        { const u32x4* p = (const u32x4*)(base + (size_t)i * PC + C_RQ + 32 * h);
#pragma unroll
            for (int k = 0; k < 4; ++k) { const u32x4 uu = p[k]; q[8 * k] = bflo(uu.x); q[8 * k + 1] = bfhi(uu.x); q[8 * k + 2] = bflo(uu.y); q[8 * k + 3] = bfhi(uu.y); q[8 * k + 4] = bflo(uu.z); q[8 * k + 5] = bfhi(uu.z); q[8 * k + 6] = bflo(uu.w); q[8 * k + 7] = bfhi(uu.w); }
#pragma unroll
            for (int k = 0; k < 32; ++k) q[k] *= 0.17677669529663687f; }
#pragma unroll
        for (int k = 0; k < 16; ++k) acc[k] = 0.f;
        for (int j = 0; j <= i; ++j) {
            const float s = dot32(q, base + (size_t)j * PC + C_RK + 32 * h) * exp2f((float)(i - j) * lg2);
            const u32x4* vp = (const u32x4*)(base + (size_t)j * PC + C_RV + 64 * h + 16 * qd);
#pragma unroll
            for (int k = 0; k < 2; ++k) { const u32x4 uu = vp[k]; acc[8 * k] += s * bflo(uu.x); acc[8 * k + 1] += s * bfhi(uu.x); acc[8 * k + 2] += s * bflo(uu.y); acc[8 * k + 3] += s * bfhi(uu.y); acc[8 * k + 4] += s * bflo(uu.z); acc[8 * k + 5] += s * bfhi(uu.z); acc[8 * k + 6] += s * bflo(uu.w); acc[8 * k + 7] += s * bfhi(uu.w); }
        }
        { const float xi = exp2f((float)(i + 1) * lg2); const float* S = rets + ((size_t)(b * 8 + h) * 64 + c) * 2048 + 16 * qd;
#pragma unroll
            for (int d = 0; d < 32; ++d) { const float qx = q[d] * xi; const f32x4* sp = (const f32x4*)(S + d * 64);
#pragma unroll
                for (int k = 0; k < 4; ++k) { const f32x4 sv = sp[k]; acc[4 * k] += qx * sv.x; acc[4 * k + 1] += qx * sv.y; acc[4 * k + 2] += qx * sv.z; acc[4 * k + 3] += qx * sv.w; } } }
        float ss = 0.f;
#pragma unroll
        for (int k = 0; k < 16; ++k) ss += acc[k] * acc[k];
        ss += __shfl_xor(ss, 1); ss += __shfl_xor(ss, 2);
        const float rs = 1.f / sqrtf(ss * (1.f / 64.f) + EPS);
        const size_t m = (size_t)b * T + c * 128 + i;
        const u32x4* gp = (const u32x4*)(proj + m * PC + C_RG + 64 * h + 16 * qd);
        float y[16];
#pragma unroll
        for (int k = 0; k < 2; ++k) { const u32x4 uu = gp[k]; const float gg[8] = {bflo(uu.x), bfhi(uu.x), bflo(uu.y), bfhi(uu.y), bflo(uu.z), bfhi(uu.z), bflo(uu.w), bfhi(uu.w)};
#pragma unroll
            for (int z = 0; z < 8; ++z) { const float gz = gg[z]; y[8 * k + z] = acc[8 * k + z] * rs * rng[64 * h + 16 * qd + 8 * k + z] * (gz / (1.f + __expf(-gz))); } }
        u32x4* op = (u32x4*)(mix + m * D + 512 + 64 * h + 16 * qd);
#pragma unroll
        for (int k = 0; k < 2; ++k) { u32x4 w; w.x = pk2(y[8 * k], y[8 * k + 1]); w.y = pk2(y[8 * k + 2], y[8 * k + 3]); w.z = pk2(y[8 * k + 4], y[8 * k + 5]); w.w = pk2(y[8 * k + 6], y[8 * k + 7]); op[k] = w; }
    }
}

__device__ __forceinline__ void retout_fast_phase(const Args& a, unsigned char* lds, int l, int blk, int G, int wave) {
    const bf16* proj = (const bf16*)(a.ws + WS_PROJ);
    bf16* mix = (bf16*)(a.ws + WS_HN);
    const float* rng = a.in[7] + l * 512;
    const int lane = lane_id(), n = lane & 31, h = lane >> 5, tid = wave * 64 + lane, qt = wave & 3, dt = wave >> 2;
    const int krow = (n & 0x13) | ((n & 4) << 1) | ((n & 8) >> 1);
    bf16* Qs = (bf16*)lds;
    bf16* Ks = Qs + 128 * 32;
    bf16* VTs = Ks + 128 * 32;
    float* ssq = (float*)(lds + 8192 + 8192 + 64 * 136 * 2);
    for (int u = blk; u < NB * 8 * 64; u += G) {
        const int b = u >> 9, hh = (u >> 6) & 7, c = u & 63;
        const float lg2 = log2f(1.f - exp2f(-5.f - (float)hh));
        const size_t m0 = (size_t)b * T + c * 128;
        { const int row = tid >> 2, pc = tid & 3; const bf16* src = proj + (m0 + row) * PC + 32 * hh + 8 * pc;
            const u32x4 uq = *(const u32x4*)(src + C_RQ), uk = *(const u32x4*)(src + C_RK);
            const float sq = 0.17677669529663687f * exp2f((float)(row + 1) * lg2), sk = exp2f(-(float)(row + 1) * lg2);
            u32x4 o; o.x = pk2(bflo(uq.x) * sq, bfhi(uq.x) * sq); o.y = pk2(bflo(uq.y) * sq, bfhi(uq.y) * sq); o.z = pk2(bflo(uq.z) * sq, bfhi(uq.z) * sq); o.w = pk2(bflo(uq.w) * sq, bfhi(uq.w) * sq);
            *(u32x4*)(Qs + row * 32 + 8 * pc) = o;
            o.x = pk2(bflo(uk.x) * sk, bfhi(uk.x) * sk); o.y = pk2(bflo(uk.y) * sk, bfhi(uk.y) * sk); o.z = pk2(bflo(uk.z) * sk, bfhi(uk.z) * sk); o.w = pk2(bflo(uk.w) * sk, bfhi(uk.w) * sk);
            *(u32x4*)(Ks + row * 32 + 8 * pc) = o; }
#pragma unroll
        for (int it = 0; it < 2; ++it) { const int idx = tid + NTHR * it, row = idx >> 3, pc = idx & 7; const u32x4 uv = *(const u32x4*)(proj + (m0 + row) * PC + C_RV + 64 * hh + 8 * pc);
            bf16* d0 = VTs + (8 * pc) * 136 + row;
            d0[0] = (bf16)(uv.x & 0xffffu); d0[136] = (bf16)(uv.x >> 16); d0[2 * 136] = (bf16)(uv.y & 0xffffu); d0[3 * 136] = (bf16)(uv.y >> 16);
            d0[4 * 136] = (bf16)(uv.z & 0xffffu); d0[5 * 136] = (bf16)(uv.z >> 16); d0[6 * 136] = (bf16)(uv.w & 0xffffu); d0[7 * 136] = (bf16)(uv.w >> 16); }
        __syncthreads();
        bf16x8 qf[2];
#pragma unroll
        for (int ks = 0; ks < 2; ++ks) qf[ks] = *(const bf16x8*)(Qs + (32 * qt + n) * 32 + 16 * ks + 8 * h);
        f32x16 O;
#pragma unroll
        for (int i = 0; i < 16; ++i) O[i] = 0.f;
        for (int kt = 0; kt <= qt; ++kt) {
            f32x16 acc;
#pragma unroll
            for (int i = 0; i < 16; ++i) acc[i] = 0.f;
#pragma unroll
            for (int ks = 0; ks < 2; ++ks) { const bf16x8 af = *(const bf16x8*)(Ks + (32 * kt + krow) * 32 + 16 * ks + 8 * h); acc = MFMA32(af, qf[ks], acc); }
            if (kt == qt) {
#pragma unroll
                for (int i = 0; i < 16; ++i) { const int cc = 16 * (i >> 3) + (i & 7) + 8 * h; acc[i] = (cc <= n) ? acc[i] : 0.f; }
            }
#pragma unroll
            for (int j = 0; j < 2; ++j) { const bf16x8 pb = nsa_pack8(acc, j); const bf16x8 vf = *(const bf16x8*)(VTs + (32 * dt + n) * 136 + 32 * kt + 16 * j + 8 * h); O = MFMA32(vf, pb, O); }
        }
        { const bf16* ST = (const bf16*)(a.ws + WS_RST) + (((size_t)(b * 8 + hh) * 64 + c) * 64 + 32 * dt + n) * 32;
#pragma unroll
            for (int ks = 0; ks < 2; ++ks) { const bf16x8 sf = *(const bf16x8*)(ST + 16 * ks + 8 * h); O = MFMA32(sf, qf[ks], O); } }
        float ss = 0.f;
#pragma unroll
        for (int i = 0; i < 16; ++i) ss += O[i] * O[i];
        ss += __shfl_xor(ss, 32);
        if (h == 0) ssq[(dt * 4 + qt) * 32 + n] = ss;
        __syncthreads();
        const float rs = 1.f / sqrtf((ssq[qt * 32 + n] + ssq[(4 + qt) * 32 + n]) * (1.f / 64.f) + EPS);
        const size_t m = m0 + 32 * qt + n;
#pragma unroll
        for (int q4 = 0; q4 < 4; ++q4) { const int e0 = 32 * dt + 8 * q4 + 4 * h;
            const u32x2 ug = *(const u32x2*)(proj + m * PC + C_RG + 64 * hh + e0); const f32x4 gn = *(const f32x4*)(rng + 64 * hh + e0);
            const float z0 = bflo(ug.x), z1 = bfhi(ug.x), z2 = bflo(ug.y), z3 = bfhi(ug.y);
            const float y0 = O[4 * q4] * rs * gn.x * fsilu(z0), y1 = O[4 * q4 + 1] * rs * gn.y * fsilu(z1);
            const float y2 = O[4 * q4 + 2] * rs * gn.z * fsilu(z2), y3 = O[4 * q4 + 3] * rs * gn.w * fsilu(z3);
            u32x2 w; w.x = pk2(y0, y1); w.y = pk2(y2, y3);
            *(u32x2*)(mix + m * D + 512 + 64 * hh + e0) = w; }
        __syncthreads();
    }
}

struct Unit { int pm, pn, e, j, nvalid; };
struct DenseSched {
    const bf16* A; const bf16* Bt; int K, nM, nN, G, c;
    __device__ __forceinline__ bool next(int i, Unit& u) const {
        const int nwg = nM * nN; const int L = i * G + c; if (L >= nwg) return false;
        int wgid = L;
        if ((G & 7) == 0) { const int q = nwg >> 3, r = nwg & 7, xcd = L & 7, off = L >> 3; wgid = (xcd < r ? xcd * (q + 1) : r * (q + 1) + (xcd - r) * q) + off; }
        const int nig = 8 * nN, gid = wgid / nig, fm = gid * 8, gsz = (nM - fm) < 8 ? (nM - fm) : 8;
        u.pm = fm + ((wgid % nig) % gsz); u.pn = (wgid % nig) / gsz; u.e = 0; u.j = u.pm; u.nvalid = 256; return true;
    }
    __device__ __forceinline__ size_t arow(const Unit& u, int r) const { return (size_t)u.pm * 256 + r; }
    __device__ __forceinline__ const bf16* bt(const Unit& u) const { return Bt + (size_t)u.pn * 256 * K; }
    static constexpr bool LOADS = false;
    __device__ __forceinline__ bool loads() const { return false; }
    __device__ __forceinline__ const char* a_base(const Unit& u) const { return (const char*)(A + (size_t)u.pm * 256 * K); }
    __device__ __forceinline__ void a_offs(const Unit& u, const int (&R)[2], const int (&C)[2], unsigned (&v0)[2], unsigned (&v1)[2]) const {
#pragma unroll
        for (int i = 0; i < 2; ++i) { v0[i] = (unsigned)(R[i] * K + C[i]) * 2u; v1[i] = (unsigned)((R[i] + 128) * K + C[i]) * 2u; }
    }
};
template <bool GATHER>
struct RoutedSched {
    const bf16* A; const bf16* Bt; size_t bstride; int K, nN, G, c, ne;
    const int* tok;
    const int* tstart;
    const int* cnt;
    __device__ __forceinline__ bool next(int i, Unit& u) const {
        const int nM = tstart[ne], nwg = nM * nN; const int L = i * G + c; if (L >= nwg) return false;
        int wgid = L;
        if ((G & 7) == 0) { const int q = nwg >> 3, r = nwg & 7, xcd = L & 7, off = L >> 3; wgid = (xcd < r ? xcd * (q + 1) : r * (q + 1) + (xcd - r) * q) + off; }
        const int nig = 8 * nN, gid = wgid / nig, fm = gid * 8, gsz = (nM - fm) < 8 ? (nM - fm) : 8;
        const int rt = fm + ((wgid % nig) % gsz);
        u.pm = rt; u.pn = (wgid % nig) / gsz; int e = 0;
        for (int k = 1; k < ne; ++k) e += (tstart[k] <= rt) ? 1 : 0;
        u.e = e; u.j = rt - tstart[e]; const int left = cnt[e] - 256 * u.j; u.nvalid = left < 256 ? left : 256; return true;
    }
    __device__ __forceinline__ size_t arow(const Unit& u, int r) const {
        if (!GATHER) return (size_t)u.pm * 256 + r;
        const int i = 256 * u.j + (r < u.nvalid ? r : 0);
        return tok ? (size_t)tok[(size_t)u.e * M + i] : (size_t)i;
    }
    __device__ __forceinline__ const bf16* bt(const Unit& u) const { return Bt + (size_t)u.e * bstride + (size_t)u.pn * 256 * K; }
    static constexpr bool LOADS = GATHER;
    __device__ __forceinline__ bool loads() const { return GATHER && tok != nullptr; }
    __device__ __forceinline__ const char* a_base(const Unit& u) const { return GATHER ? (const char*)A : (const char*)(A + (size_t)u.pm * 256 * K); }
    __device__ __forceinline__ void a_offs(const Unit& u, const int (&R)[2], const int (&C)[2], unsigned (&v0)[2], unsigned (&v1)[2]) const {
#pragma unroll
        for (int i = 0; i < 2; ++i) {
            if (GATHER) { v0[i] = (unsigned)(arow(u, R[i]) * K + C[i]) * 2u; v1[i] = (unsigned)(arow(u, R[i] + 128) * K + C[i]) * 2u; }
            else { v0[i] = (unsigned)(R[i] * K + C[i]) * 2u; v1[i] = (unsigned)((R[i] + 128) * K + C[i]) * 2u; }
        }
    }
};
__device__ __forceinline__ void fold_norm(const f32x4& n0, const f32x4& n1, const f32x4& n2, const f32x4& n3, size_t m, int col, bf16* xb, const float* gain, float* rowss) {
    float ss = (n0.x * n0.x + n0.y * n0.y + n0.z * n0.z + n0.w * n0.w) + (n1.x * n1.x + n1.y * n1.y + n1.z * n1.z + n1.w * n1.w)
             + (n2.x * n2.x + n2.y * n2.y + n2.z * n2.z + n2.w * n2.w) + (n3.x * n3.x + n3.y * n3.y + n3.z * n3.z + n3.w * n3.w);
    ss += __shfl_xor(ss, 16); ss += __shfl_xor(ss, 32);
    if (lane_id() < 16) rowss[m * 16 + 4 * (col >> 8) + ((col >> 5) & 3)] = ss;
    const f32x4 g0 = *(const f32x4*)(gain + col), g1 = *(const f32x4*)(gain + col + 4), g2 = *(const f32x4*)(gain + col + 128), g3 = *(const f32x4*)(gain + col + 132);
    u32x4 w; w.x = pk2(n0.x * g0.x, n0.y * g0.y); w.y = pk2(n0.z * g0.z, n0.w * g0.w); w.z = pk2(n1.x * g1.x, n1.y * g1.y); w.w = pk2(n1.z * g1.z, n1.w * g1.w);
    *(u32x4*)(xb + m * D + col) = w;
    w.x = pk2(n2.x * g2.x, n2.y * g2.y); w.y = pk2(n2.z * g2.z, n2.w * g2.w); w.z = pk2(n3.x * g3.x, n3.y * g3.y); w.w = pk2(n3.z * g3.z, n3.w * g3.w);
    *(u32x4*)(xb + m * D + col + 128) = w;
}
__device__ __forceinline__ float fold_rstd(const float* rowss, size_t m) {
    const f32x4* p = (const f32x4*)(rowss + m * 16); const f32x4 a = p[0], b = p[1], c = p[2], d = p[3];
    const float ss = (((a.x + a.y) + (a.z + a.w)) + ((b.x + b.y) + (b.z + b.w))) + (((c.x + c.y) + (c.z + c.w)) + ((d.x + d.y) + (d.z + d.w)));
    return 1.0f / sqrtf(ss * (1.f / D) + EPS);
}
struct EpiIn {
    bf16* proj; float* gates; const float* rowss;
    __device__ __forceinline__ void row8(const Unit& u, int r, int c8, const float (&lo_)[8], const float (&hi_)[8]) const {
        const size_t m = (size_t)u.pm * 256 + r;
        const float rs = rowss ? fold_rstd(rowss, m) : 1.f;
        float lo[8], hi[8];
#pragma unroll
        for (int i = 0; i < 8; ++i) { lo[i] = lo_[i] * rs; hi[i] = hi_[i] * rs; }
        if (u.pn < 11) {
            u32x4 w; w.x = pk2(lo[0], lo[1]); w.y = pk2(lo[2], lo[3]); w.z = pk2(lo[4], lo[5]); w.w = pk2(lo[6], lo[7]);
            *(u32x4*)(proj + m * PC + u.pn * 256 + c8) = w;
            w.x = pk2(hi[0], hi[1]); w.y = pk2(hi[2], hi[3]); w.z = pk2(hi[4], hi[5]); w.w = pk2(hi[6], hi[7]);
            *(u32x4*)(proj + m * PC + u.pn * 256 + 128 + c8) = w;
        } else if (c8 < 24) {
            f32x4 s0, s1;
            s0.x = fsigmoid(lo[0]); s0.y = fsigmoid(lo[1]); s0.z = fsigmoid(lo[2]); s0.w = fsigmoid(lo[3]);
            s1.x = fsigmoid(lo[4]); s1.y = fsigmoid(lo[5]); s1.z = fsigmoid(lo[6]); s1.w = fsigmoid(lo[7]);
            *(f32x4*)(gates + m * 24 + c8) = s0; *(f32x4*)(gates + m * 24 + c8 + 4) = s1;
        }
    }
};
struct EpiRes {
    const float* base; float* out; bf16* xb; const float* gain; float* rowss;
    __device__ __forceinline__ void row8(const Unit& u, int r, int c8, const float (&lo)[8], const float (&hi)[8]) const {
        const size_t o = ((size_t)u.pm * 256 + r) * D + u.pn * 256 + c8;
        const f32x4 b0 = *(const f32x4*)(base + o), b1 = *(const f32x4*)(base + o + 4), b2 = *(const f32x4*)(base + o + 128), b3 = *(const f32x4*)(base + o + 132);
        const f32x4 n0 = (f32x4){b0.x + lo[0], b0.y + lo[1], b0.z + lo[2], b0.w + lo[3]}, n1 = (f32x4){b1.x + lo[4], b1.y + lo[5], b1.z + lo[6], b1.w + lo[7]};
        const f32x4 n2 = (f32x4){b2.x + hi[0], b2.y + hi[1], b2.z + hi[2], b2.w + hi[3]}, n3 = (f32x4){b3.x + hi[4], b3.y + hi[5], b3.z + hi[6], b3.w + hi[7]};
        *(f32x4*)(out + o) = n0; *(f32x4*)(out + o + 4) = n1; *(f32x4*)(out + o + 128) = n2; *(f32x4*)(out + o + 132) = n3;
        if (xb) fold_norm(n0, n1, n2, n3, (size_t)u.pm * 256 + r, u.pn * 256 + c8, xb, gain, rowss);
    }
};
struct EpiGU {
    bf16* hid; const float* rowss;
    __device__ __forceinline__ void row8(const Unit& u, int r, int c8, const float (&lo)[8], const float (&hi)[8]) const {
        float h[8];
        const float rs = rowss ? fold_rstd(rowss, (size_t)u.pm * 256 + r) : 1.f;
#pragma unroll
        for (int i = 0; i < 8; ++i) { const float gt = lo[i] * rs; h[i] = fsilu(gt) * (hi[i] * rs); }
        u32x4 w; w.x = pk2(h[0], h[1]); w.y = pk2(h[2], h[3]); w.z = pk2(h[4], h[5]); w.w = pk2(h[6], h[7]);
        *(u32x4*)(hid + ((size_t)u.pm * 256 + r) * FF + u.pn * 128 + c8) = w;
    }
};
struct EpiGU8 {
    unsigned char* hid;
    __device__ __forceinline__ void row8(const Unit& u, int r, int c8, const float (&lo)[8], const float (&hi)[8]) const {
        constexpr float inv = 1.f / (F8_SA * F8_SW);
        float h[8];
#pragma unroll
        for (int i = 0; i < 8; ++i) { const float gt = lo[i] * inv; h[i] = fsilu(gt) * (hi[i] * (inv * F8_SH)); }
        u32x2 w; w.x = pk4_fp8(h[0], h[1], h[2], h[3]); w.y = pk4_fp8(h[4], h[5], h[6], h[7]);
        *(u32x2*)(hid + ((size_t)u.pm * 256 + r) * FF + u.pn * 128 + c8) = w;
    }
};
struct EpiDown {
    float* x; const int* tok; const float* wt; float scale; bf16* xb; const float* gain; float* rowss;
    __device__ __forceinline__ void row8(const Unit& u, int r, int c8, const float (&lo)[8], const float (&hi)[8]) const {
        if (r >= u.nvalid) return;
        const int i = 256 * u.j + r; size_t m; float w;
        if (tok) { m = (size_t)tok[(size_t)u.e * M + i]; w = wt[(size_t)u.e * M + i] * scale; } else { m = (size_t)i; w = scale; }
        float* o = x + m * D + u.pn * 256 + c8;
        f32x4 b0 = *(f32x4*)(o), b1 = *(f32x4*)(o + 4), b2 = *(f32x4*)(o + 128), b3 = *(f32x4*)(o + 132);
        b0.x += w * lo[0]; b0.y += w * lo[1]; b0.z += w * lo[2]; b0.w += w * lo[3]; b1.x += w * lo[4]; b1.y += w * lo[5]; b1.z += w * lo[6]; b1.w += w * lo[7];
        b2.x += w * hi[0]; b2.y += w * hi[1]; b2.z += w * hi[2]; b2.w += w * hi[3]; b3.x += w * hi[4]; b3.y += w * hi[5]; b3.z += w * hi[6]; b3.w += w * hi[7];
        *(f32x4*)(o) = b0; *(f32x4*)(o + 4) = b1; *(f32x4*)(o + 128) = b2; *(f32x4*)(o + 132) = b3;
        if (xb) fold_norm(b0, b1, b2, b3, m, u.pn * 256 + c8, xb, gain, rowss);
    }
};

template <class Sched, class Epi>
__device__ __forceinline__ void gemm_naive(unsigned char* lds, const Sched& S, const Epi& E, int tid) {
    float* As = (float*)lds;
    float* Bs = As + 32 * 132;
    const int tr = tid >> 4, tc = tid & 15;
    const int lr = tid >> 2, lk = (tid & 3) * 8;
    const int K = S.K;
    Unit u;
    for (int it = 0; S.next(it, u); ++it) {
        const bf16* Btile = S.bt(u);
        for (int hf = 0; hf < 2; ++hf) {
            float lo[4][8], hi[4][8];
#pragma unroll
            for (int i = 0; i < 4; ++i)
#pragma unroll
                for (int j = 0; j < 8; ++j) { lo[i][j] = 0.f; hi[i][j] = 0.f; }
            const bf16* arow = S.A + S.arow(u, hf * 128 + lr) * K + lk;
            const bf16* brow0 = Btile + (size_t)lr * K + lk; const bf16* brow1 = Btile + (size_t)(lr + 128) * K + lk;
            for (int k0 = 0; k0 < K; k0 += 32) {
                const u32x4 av = *(const u32x4*)(arow + k0), b0 = *(const u32x4*)(brow0 + k0), b1 = *(const u32x4*)(brow1 + k0);
                __syncthreads();
                As[(lk + 0) * 132 + lr] = bflo(av.x); As[(lk + 1) * 132 + lr] = bfhi(av.x); As[(lk + 2) * 132 + lr] = bflo(av.y); As[(lk + 3) * 132 + lr] = bfhi(av.y);
                As[(lk + 4) * 132 + lr] = bflo(av.z); As[(lk + 5) * 132 + lr] = bfhi(av.z); As[(lk + 6) * 132 + lr] = bflo(av.w); As[(lk + 7) * 132 + lr] = bfhi(av.w);
                Bs[(lk + 0) * 260 + lr] = bflo(b0.x); Bs[(lk + 1) * 260 + lr] = bfhi(b0.x); Bs[(lk + 2) * 260 + lr] = bflo(b0.y); Bs[(lk + 3) * 260 + lr] = bfhi(b0.y);
                Bs[(lk + 4) * 260 + lr] = bflo(b0.z); Bs[(lk + 5) * 260 + lr] = bfhi(b0.z); Bs[(lk + 6) * 260 + lr] = bflo(b0.w); Bs[(lk + 7) * 260 + lr] = bfhi(b0.w);
                Bs[(lk + 0) * 260 + lr + 128] = bflo(b1.x); Bs[(lk + 1) * 260 + lr + 128] = bfhi(b1.x); Bs[(lk + 2) * 260 + lr + 128] = bflo(b1.y); Bs[(lk + 3) * 260 + lr + 128] = bfhi(b1.y);
                Bs[(lk + 4) * 260 + lr + 128] = bflo(b1.z); Bs[(lk + 5) * 260 + lr + 128] = bfhi(b1.z); Bs[(lk + 6) * 260 + lr + 128] = bflo(b1.w); Bs[(lk + 7) * 260 + lr + 128] = bfhi(b1.w);
                __syncthreads();
#pragma unroll 4
                for (int k = 0; k < 32; ++k) {
                    const f32x4 av4 = *(const f32x4*)(As + k * 132 + 4 * tr);
                    const f32x4 l0 = *(const f32x4*)(Bs + k * 260 + 8 * tc), l1 = *(const f32x4*)(Bs + k * 260 + 8 * tc + 4);
                    const f32x4 h0 = *(const f32x4*)(Bs + k * 260 + 128 + 8 * tc), h1 = *(const f32x4*)(Bs + k * 260 + 128 + 8 * tc + 4);
                    const float aa[4] = {av4.x, av4.y, av4.z, av4.w};
                    const float bl[8] = {l0.x, l0.y, l0.z, l0.w, l1.x, l1.y, l1.z, l1.w}, bh[8] = {h0.x, h0.y, h0.z, h0.w, h1.x, h1.y, h1.z, h1.w};
#pragma unroll
                    for (int i = 0; i < 4; ++i)
#pragma unroll
                        for (int j = 0; j < 8; ++j) { lo[i][j] += aa[i] * bl[j]; hi[i][j] += aa[i] * bh[j]; }
                }
            }
#pragma unroll
            for (int i = 0; i < 4; ++i) E.row8(u, hf * 128 + 4 * tr + i, 8 * tc, lo[i], hi[i]);
        }
    }
    __syncthreads();
}

namespace pg8 {
constexpr int BK = 64, HALF = 128, HTB = HALF * BK * 2;
__device__ __forceinline__ int lds_byte(int r, int c) { const int st = (r >> 4) * 2 + (c >> 5), rr = r & 15, cc = c & 31, ob = rr * 64 + cc * 2; return st * 1024 + (ob ^ (((ob >> 9) & 1) << 5)); }
__device__ __forceinline__ void stage_rc(int b, int& R, int& C) { const int st = b / 1024, sb = b % 1024, swz = sb ^ (((sb >> 9) & 1) << 5); R = (st >> 1) * 16 + swz / 64; C = (st & 1) * 32 + (swz % 64) / 2; }
__device__ __forceinline__ int perm32(int rho) { const int n = rho >> 4, i = rho & 15; return 8 * (i >> 2) + 4 * n + (i & 3); }
}
template <bool FP8, class Sched, class Epi>
__device__ __forceinline__ void gemm_fast(LAS unsigned char* lds, const Sched& S, const Epi& E, int wid) {
    using namespace pg8;
    const int lane = lane_id(), tid = wid * 64 + lane, wr = wid >> 2, wc = wid & 3, fr = lane & 15, fq = lane >> 4;
    const int K = S.K, nt = K / BK;
    unsigned voffB[2];
#pragma unroll
    for (int i = 0; i < 2; ++i) { int R, C; stage_rc(tid * 16 + i * 8192, R, C); const int Rb = (R & ~31) + perm32(R & 31); voffB[i] = (unsigned)(Rb * K + C) * 2u; }
    volatile LAS unsigned* nvs = (volatile LAS unsigned*)(lds + NVOFF_OFF) + tid * 4;
#define PG8_AOFFS(u, o0, o1) do { int _t = tid; asm volatile("" : "+v"(_t)); int _R[2], _C[2]; stage_rc(_t * 16, _R[0], _C[0]); stage_rc(_t * 16 + 8192, _R[1], _C[1]); S.a_offs(u, _R, _C, o0, o1); } while (0)
    const size_t kstep = (size_t)(BK * 2);
    const size_t hstep = (size_t)HALF * K * 2;
    const unsigned ldsw = (unsigned)wid * 1024u;
    const int aoff = lds_byte(wr * 64 + fr, fq * 8), boff = lds_byte(wc * 32 + fr, fq * 8);
    const int c8f = 32 * (fq >> 1) + 16 * (fq & 1);
    const int aoff0 = FP8 ? lds_byte(wr * 64 + fr, c8f) : 0, boff0 = FP8 ? lds_byte(wc * 32 + fr, c8f) : 0;
    int boffH = boff + 4 * HTB; asm volatile("" : "+v"(boffH));
#define PG8_SA(b, h) (((b) * 2 + (h)) * HTB)
#define PG8_SB(b, h) ((4 + (b) * 2 + (h)) * HTB)
#define PG8_STAGE(bufoff, gbase, voff) do { _Pragma("unroll") for (int _i = 0; _i < 2; ++_i) \
        __builtin_amdgcn_global_load_lds((const unsigned*)((const char*)(gbase) + (voff)[_i]), (LAS unsigned*)(lds + (bufoff) + ldsw + _i * 8192), 16, 0, 0); } while (0)
#define PG8_STAGE_A1(bufoff, gbase) do { if constexpr (Sched::LOADS) PG8_STAGE(bufoff, gbase, cv1); else PG8_STAGE(bufoff, (gbase) + hstep, cv0); } while (0)
#define PG8_LDA(dst, b, h) do { _Pragma("unroll") for (int m = 0; m < 4; ++m) _Pragma("unroll") for (int k = 0; k < 2; ++k) dst[m][k] = *(const LAS bf16x8*)(lds + PG8_SA(b, h) + aoff + m * 2048 + k * 1024); } while (0)
#define PG8_LDB(dst, b, h) do { _Pragma("unroll") for (int n = 0; n < 2; ++n) _Pragma("unroll") for (int k = 0; k < 2; ++k) dst[n][k] = *(const LAS bf16x8*)(lds + boffH + (PG8_SB(b, h) - 4 * HTB) + n * 2048 + k * 1024); } while (0)
#define PG8_MMA(ai, bj, At, Bt) do { __builtin_amdgcn_s_setprio(1); _Pragma("unroll") for (int m = 0; m < 4; ++m) _Pragma("unroll") for (int n = 0; n < 2; ++n) _Pragma("unroll") for (int k = 0; k < 2; ++k) \
        acc[ai][bj][m][n] = __builtin_amdgcn_mfma_f32_16x16x32_bf16(Bt[n][k], At[m][k], acc[ai][bj][m][n], 0, 0, 0); __builtin_amdgcn_s_setprio(0); } while (0)
#define PG8_RD8(dst, o0) do { const v4i _l = *(const LAS v4i*)(lds + (o0)), _h = *(const LAS v4i*)(lds + (o0) + 16); dst = __builtin_shufflevector(_l, _h, 0, 1, 2, 3, 4, 5, 6, 7); } while (0)
#define PG8_LDA8(dst, b, h) do { _Pragma("unroll") for (int m = 0; m < 4; ++m) { const v4i _l = *(const LAS v4i*)(lds + PG8_SA(b, h) + aoff + m * 2048), _h = *(const LAS v4i*)(lds + PG8_SA(b, h) + aoff + m * 2048 + 1024); dst[m] = __builtin_shufflevector(_l, _h, 0, 1, 2, 3, 4, 5, 6, 7); } } while (0)
#define PG8_LDB8(dst, b, h) do { _Pragma("unroll") for (int n = 0; n < 2; ++n) { const v4i _l = *(const LAS v4i*)(lds + boffH + (PG8_SB(b, h) - 4 * HTB) + n * 2048), _h = *(const LAS v4i*)(lds + boffH + (PG8_SB(b, h) - 4 * HTB) + n * 2048 + 1024); dst[n] = __builtin_shufflevector(_l, _h, 0, 1, 2, 3, 4, 5, 6, 7); } } while (0)
#define PG8_MMA8(ai, bj, At, Bt) do { __builtin_amdgcn_s_setprio(1); _Pragma("unroll") for (int m = 0; m < 4; ++m) _Pragma("unroll") for (int n = 0; n < 2; ++n) \
        asm volatile("v_mfma_scale_f32_16x16x128_f8f6f4 %0, %1, %2, %0, %3, %3 op_sel_hi:[0,0,0]" : "+v"(acc[ai][bj][m][n]) : "v"(Bt[n]), "v"(At[m]), "v"(f8scale)); __builtin_amdgcn_s_setprio(0); } while (0)
#define PG8_WAIT_V(n) asm volatile("s_waitcnt vmcnt(" #n ")" ::: "memory")
#define PG8_WAIT_L(n) asm volatile("s_waitcnt lgkmcnt(" #n ")" ::: "memory")
#define PG8_BAR __builtin_amdgcn_s_barrier()
#define PG8_SCHED __builtin_amdgcn_sched_barrier(0)
#define XLDA(b, h) do { if constexpr (FP8) PG8_LDA8(At8, b, h); else PG8_LDA(At, b, h); } while (0)
#define XLDB0(b, h) do { if constexpr (FP8) PG8_LDB8(B08, b, h); else PG8_LDB(B0, b, h); } while (0)
#define XLDB1(b, h) do { if constexpr (FP8) PG8_LDB8(B18, b, h); else PG8_LDB(B1, b, h); } while (0)
#define XMMA(ai, bj, w) do { if constexpr (FP8) { if (w) PG8_MMA8(ai, bj, At8, B18); else PG8_MMA8(ai, bj, At8, B08); } else { if (w) PG8_MMA(ai, bj, At, B1); else PG8_MMA(ai, bj, At, B0); } } while (0)
    Unit cur, nxt; int ui = 0;
    if (!S.next(0, cur)) return;
    f32x4 acc[2][2][4][2];
#pragma unroll
    for (int a = 0; a < 2; ++a)
#pragma unroll
        for (int b = 0; b < 2; ++b)
#pragma unroll
            for (int m = 0; m < 4; ++m)
#pragma unroll
                for (int n = 0; n < 2; ++n) acc[a][b][m][n] = (f32x4){0.f, 0.f, 0.f, 0.f};
    bf16x8 At[4][2], B0[2][2], B1[2][2];
    v8i At8[4], B08[2], B18[2];
    const int f8scale = 0x7f7f7f7f;
    unsigned cv0[2], cv1[2];
    const char* cA = S.a_base(cur); const char* cB = (const char*)S.bt(cur);
    PG8_AOFFS(cur, cv0, cv1);
    if (Sched::LOADS && S.loads()) PG8_WAIT_V(0);
    PG8_STAGE(PG8_SB(0, 0), cB, voffB); PG8_STAGE(PG8_SB(0, 1), cB + hstep, voffB); PG8_STAGE(PG8_SA(0, 0), cA, cv0); PG8_STAGE_A1(PG8_SA(0, 1), cA);
    if (wr == 1) PG8_BAR;
    PG8_WAIT_V(2); PG8_BAR;
    PG8_STAGE(PG8_SB(1, 0), cB + kstep, voffB); PG8_STAGE(PG8_SA(1, 0), cA + kstep, cv0); PG8_STAGE(PG8_SB(1, 1), cB + hstep + kstep, voffB);
    PG8_WAIT_V(6); PG8_BAR;
    for (;;) {
        const bool has_next = S.next(ui + 1, nxt);
        const char* nA = cA; const char* nB = cB;
        if (has_next) { nA = S.a_base(nxt); nB = (const char*)S.bt(nxt);
            if (Sched::LOADS) { unsigned n0[2], n1[2]; PG8_AOFFS(nxt, n0, n1); if (S.loads()) PG8_WAIT_V(0); nvs[0] = n0[0]; nvs[1] = n0[1]; nvs[2] = n1[0]; nvs[3] = n1[1]; } }
        for (int t = 0; t < nt; t += 2) {
            const bool last = (t == nt - 2);
            const char* a1 = cA + (size_t)(t + 1) * kstep;
            const char* a2 = last ? nA : cA + (size_t)(t + 2) * kstep; const char* b2 = last ? nB : cB + (size_t)(t + 2) * kstep;
            const char* a3 = a2 + kstep; const char* b3 = b2 + kstep;
            XLDB0(0, 0); XLDB1(0, 1); PG8_SCHED; XLDA(0, 0); PG8_STAGE_A1(PG8_SA(1, 1), a1);
            if (Sched::LOADS) { if (last && has_next) { cv0[0] = nvs[0]; cv0[1] = nvs[1]; cv1[0] = nvs[2]; cv1[1] = nvs[3]; } }
            PG8_WAIT_V(8); PG8_WAIT_L(0); PG8_BAR; XMMA(0, 0, 0); XMMA(0, 1, 1); PG8_BAR; PG8_SCHED;
            XLDA(0, 1); PG8_STAGE(PG8_SB(0, 0), b2, voffB); PG8_STAGE(PG8_SB(0, 1), b2 + hstep, voffB); PG8_STAGE(PG8_SA(0, 0), a2, cv0);
            PG8_WAIT_V(8); PG8_WAIT_L(0); PG8_BAR; XMMA(1, 0, 0); XMMA(1, 1, 1); PG8_BAR; PG8_SCHED;
            XLDB0(1, 0); XLDB1(1, 1); PG8_SCHED; XLDA(1, 0); PG8_STAGE_A1(PG8_SA(0, 1), a2);
            PG8_WAIT_V(8); PG8_WAIT_L(0); PG8_BAR; XMMA(0, 0, 0); XMMA(0, 1, 1); PG8_BAR; PG8_SCHED;
            XLDA(1, 1); PG8_STAGE(PG8_SB(1, 0), b3, voffB); PG8_STAGE(PG8_SB(1, 1), b3 + hstep, voffB); PG8_STAGE(PG8_SA(1, 0), a3, cv0);
            PG8_WAIT_V(8); PG8_WAIT_L(0); PG8_BAR; XMMA(1, 0, 0); XMMA(1, 1, 1); PG8_BAR; PG8_SCHED;
        }
        if (wr == 0) PG8_BAR;
        {
            int frl = fr, c8 = wc * 32 + 8 * fq;
            asm volatile("" : "+v"(frl), "+v"(c8));
#pragma unroll
            for (int ai = 0; ai < 2; ++ai)
#pragma unroll
                for (int m = 0; m < 4; ++m) {
                    const float lo[8] = {acc[ai][0][m][0][0], acc[ai][0][m][0][1], acc[ai][0][m][0][2], acc[ai][0][m][0][3], acc[ai][0][m][1][0], acc[ai][0][m][1][1], acc[ai][0][m][1][2], acc[ai][0][m][1][3]};
                    const float hi[8] = {acc[ai][1][m][0][0], acc[ai][1][m][0][1], acc[ai][1][m][0][2], acc[ai][1][m][0][3], acc[ai][1][m][1][0], acc[ai][1][m][1][1], acc[ai][1][m][1][2], acc[ai][1][m][1][3]};
                    E.row8(cur, ai * HALF + wr * 64 + m * 16 + frl, c8, lo, hi);
                }
        }
        if (!has_next) break;
#pragma unroll
        for (int a = 0; a < 2; ++a)
#pragma unroll
            for (int b = 0; b < 2; ++b)
#pragma unroll
                for (int m = 0; m < 4; ++m)
#pragma unroll
                    for (int n = 0; n < 2; ++n) acc[a][b][m][n] = (f32x4){0.f, 0.f, 0.f, 0.f};
        cur = nxt; cA = nA; cB = nB; ++ui;
        if (wr == 1) PG8_BAR;
    }
    PG8_WAIT_V(0);
    PG8_BAR;
#undef XLDA
#undef XLDB0
#undef XLDB1
#undef XMMA
#undef PG8_RD8
#undef PG8_LDA8
#undef PG8_LDB8
#undef PG8_MMA8
#undef PG8_STAGE_A1
#undef PG8_AOFFS
#undef PG8_SA
#undef PG8_SB
#undef PG8_STAGE
#undef PG8_LDA
#undef PG8_LDB
#undef PG8_MMA
#undef PG8_WAIT_V
#undef PG8_WAIT_L
#undef PG8_BAR
#undef PG8_SCHED
}

__device__ __forceinline__ void routed_setup(unsigned char* lds, const int* cnt_g, int ne, bool dense, int tid, int*& tstart, int*& cnt) {
    tstart = (int*)(lds + MISC_OFF + 64); cnt = tstart + 16;
    __syncthreads();
    if (tid == 0) { int acc = 0; for (int e = 0; e < ne; ++e) { const int n = dense ? M : __hip_atomic_load(cnt_g + e, __ATOMIC_RELAXED, __HIP_MEMORY_SCOPE_AGENT); cnt[e] = n; tstart[e] = acc; acc += (n + 255) >> 8; } tstart[ne] = acc; }
    __syncthreads();
}

constexpr int PH_PER_LAYER = 11, NPHASE = 2 * PH_PER_LAYER;
#if FAST_GEMM
#define GEMM_CALL(S, E) gemm_fast<false>((LAS unsigned char*)lds, S, E, wave)
#define GEMM_CALL8(S, E) gemm_fast<true>((LAS unsigned char*)lds, S, E, wave)
#else
#define GEMM_CALL(S, E) gemm_naive(lds, S, E, wave * 64 + lane_id())
#endif
#define IN(k) (lo <= (k) && (k) < hi)
#define SEAM(k) do { if (IN(k) && IN((k) + 1)) xcd_barrier(bar); } while (0)
template <int L>
__device__ __forceinline__ void layer(const Args& a, unsigned char* lds, const XcdBarrier& bar, int wave, int G, int blk) {
#define lane lane_id()
#define tid (wave * 64 + lane_id())
    unsigned char* ws = a.ws;
    const int lo = a.ph_lo, hi = a.ph_hi;
    bf16* hn = (bf16*)(ws + WS_HN); bf16* proj = (bf16*)(ws + WS_PROJ); float* gates = (float*)(ws + WS_GATES);
    int* cntg = (int*)(ws + WS_CTL) + CW_CNT;
    {
        constexpr int l = L; constexpr int P = l * PH_PER_LAYER;
        const float* xin = (l == 0) ? a.in[0] : a.out;
        constexpr bool FUSED = FUSE_NORM && FAST_GEMM;
        float* rowss0 = (float*)(ws + WS_ROWP); float* rowss1 = rowss0 + (size_t)M * 16;
        bf16* x2 = (bf16*)(ws + WS_X2);
        if (IN(P + 0)) {
            if (l == 0) conv_phase(a, lds, blk * NWAVES + wave, G * NWAVES, wave, lane);
            if (l == 0) { const int gw = blk * NWAVES + wave;
                if (gw < 256) { const int lw = gw >> 6, nn = gw & 63, ln = lane; const float* pos = a.in[5] + (size_t)lw * 2048; const float* w = a.in[6] + (size_t)lw * 2048 * 64;
                    float sacc = 0.f;
                    for (int i = 0; i < 32; ++i) sacc += pos[64 * i + ln] * w[(size_t)(64 * i + ln) * 64 + nn];
                    sacc = wave_sum(sacc);
                    if (ln == 0) ((float*)(ws + WS_CTL) + CW_CBIAS)[lw * 64 + nn] = sacc; } }
            if (!(FUSED && l == 1)) norm_phase<false>(a, lds, xin, a.in[1] + l * D, hn, blk, G, wave, lane, tid);
        }
        if (!(FUSED && l == 1)) SEAM(P + 0);
        if (IN(P + 1)) {
            DenseSched S{hn, (const bf16*)(ws + WS_WIN) + (size_t)l * NIN * D, D, M / 256, NIN / 256, G, blk};
            EpiIn E{proj, gates, (FUSED && l == 1) ? rowss1 : nullptr};
            GEMM_CALL(S, E);
        }
        SEAM(P + 1);
        if (IN(P + 2)) post_phase(a, lds, l, blk, G, wave, lane, tid);
        SEAM(P + 2);
        if (IN(P + 3)) { scan_phase(a, blk, G, tid);
#if NSA_FAST && NSA_LS
            nsa_ls_phase(a, lds, l, blk, G, wave);
#elif NSA_FAST
            nsa_fast_phase(a, lds, l, blk, G, wave);
#else
            nsa_phase(a, lds, blk, G, tid);
#endif
        }
        SEAM(P + 3);
        if (IN(P + 4)) {
#if RET_FAST
            retout_fast_phase(a, lds, l, blk, G, wave);
#else
            retout_phase(a, l, blk, G, tid);
#endif
        }
        SEAM(P + 4);
        if (IN(P + 5)) {
            DenseSched S{hn, (const bf16*)(ws + WS_WOUT) + (size_t)l * D * D, D, M / 256, D / 256, G, blk};
            EpiRes E{xin, a.out, (FUSED && l == 0) ? x2 : nullptr, a.in[9] + l * D, rowss0};
            GEMM_CALL(S, E);
        }
        SEAM(P + 5);
        if (IN(P + 6)) {
            if (l == 0) { if (!FUSED) norm_phase<false, DENSE_FP8 && FAST_GEMM>(a, lds, a.out, a.in[9] + l * D, hn, blk, G, wave, lane, tid); }
            else norm_phase<true, MOE_FP8 && FAST_GEMM>(a, lds, a.out, a.in[9] + l * D, hn, blk, G, wave, lane, tid);
        }
        if (!(FUSED && l == 0)) SEAM(P + 6);
#pragma unroll
        for (int s = 0; s < 2; ++s) {
            const bool dense = (l == 0);
            if (dense && s == 1) break;
            const int ne = dense ? 1 : NE;
            const int* tok = dense ? nullptr : (const int*)(ws + WS_RTOK) + (size_t)s * NE * M;
            const float* wt = dense ? nullptr : (const float*)(ws + WS_RWT) + (size_t)s * NE * M;
            if (IN(P + 7 + 2 * s)) {
                int *tstart, *cnt; routed_setup(lds, cntg + s * 8, ne, dense, tid, tstart, cnt);
                if (!(FAST_GEMM && (dense ? DENSE_FP8 : MOE_FP8))) {
                    RoutedSched<true> S{(FUSED && dense) ? x2 : hn, (const bf16*)(ws + (dense ? WS_WGU : WS_MGU)), (size_t)2 * FF * D, D, 2 * FF / 256, G, blk, ne, tok, tstart, cnt};
                    EpiGU E{proj, (FUSED && dense) ? rowss0 : nullptr};
                    GEMM_CALL(S, E);
                } else {
#if (MOE_FP8 || DENSE_FP8) && FAST_GEMM
                    RoutedSched<true> S{hn, (const bf16*)(ws + (dense ? WS_WGU : WS_MGU)), (size_t)2 * FF * D / 2, D / 2, 2 * FF / 256, G, blk, ne, tok, tstart, cnt};
                    EpiGU8 E{(unsigned char*)proj};
                    GEMM_CALL8(S, E);
#endif
                }
            }
            SEAM(P + 7 + 2 * s);
            if (IN(P + 8 + 2 * s)) {
                int *tstart, *cnt; routed_setup(lds, cntg + s * 8, ne, dense, tid, tstart, cnt);
                if (!(FAST_GEMM && (dense ? DENSE_FP8 : MOE_FP8))) {
                    RoutedSched<false> S{proj, (const bf16*)(ws + (dense ? WS_WDN : WS_MDN)), (size_t)D * FF, FF, D / 256, G, blk, ne, tok, tstart, cnt};
                    EpiDown E{a.out, tok, wt, 1.f, (FUSED && dense) ? hn : nullptr, a.in[1] + D, rowss1};
                    GEMM_CALL(S, E);
                } else {
#if (MOE_FP8 || DENSE_FP8) && FAST_GEMM
                    RoutedSched<false> S{proj, (const bf16*)(ws + (dense ? WS_WDN : WS_MDN)), (size_t)D * FF / 2, FF / 2, D / 256, G, blk, ne, tok, tstart, cnt};
                    EpiDown E{a.out, tok, wt, 1.f / (F8_SH * F8_SW), nullptr, nullptr, nullptr};
                    GEMM_CALL8(S, E);
#endif
                }
            }
            if (!(l == 1 && s == 1)) SEAM(P + 8 + 2 * s);
        }
    }
}
#undef lane
#undef tid
#undef IN
#undef SEAM
__global__ void __launch_bounds__(NTHR, 2) fwd(Args a) {
    extern __shared__ __attribute__((aligned(16))) unsigned char lds[];
    const int wave = __builtin_amdgcn_readfirstlane(threadIdx.x >> 6);
    const int G = gridDim.x, blk = blockIdx.x;
    unsigned char* ws = a.ws;
    volatile LAS unsigned* misc = (volatile LAS unsigned*)((LAS unsigned char*)lds + MISC_OFF);
    if (wave == 0) misc[lane_id()] = 0u;
    __syncthreads();
    XcdBarrier bar; bar.bar = (unsigned*)(ws + WS_CTL) + CW_BAR; bar.x = 0; bar.st = nullptr;
    const bool multi = (a.ph_hi - a.ph_lo) > 1;
    bar.wave = wave;
    if (multi) bar = xcd_barrier_post((unsigned*)(ws + WS_CTL) + CW_BAR, misc + 8, wave);
    layer<0>(a, lds, bar, wave, G, blk);
    layer<1>(a, lds, bar, wave, G, blk);
}

extern "C" void kernel_launch(void* const* d_in, const int* in_sizes, int n_in, void* d_out, int out_size, void* d_ws, size_t ws_size, hipStream_t stream) {
    static int grid = 0;
    if (grid == 0) {
        if (n_in != 18 || out_size != M * D || ws_size < WS_END) { fprintf(stderr, "kernel_launch: unexpected problem (n_in %d out %d ws %zu)\n", n_in, out_size, ws_size); grid = -1; return; }
        int dev = 0, cus = 0;
        if (hipGetDevice(&dev) != hipSuccess || hipDeviceGetAttribute(&cus, hipDeviceAttributeMultiprocessorCount, dev) != hipSuccess) { grid = -1; return; }
        if (hipFuncSetAttribute((const void*)fwd, hipFuncAttributeMaxDynamicSharedMemorySize, LDS_BYTES) != hipSuccess) { grid = -1; return; }
        int per_cu = 0;
        if (hipOccupancyMaxActiveBlocksPerMultiprocessor(&per_cu, (const void*)fwd, NTHR, LDS_BYTES) != hipSuccess || per_cu < 1) fprintf(stderr, "kernel_launch: occupancy query says %d\n", per_cu);
        (void)hipGetLastError();
        grid = 256;
        if (cus < 256) { fprintf(stderr, "kernel_launch: needs 256 CUs, device has %d\n", cus); grid = -1; return; }
    }
    if (grid < 0) return;
    (void)hipMemsetAsync((char*)d_ws + WS_CTL, 0, CTL_BYTES, stream);
    Args a{};
    for (int i = 0; i < 18; ++i) a.in[i] = (const float*)d_in[i];
    a.out = (float*)d_out; a.ws = (unsigned char*)d_ws;
#if ONE_LAUNCH
    a.ph_lo = 0; a.ph_hi = NPHASE;
    hipLaunchKernelGGL(fwd, dim3(grid), dim3(NTHR), LDS_BYTES, stream, a);
#else
    for (int p = 0; p < NPHASE; ++p) {
        if (p == 9 || p == 10) continue;
        a.ph_lo = p; a.ph_hi = p + 1;
        hipLaunchKernelGGL(fwd, dim3(grid), dim3(NTHR), LDS_BYTES, stream, a);
    }
#endif
}
```
